# Optimizing an MI355X kernel written in HIP

```python
import jax, jax.numpy as jnp
from jax import lax
import numpy as np

D_MODEL = 1024
BATCH = 2
SEQ = 8192
DEPTH = 1
DEC_BATCH = 32
DEC_SEQ = 64
PAST_LEN = 4096

CHUNK = 64
Q_BLOCK = 128
GLA_HEADS = 4
GLA_DK = D_MODEL // 2 // GLA_HEADS
GLA_DV = D_MODEL // GLA_HEADS
GLA_QK = GLA_HEADS * GLA_DK
GLA_V = GLA_HEADS * GLA_DV
GLA_GATE_RANK = 16
GLA_GATE_TEMP = 16.0
SB_HEADS = 8
SB_DH = D_MODEL // SB_HEADS
SB_W = SB_HEADS * SB_DH
D_FF = 2816
LN_EPS = 1e-5
DN_ALPHA = (2 * DEPTH) ** 0.25
DN_BETA = (8 * DEPTH) ** -0.25
SPLITS = (GLA_QK, GLA_QK, GLA_V, GLA_V, GLA_GATE_RANK, SB_W, SB_W, SB_W, D_MODEL, D_MODEL)
D_IN = sum(SPLITS)
SPLIT_POINTS = tuple(int(v) for v in np.cumsum(SPLITS)[:-1])

kernel_name = 'gla_stickbreaking_macaron_deepnorm_stream'


def layer_norm(x, g, b):
    xf = x.astype(jnp.float32)
    mu = jnp.mean(xf, axis=-1, keepdims=True)
    var = jnp.mean(jnp.square(xf - mu), axis=-1, keepdims=True)
    return ((xf - mu) * lax.rsqrt(var + LN_EPS) * g + b).astype(x.dtype)


def swiglu(x, w_in, w_out):
    gate, up = jnp.split(x @ w_in, 2, axis=-1)
    return (jax.nn.silu(gate) * up) @ w_out


def head_rms_norm(o, g):
    of = o.astype(jnp.float32)
    return of * lax.rsqrt(jnp.mean(jnp.square(of), axis=-1, keepdims=True) + LN_EPS) * g


def gla_chunked(q, k, v, log_a, s0):
    B, T, H, dk = q.shape
    dv = v.shape[-1]
    c = min(CHUNK, T)
    n = T // c

    def chunks(t):
        return jnp.moveaxis(t.reshape(B, n, c, H, t.shape[-1]), 1, 0)

    causal = jnp.tril(jnp.ones((c, c), dtype=bool))

    def step(S, inp):
        qc, kc, vc, gc = inp
        b = jnp.cumsum(gc, axis=1)
        b_last = b[:, -1]
        qg = qc * jnp.exp(b)
        kg = kc * jnp.exp(-b)
        kd = kc * jnp.exp(b_last[:, None] - b)
        att = jnp.where(causal, jnp.einsum('bthk,bshk->bhts', qg, kg), 0.0)
        o = jnp.einsum('bhts,bshv->bthv', att, vc) + jnp.einsum('bthk,bhkv->bthv', qg, S)
        S = jnp.exp(b_last)[..., None] * S + jnp.einsum('bshk,bshv->bhkv', kd, vc)
        return S, o

    S, o = lax.scan(step, s0.astype(jnp.float32), (chunks(q), chunks(k), chunks(v), chunks(log_a)))
    o = jnp.moveaxis(o, 0, 1).reshape(B, T, H, dv)
    return o, S.astype(s0.dtype)


def sb_block(qb, q_pos, k, v, k_pos):
    z = jnp.einsum('bqhd,bkhd->bhqk', qb, k).astype(jnp.float32) * (SB_DH ** -0.5)
    visible = k_pos[None, :] < q_pos[:, None]
    log_beta = jax.nn.log_sigmoid(z)
    log_keep = jnp.where(visible, jax.nn.log_sigmoid(-z), 0.0)
    rev = lax.cumsum(log_keep, axis=3, reverse=True)
    between = jnp.concatenate([rev[..., 1:], jnp.zeros_like(rev[..., :1])], axis=-1)
    w = jnp.exp(jnp.where(visible, log_beta + between, -jnp.inf))
    return jnp.einsum('bhqk,bkhd->bqhd', w, v).astype(qb.dtype)


def stick_breaking(q, k, v, n_past):
    B, T, H, d = q.shape
    blk = min(Q_BLOCK, T)
    nb = T // blk
    k_pos = jnp.arange(k.shape[1])
    q_pos = (n_past + jnp.arange(T)).reshape(nb, blk)
    q_blocks = jnp.moveaxis(q.reshape(B, nb, blk, H, d), 1, 0)
    out = lax.map(lambda a: sb_block(a[0], a[1], k, v, k_pos), (q_blocks, q_pos))
    return jnp.moveaxis(out, 0, 1).reshape(B, T, H, d)


def token_mix(h, s0, k_past, v_past, w_in, w_gla_gate_up, b_gla_gate, g_gla_norm, w_gla_o, w_sb_o, w_out):
    B, T, _ = h.shape
    gq, gk, gv, gr, glr, sq, sk, sv, ga, gb = jnp.split(h @ w_in, SPLIT_POINTS, axis=-1)
    q = gq.reshape(B, T, GLA_HEADS, GLA_DK) * (GLA_DK ** -0.5)
    k = gk.reshape(B, T, GLA_HEADS, GLA_DK)
    v = gv.reshape(B, T, GLA_HEADS, GLA_DV)
    log_a = (jax.nn.log_sigmoid((glr @ w_gla_gate_up + b_gla_gate).astype(jnp.float32))
             / GLA_GATE_TEMP).reshape(B, T, GLA_HEADS, GLA_DK)
    o_a, s_new = gla_chunked(q, k, v, log_a, s0)
    o_a = head_rms_norm(o_a, g_gla_norm).reshape(B, T, GLA_V).astype(h.dtype) * jax.nn.silu(gr)
    branch_a = o_a @ w_gla_o
    sq = sq.reshape(B, T, SB_HEADS, SB_DH)
    sk = sk.reshape(B, T, SB_HEADS, SB_DH)
    sv = sv.reshape(B, T, SB_HEADS, SB_DH)
    k_all = jnp.concatenate([k_past, sk], axis=1)
    v_all = jnp.concatenate([v_past, sv], axis=1)
    o_b = stick_breaking(sq, k_all, v_all, k_past.shape[1])
    branch_b = o_b.reshape(B, T, SB_W) @ w_sb_o
    merged = jax.nn.sigmoid(ga) * branch_a + jax.nn.sigmoid(gb) * branch_b
    return merged @ w_out, s_new, sk, sv


def encoder_layer(x, s0, k_past, v_past, ffn1_w_in, ffn1_w_out, ln1_g, ln1_b,
                  w_in, w_gla_gate_up, b_gla_gate, g_gla_norm, w_gla_o, w_sb_o, w_out, ln2_g, ln2_b,
                  ffn2_w_in, ffn2_w_out, ln3_g, ln3_b):
    h = layer_norm(DN_ALPHA * x + 0.5 * swiglu(x, ffn1_w_in, ffn1_w_out), ln1_g, ln1_b)
    mix, s_new, k_new, v_new = token_mix(h, s0, k_past, v_past, w_in, w_gla_gate_up, b_gla_gate,
                                         g_gla_norm, w_gla_o, w_sb_o, w_out)
    h = layer_norm(DN_ALPHA * h + mix, ln2_g, ln2_b)
    y = layer_norm(DN_ALPHA * h + 0.5 * swiglu(h, ffn2_w_in, ffn2_w_out), ln3_g, ln3_b)
    return y, s_new, k_new, v_new


def setup_inputs(seed: int = 0) -> dict:
    key = jax.random.key(seed)
    ks = iter(jax.random.split(key, 32))

    def nrm(shape, scale):
        return jax.random.normal(next(ks), shape, jnp.float32) * scale

    L = DEPTH
    return {
        'x_prompt': nrm((BATCH, SEQ, D_MODEL), 1.0),
        'x_sample': nrm((DEC_BATCH, DEC_SEQ, D_MODEL), 1.0),
        'state_gla': nrm((L, DEC_BATCH, GLA_HEADS, GLA_DK, GLA_DV), 1.0),
        'cache_sb_k': nrm((L, DEC_BATCH, PAST_LEN, SB_HEADS, SB_DH), 1.0),
        'cache_sb_v': nrm((L, DEC_BATCH, PAST_LEN, SB_HEADS, SB_DH), 1.0),
        'ffn1_w_in': nrm((L, D_MODEL, 2 * D_FF), D_MODEL ** -0.5),
        'ffn1_w_out': nrm((L, D_FF, D_MODEL), D_FF ** -0.5 * DN_BETA),
        'ln1_g': 1.0 + nrm((L, D_MODEL), 0.02),
        'ln1_b': nrm((L, D_MODEL), 0.02),
        'w_in': nrm((L, D_MODEL, D_IN), D_MODEL ** -0.5),
        'w_gla_gate_up': nrm((L, GLA_GATE_RANK, GLA_QK), GLA_GATE_RANK ** -0.5),
        'b_gla_gate': nrm((L, GLA_QK), 0.1),
        'g_gla_norm': 1.0 + nrm((L, GLA_HEADS, GLA_DV), 0.02),
        'w_gla_o': nrm((L, GLA_V, D_MODEL), GLA_V ** -0.5),
        'w_sb_o': nrm((L, SB_W, D_MODEL), SB_W ** -0.5),
        'w_out': nrm((L, D_MODEL, D_MODEL), D_MODEL ** -0.5 * DN_BETA),
        'ln2_g': 1.0 + nrm((L, D_MODEL), 0.02),
        'ln2_b': nrm((L, D_MODEL), 0.02),
        'ffn2_w_in': nrm((L, D_MODEL, 2 * D_FF), D_MODEL ** -0.5),
        'ffn2_w_out': nrm((L, D_FF, D_MODEL), D_FF ** -0.5 * DN_BETA),
        'ln3_g': 1.0 + nrm((L, D_MODEL), 0.02),
        'ln3_b': nrm((L, D_MODEL), 0.02),
    }


def reference(x_prompt, x_sample, state_gla, cache_sb_k, cache_sb_v,
              ffn1_w_in, ffn1_w_out, ln1_g, ln1_b,
              w_in, w_gla_gate_up, b_gla_gate, g_gla_norm, w_gla_o, w_sb_o, w_out, ln2_g, ln2_b,
              ffn2_w_in, ffn2_w_out, ln3_g, ln3_b):
    bp = x_prompt.shape[0]
    xp, xs = x_prompt, x_sample
    gla_p, k_p, v_p, gla_s, k_s, v_s = [], [], [], [], [], []
    for l in range(DEPTH):
        lw = (ffn1_w_in[l], ffn1_w_out[l], ln1_g[l], ln1_b[l],
              w_in[l], w_gla_gate_up[l], b_gla_gate[l], g_gla_norm[l], w_gla_o[l], w_sb_o[l], w_out[l],
              ln2_g[l], ln2_b[l], ffn2_w_in[l], ffn2_w_out[l], ln3_g[l], ln3_b[l])
        s0_p = jnp.zeros((bp, GLA_HEADS, GLA_DK, GLA_DV), xp.dtype)
        past_p = jnp.zeros((bp, 0, SB_HEADS, SB_DH), xp.dtype)
        xp, sp, kp, vp = encoder_layer(xp, s0_p, past_p, past_p, *lw)
        xs, ss, ksn, vsn = encoder_layer(xs, state_gla[l], cache_sb_k[l], cache_sb_v[l], *lw)
        gla_p.append(sp); k_p.append(kp); v_p.append(vp)
        gla_s.append(ss); k_s.append(ksn); v_s.append(vsn)
    return (xp, xs, jnp.stack(gla_p), jnp.stack(k_p), jnp.stack(v_p),
            jnp.stack(gla_s), jnp.stack(k_s), jnp.stack(v_s))
```

```cpp
#include <hip/hip_runtime.h>
#include <cstdio>
#include <cstdint>
namespace pg8 {
#define PG8_LAS __attribute__((address_space(3)))
typedef unsigned short bf16_t;
typedef short bf16x8 __attribute__((ext_vector_type(8)));
typedef float f32x4 __attribute__((ext_vector_type(4)));
typedef unsigned u32x4 __attribute__((ext_vector_type(4)));
constexpr int BM = 256, BK = 64, HALF = 128, HTB = HALF * BK * 2  , STAGE_BYTES = 8 * HTB, NXCD = 8, WGM = 8;

__host__ __device__ __forceinline__ int lds_byte(int r, int c) { const int st = (r >> 4) * 2 + (c >> 5), rr = r & 15, cc = c & 31, ob = rr * 64 + cc * 2; return st * 1024 + (ob ^ (((ob >> 9) & 1) << 5)); }
__host__ __device__ __forceinline__ void stage_rc(int b, int& R, int& C) { const int st = b / 1024, sb = b % 1024, swz = sb ^ (((sb >> 9) & 1) << 5); R = (st >> 1) * 16 + swz / 64; C = (st & 1) * 32 + (swz % 64) / 2; }
__host__ __device__ __forceinline__ int perm32(int rho) { const int n = rho >> 4, i = rho & 15; return 8 * (i >> 2) + 4 * n + (i & 3); }

struct Unit { int pm, pn; };
struct Gemm { const bf16_t* A; const bf16_t* Bt; int M, N, K; };

struct StaticOrder {
    int nM, nN, nwg, G, c;
    __host__ __device__ void init(int M, int N, int G_, int c_) { nM = M / BM; nN = N / BM; nwg = nM * nN; G = G_; c = c_; }
    __host__ __device__ bool next(int i, Unit& u) const {
        const long L = (long)i * G + c; if (L >= nwg) return false;
        int wgid = (int)L; { const int q = nwg / NXCD, r = nwg % NXCD, xcd = wgid % NXCD, off = wgid / NXCD; wgid = (xcd < r ? xcd * (q + 1) : r * (q + 1) + (xcd - r) * q) + off; }
        const int nig = WGM * nN, gid = wgid / nig, fm = gid * WGM, gsz = (nM - fm) < WGM ? (nM - fm) : WGM;
        u.pm = fm + ((wgid % nig) % gsz); u.pn = (wgid % nig) / gsz; return true;
    }
    __device__ __forceinline__ void a_ready(const Unit&) const {}
    __device__ __forceinline__ void done(const Unit&) const {}
};

__device__ __forceinline__ unsigned cvt_pk_bf16(float lo, float hi) { unsigned r; asm volatile("v_cvt_pk_bf16_f32 %0, %1, %2" : "=v"(r) : "v"(lo), "v"(hi)); return r; }
__device__ __forceinline__ float fast_sigmoid(float x) { return __builtin_amdgcn_rcpf(1.0f + __builtin_amdgcn_exp2f(-1.4426950408889634f * x)); }
struct EpiSwiGLU {
    static constexpr bool PERM = true, AFTER_DRAIN = false;
    bf16_t* O; int ldc;
    __device__ __forceinline__ void operator()(const f32x4 (&acc)[2][2][4][2], const Unit& u, int wr, int wc, int fr, int fq) const {
        const int row0 = u.pm * BM + wr * 64 + fr, col0 = u.pn * HALF + wc * 32 + 8 * fq;
#pragma unroll
        for (int ai = 0; ai < 2; ++ai)
#pragma unroll
            for (int m = 0; m < 4; ++m) { bf16_t* rowp = O + (size_t)(row0 + ai * HALF + m * 16) * ldc + col0;
                float o[8];
#pragma unroll
                for (int n = 0; n < 2; ++n)
#pragma unroll
                    for (int j = 0; j < 4; ++j) { const float g = acc[ai][0][m][n][j], up = acc[ai][1][m][n][j]; o[n * 4 + j] = g * fast_sigmoid(g) * up; }
                u32x4 w; w.x = cvt_pk_bf16(o[0], o[1]); w.y = cvt_pk_bf16(o[2], o[3]); w.z = cvt_pk_bf16(o[4], o[5]); w.w = cvt_pk_bf16(o[6], o[7]);
                *(u32x4*)rowp = w; }
    }
};
struct EpiResid {
    static constexpr bool PERM = false, AFTER_DRAIN = false;
    const float* base0; const float* base1; float* out; float alpha, beta;
    __device__ __forceinline__ void operator()(const f32x4 (&acc)[2][2][4][2], const Unit& u, int wr, int wc, int fr, int fq) const {
        const int row0 = u.pm * BM + wr * 64 + fr, col0 = u.pn * BM + wc * 32 + 4 * fq;
        const float* bp = (u.pm < 64) ? base0 : (base1 - (size_t)16384 * 1024);
#pragma unroll
        for (int ai = 0; ai < 2; ++ai)
#pragma unroll
            for (int m = 0; m < 4; ++m) { const size_t ro = (size_t)(row0 + ai * HALF + m * 16) * 1024 + col0;
#pragma unroll
                for (int bj = 0; bj < 2; ++bj)
#pragma unroll
                    for (int n = 0; n < 2; ++n) { const f32x4 b = *(const f32x4*)(bp + ro + bj * HALF + n * 16);
                        *(f32x4*)(out + ro + bj * HALF + n * 16) = b * alpha + acc[ai][bj][m][n] * beta; } }
    }
};
struct EpiMixIn {
    static constexpr bool PERM = true, AFTER_DRAIN = false;
    bf16_t *GQ, *GK, *GV, *GR, *SQ, *SKB, *SVB, *GA, *GB; float *okp, *oks, *ovp, *ovs;
    __device__ __forceinline__ void operator()(const f32x4 (&acc)[2][2][4][2], const Unit& u, int wr, int wc, int fr, int fq) const {
        const int pn = u.pn; bf16_t* dst; int ld, cb, act = 0; float sc = 1.f; float* fp = nullptr; float* fs = nullptr; bool bf_prompt_only = false;
        if (pn < 2) { dst = GQ; ld = 512; cb = pn * 256; sc = 0.08838834764831845f; }
        else if (pn < 4) { dst = GK; ld = 512; cb = (pn - 2) * 256; }
        else if (pn < 8) { dst = GV; ld = 1024; cb = (pn - 4) * 256; }
        else if (pn < 12) { dst = GR; ld = 1024; cb = (pn - 8) * 256; act = 1; }
        else if (pn < 16) { dst = SQ; ld = 1024; cb = (pn - 12) * 256; sc = 0.08838834764831845f * 1.4426950408889634f; }
        else if (pn < 20) { dst = SKB; ld = 1024; cb = (pn - 16) * 256; fp = okp; fs = oks; bf_prompt_only = true; }
        else if (pn < 24) { dst = SVB; ld = 1024; cb = (pn - 20) * 256; fp = ovp; fs = ovs; bf_prompt_only = true; }
        else if (pn < 28) { dst = GA; ld = 1024; cb = (pn - 24) * 256; act = 2; }
        else { dst = GB; ld = 1024; cb = (pn - 28) * 256; act = 2; }
        const int row0 = u.pm * BM + wr * 64 + fr, col0 = cb + wc * 32 + 8 * fq;
        const bool prompt = u.pm < 64;
        float* fbase = fp ? (prompt ? fp : fs - (size_t)16384 * 1024) : nullptr;
#pragma unroll
        for (int ai = 0; ai < 2; ++ai)
#pragma unroll
            for (int m = 0; m < 4; ++m) { const int row = row0 + ai * HALF + m * 16;
#pragma unroll
                for (int bj = 0; bj < 2; ++bj) { f32x4 v0 = acc[ai][bj][m][0], v1 = acc[ai][bj][m][1]; const int col = col0 + bj * HALF;
                    if (fbase) { *(f32x4*)(fbase + (size_t)row * 1024 + col) = v0; *(f32x4*)(fbase + (size_t)row * 1024 + col + 4) = v1; }
                    if (act == 1) {
#pragma unroll
                        for (int j = 0; j < 4; ++j) { v0[j] = v0[j] * fast_sigmoid(v0[j]); v1[j] = v1[j] * fast_sigmoid(v1[j]); } }
                    if (act == 2) {
#pragma unroll
                        for (int j = 0; j < 4; ++j) { v0[j] = fast_sigmoid(v0[j]); v1[j] = fast_sigmoid(v1[j]); } }
                    v0 = v0 * sc; v1 = v1 * sc;
                    if (!bf_prompt_only || prompt) { u32x4 w; w.x = cvt_pk_bf16(v0[0], v0[1]); w.y = cvt_pk_bf16(v0[2], v0[3]); w.z = cvt_pk_bf16(v1[0], v1[1]); w.w = cvt_pk_bf16(v1[2], v1[3]);
                        *(u32x4*)(dst + (size_t)row * ld + col) = w; } } }
    }
};
template <int SECOND> struct EpiBranch {
    static constexpr bool PERM = true, AFTER_DRAIN = false;
    const bf16_t* G; float* Tb; bf16_t* Mg;
    __device__ __forceinline__ void operator()(const f32x4 (&acc)[2][2][4][2], const Unit& u, int wr, int wc, int fr, int fq) const {
        const int row0 = u.pm * BM + wr * 64 + fr, col0 = u.pn * BM + wc * 32 + 8 * fq;
#pragma unroll
        for (int ai = 0; ai < 2; ++ai)
#pragma unroll
            for (int m = 0; m < 4; ++m) { const size_t ro = (size_t)(row0 + ai * HALF + m * 16) * 1024 + col0;
#pragma unroll
                for (int bj = 0; bj < 2; ++bj) { const u32x4 gw = *(const u32x4*)(G + ro + bj * HALF);
                    float g[8];
#pragma unroll
                    for (int j = 0; j < 4; ++j) { g[2 * j] = __uint_as_float(gw[j] << 16); g[2 * j + 1] = __uint_as_float(gw[j] & 0xffff0000u); }
                    f32x4 v0 = acc[ai][bj][m][0], v1 = acc[ai][bj][m][1];
#pragma unroll
                    for (int j = 0; j < 4; ++j) { v0[j] *= g[j]; v1[j] *= g[4 + j]; }
                    if (SECOND == 0) { *(f32x4*)(Tb + ro + bj * HALF) = v0; *(f32x4*)(Tb + ro + bj * HALF + 4) = v1; }
                    else { v0 = v0 + *(const f32x4*)(Tb + ro + bj * HALF); v1 = v1 + *(const f32x4*)(Tb + ro + bj * HALF + 4);
                        u32x4 w; w.x = cvt_pk_bf16(v0[0], v0[1]); w.y = cvt_pk_bf16(v0[2], v0[3]); w.z = cvt_pk_bf16(v1[0], v1[1]); w.w = cvt_pk_bf16(v1[2], v1[3]);
                        *(u32x4*)(Mg + ro + bj * HALF) = w; } } }
    }
};
template <class Epi, class Sched, bool ALIGN_EPI = false, bool SP2 = false>
__device__ __forceinline__ void gemm_phase(PG8_LAS unsigned char* lds, const Gemm g, const Sched& S, const Epi& E) {
    int tid_ = threadIdx.x; asm volatile("" : "+v"(tid_));
    const int tid = tid_, wid = __builtin_amdgcn_readfirstlane(tid >> 6), lane = tid & 63, wr = wid >> 2, wc = wid & 3, fr = lane & 15, fq = lane >> 4;
    const int K = g.K, nt = K / BK;
    unsigned voffA[2], voffB[2];
#pragma unroll
    for (int i = 0; i < 2; ++i) { int R, C; stage_rc(tid * 16 + i * 8192, R, C); const int Rb = Epi::PERM ? ((R & ~31) + perm32(R & 31)) : R;
        voffA[i] = (unsigned)(R * K + C) * 2u; voffB[i] = (unsigned)(Rb * K + C) * 2u; }
    const size_t kstep = (size_t)(BK * 2);
    const size_t hstep = (size_t)HALF * K * 2;
    const size_t tstep = 2 * hstep;
    const unsigned ldsw = (unsigned)wid * 1024u;
    const int aoff = lds_byte(wr * 64 + fr, fq * 8), boff = lds_byte(wc * 32 + fr, fq * 8);
#define PG8_SA(b, h) (((b) * 2 + (h)) * HTB)
#define PG8_SB(b, h) ((4 + (b) * 2 + (h)) * HTB)
#define PG8_STAGE(bufoff, gbase, voff) do { _Pragma("unroll") for (int _i = 0; _i < 2; ++_i) \
        __builtin_amdgcn_global_load_lds((const unsigned*)((const char*)(gbase) + (voff)[_i]), (PG8_LAS unsigned*)(lds + (bufoff) + ldsw + _i * 8192), 16, 0, 0); } while (0)
#define PG8_LDA(dst, b, h) do { _Pragma("unroll") for (int m = 0; m < 4; ++m) _Pragma("unroll") for (int k = 0; k < 2; ++k) dst[m][k] = *(const PG8_LAS bf16x8*)(lds + PG8_SA(b, h) + aoff + m * 2048 + k * 1024); } while (0)
#define PG8_LDB(dst, b, h) do { _Pragma("unroll") for (int n = 0; n < 2; ++n) _Pragma("unroll") for (int k = 0; k < 2; ++k) dst[n][k] = *(const PG8_LAS bf16x8*)(lds + PG8_SB(b, h) + boff + n * 2048 + k * 1024); } while (0)
#define PG8_MMA(ai, bj, At, Bt) do { __builtin_amdgcn_s_setprio(1); _Pragma("unroll") for (int m = 0; m < 4; ++m) _Pragma("unroll") for (int n = 0; n < 2; ++n) _Pragma("unroll") for (int k = 0; k < 2; ++k) \
        acc[ai][bj][m][n] = __builtin_amdgcn_mfma_f32_16x16x32_bf16(Bt[n][k], At[m][k], acc[ai][bj][m][n], 0, 0, 0); __builtin_amdgcn_s_setprio(0); } while (0)
#define PG8_WAIT_V(n) asm volatile("s_waitcnt vmcnt(" #n ")" ::: "memory")
#define PG8_WAIT_L(n) asm volatile("s_waitcnt lgkmcnt(" #n ")" ::: "memory")
#define PG8_BAR __builtin_amdgcn_s_barrier()
#define PG8_SCHED __builtin_amdgcn_sched_barrier(0)
    Unit cur, nxt; int ui = 0;
    if (!S.next(0, cur)) return;
    f32x4 acc[2][2][4][2];
#pragma unroll
    for (int a = 0; a < 2; ++a)
#pragma unroll
        for (int b = 0; b < 2; ++b)
#pragma unroll
            for (int m = 0; m < 4; ++m)
#pragma unroll
                for (int n = 0; n < 2; ++n) acc[a][b][m][n] = (f32x4){0.f, 0.f, 0.f, 0.f};
    bf16x8 At[4][2], B0[2][2], B1[2][2];
    const char* cA = (const char*)g.A + (size_t)cur.pm * tstep; const char* cB = (const char*)g.Bt + (size_t)cur.pn * tstep;
    S.a_ready(cur);
    if constexpr (SP2) {
        PG8_STAGE(PG8_SB(0, 0), cB, voffB); PG8_STAGE(PG8_SB(0, 1), cB + hstep, voffB); PG8_STAGE(PG8_SA(0, 0), cA, voffA); PG8_STAGE(PG8_SA(0, 1), cA + hstep, voffA);
        if (wr == 1) PG8_BAR;
        PG8_WAIT_V(2); PG8_BAR;
        PG8_STAGE(PG8_SB(1, 0), cB + kstep, voffB); PG8_STAGE(PG8_SA(1, 0), cA + kstep, voffA); PG8_STAGE(PG8_SB(1, 1), cB + hstep + kstep, voffB);
        PG8_WAIT_V(6); PG8_BAR;
    } else {
        PG8_STAGE(PG8_SB(0, 0), cB, voffB); PG8_STAGE(PG8_SA(0, 0), cA, voffA); PG8_STAGE(PG8_SB(0, 1), cB + hstep, voffB); PG8_STAGE(PG8_SA(0, 1), cA + hstep, voffA);
        if (wr == 1) PG8_BAR;
        PG8_WAIT_V(4); PG8_BAR;
        PG8_STAGE(PG8_SB(1, 0), cB + kstep, voffB); PG8_STAGE(PG8_SA(1, 0), cA + kstep, voffA); PG8_STAGE(PG8_SB(1, 1), cB + hstep + kstep, voffB);
        PG8_WAIT_V(6); PG8_BAR;
    }
    for (;;) {
        const bool has_next = S.next(ui + 1, nxt);
        const char* nA = has_next ? (const char*)g.A + (size_t)nxt.pm * tstep : cA; const char* nB = has_next ? (const char*)g.Bt + (size_t)nxt.pn * tstep : cB;
        for (int t = 0; t < nt; t += 2) {
            const bool last = (t == nt - 2);
            const char* a1 = cA + (size_t)(t + 1) * kstep;
            const char* a2 = last ? nA : cA + (size_t)(t + 2) * kstep; const char* b2 = last ? nB : cB + (size_t)(t + 2) * kstep;
            const char* a3 = a2 + kstep; const char* b3 = b2 + kstep;
            if (last && has_next) S.a_ready(nxt);
            if constexpr (SP2) {
            PG8_LDB(B0, 0, 0); PG8_LDB(B1, 0, 1); PG8_SCHED; PG8_LDA(At, 0, 0); PG8_STAGE(PG8_SA(1, 1), a1 + hstep, voffA);
            PG8_WAIT_V(8); PG8_WAIT_L(0); PG8_BAR; PG8_MMA(0, 0, At, B0); PG8_MMA(0, 1, At, B1); PG8_BAR; PG8_SCHED;
            PG8_LDA(At, 0, 1); PG8_STAGE(PG8_SB(0, 0), b2, voffB); PG8_STAGE(PG8_SB(0, 1), b2 + hstep, voffB); PG8_STAGE(PG8_SA(0, 0), a2, voffA);
            PG8_WAIT_V(8); PG8_WAIT_L(0); PG8_BAR; PG8_MMA(1, 0, At, B0); PG8_MMA(1, 1, At, B1); PG8_BAR; PG8_SCHED;
            PG8_LDB(B0, 1, 0); PG8_LDB(B1, 1, 1); PG8_SCHED; PG8_LDA(At, 1, 0); PG8_STAGE(PG8_SA(0, 1), a2 + hstep, voffA);
            PG8_WAIT_V(8); PG8_WAIT_L(0); PG8_BAR; PG8_MMA(0, 0, At, B0); PG8_MMA(0, 1, At, B1); PG8_BAR; PG8_SCHED;
            PG8_LDA(At, 1, 1); PG8_STAGE(PG8_SB(1, 0), b3, voffB); PG8_STAGE(PG8_SB(1, 1), b3 + hstep, voffB); PG8_STAGE(PG8_SA(1, 0), a3, voffA);
            PG8_WAIT_V(8); PG8_WAIT_L(0); PG8_BAR; PG8_MMA(1, 0, At, B0); PG8_MMA(1, 1, At, B1); PG8_BAR; PG8_SCHED;
            } else {
            PG8_LDB(B0, 0, 0); PG8_SCHED; PG8_LDA(At, 0, 0); PG8_STAGE(PG8_SA(1, 1), a1 + hstep, voffA);
            PG8_WAIT_L(8); PG8_BAR; PG8_WAIT_L(0); PG8_MMA(0, 0, At, B0); PG8_BAR; PG8_SCHED;
            PG8_LDB(B1, 0, 1); PG8_STAGE(PG8_SB(0, 0), b2, voffB);
            PG8_BAR; PG8_WAIT_L(0); PG8_MMA(0, 1, At, B1); PG8_BAR;
            PG8_LDA(At, 0, 1); PG8_STAGE(PG8_SA(0, 0), a2, voffA);
            PG8_BAR; PG8_WAIT_L(0); PG8_MMA(1, 0, At, B0); PG8_BAR; PG8_SCHED;
            PG8_STAGE(PG8_SB(0, 1), b2 + hstep, voffB);
            PG8_WAIT_V(6); PG8_BAR; PG8_MMA(1, 1, At, B1); PG8_BAR;
            PG8_LDB(B0, 1, 0); PG8_SCHED; PG8_LDA(At, 1, 0); PG8_STAGE(PG8_SA(0, 1), a2 + hstep, voffA);
            PG8_WAIT_L(8); PG8_BAR; PG8_WAIT_L(0); PG8_MMA(0, 0, At, B0); PG8_BAR; PG8_SCHED;
            PG8_LDB(B1, 1, 1); PG8_STAGE(PG8_SB(1, 0), b3, voffB);
            PG8_BAR; PG8_WAIT_L(0); PG8_MMA(0, 1, At, B1); PG8_BAR;
            PG8_LDA(At, 1, 1); PG8_STAGE(PG8_SA(1, 0), a3, voffA);
            PG8_BAR; PG8_WAIT_L(0); PG8_MMA(1, 0, At, B0); PG8_BAR; PG8_SCHED;
            PG8_STAGE(PG8_SB(1, 1), b3 + hstep, voffB);
            PG8_WAIT_V(6); PG8_BAR; PG8_MMA(1, 1, At, B1); PG8_BAR;
            }
        }
        if constexpr (ALIGN_EPI) { if (wr == 0) PG8_BAR; }
        if constexpr (!Epi::AFTER_DRAIN) { E(acc, cur, wr, wc, fr, fq); S.done(cur); }
        if (!has_next) break;
#pragma unroll
        for (int a = 0; a < 2; ++a)
#pragma unroll
            for (int b = 0; b < 2; ++b)
#pragma unroll
                for (int m = 0; m < 4; ++m)
#pragma unroll
                    for (int n = 0; n < 2; ++n) acc[a][b][m][n] = (f32x4){0.f, 0.f, 0.f, 0.f};
        cur = nxt; cA = nA; cB = nB; ++ui;
        if constexpr (ALIGN_EPI) { if (wr == 1) PG8_BAR; }
    }
    PG8_WAIT_V(0);
    if constexpr (!ALIGN_EPI) { if (wr == 0) PG8_BAR; }
    PG8_BAR;
    if constexpr (Epi::AFTER_DRAIN) { E.fused(acc, cur, wr, wc, fr, fq, lds, wid, lane); S.done(cur); }
#undef PG8_SA
#undef PG8_SB
#undef PG8_STAGE
#undef PG8_LDA
#undef PG8_LDB
#undef PG8_MMA
#undef PG8_WAIT_V
#undef PG8_WAIT_L
#undef PG8_BAR
#undef PG8_SCHED
}
}
constexpr int NWAVES = 8;
constexpr int DM = 1024, MP = 16384, MS = 2048, MT = MP + MS, DFF = 2816, NIN = 8192, TSEQ = 8192, NCHP = 128  ;
constexpr float LN_EPS = 1e-5f;
constexpr float DN_ALPHA = 1.189207115002721f;
constexpr float LOG2E = 1.4426950408889634f;
constexpr size_t O_Y = 0, O_SGP = 18874368, O_KP = 19136512, O_VP = 35913728, O_SGS = 52690944, O_KS = 56885248, O_VS = 58982400, O_END = 61079552;
constexpr size_t MiB = 1u << 20;
constexpr size_t WS_CTL = 0, CTL_ZERO_BYTES = 1 * MiB;
constexpr size_t WS_W1IN = 2 * MiB, WS_W1OUT = 13 * MiB, WS_WIN = 19 * MiB, WS_WGLAO = 35 * MiB, WS_WSBO = 37 * MiB, WS_WOUT = 39 * MiB, WS_W2IN = 41 * MiB, WS_W2OUT = 52 * MiB;
constexpr size_t WS_XB = 64 * MiB, WS_HB = 100 * MiB, WS_ACT = 136 * MiB, WS_R = 236 * MiB, WS_H = 308 * MiB;
constexpr size_t WS_GQ = 380 * MiB, WS_GK = 398 * MiB, WS_GV = 416 * MiB, WS_GR = 452 * MiB, WS_SQ = 488 * MiB, WS_SKB = 524 * MiB, WS_SVB = 556 * MiB, WS_GA = 588 * MiB, WS_GB = 624 * MiB;
constexpr size_t WS_B2 = 660 * MiB, WS_DS = 696 * MiB, WS_STS = 824 * MiB, WS_OA = 888 * MiB, WS_OB = 924 * MiB, WS_MG = 960 * MiB, WS_END = 996 * MiB;
constexpr int CW_TMO = 0, CW_BAR = 4096;
constexpr int RING_OFF = 0, RING_BYTES = 131072;
constexpr int LDS_BYTES = 147456;
constexpr int MISC_OFF = LDS_BYTES - 256;
#define GAS __attribute__((address_space(1)))
#define LAS __attribute__((address_space(3)))
typedef unsigned short bf16;
typedef unsigned v4u __attribute__((ext_vector_type(4)));
typedef float f32x4 __attribute__((ext_vector_type(4)));
typedef short bf16x8 __attribute__((ext_vector_type(8)));
typedef GAS unsigned gu32;
typedef GAS unsigned long long gu64;
#define RLX_AGENT __ATOMIC_RELAXED, __HIP_MEMORY_SCOPE_AGENT
#define LDS_WAIT() asm volatile("s_waitcnt lgkmcnt(0)" ::: "memory")
#define VM_WAIT() asm volatile("s_waitcnt vmcnt(0)" ::: "memory")
__device__ __forceinline__ unsigned long long rt() { return __builtin_amdgcn_s_memrealtime(); }
__device__ __forceinline__ unsigned f2bf(float f) { unsigned u = __builtin_bit_cast(unsigned, f); return (u + 0x7fffu + ((u >> 16) & 1u)) >> 16; }
__device__ __forceinline__ unsigned pk2(float lo, float hi) { return f2bf(lo) | (f2bf(hi) << 16); }

#define XB_TMO      128
#define XB_XCNT(j)  (256  + 64 * (j))
#define XB_XSUB(j)  (1280 + 64 * (j))
#define XB_XGEN(j)  (2304 + 64 * (j))
#define XB_TOP      3328
#define XB_TOPGEN   3392
#define XCD_BAR_WORDS 3456
#define XB_SPIN_CAP (1u << 18)

__device__ __forceinline__ unsigned xb_ld(unsigned* p)              { return __hip_atomic_load(p, __ATOMIC_RELAXED, __HIP_MEMORY_SCOPE_AGENT); }
__device__ __forceinline__ unsigned xb_add(unsigned* p, unsigned v) { return __hip_atomic_fetch_add(p, v, __ATOMIC_RELAXED, __HIP_MEMORY_SCOPE_AGENT); }
__device__ __forceinline__ unsigned xb_xcc_id() { return (unsigned)__builtin_amdgcn_s_getreg((3 << 11) | 20) & 0xFu; }
#define XB_SPIN(cond, bar) do { unsigned _sp = 0; while (cond) { __builtin_amdgcn_s_sleep(1); \
    if ((++_sp & 255u) == 0u) { if (xb_ld(&(bar)[XB_TMO])) break; if (_sp > XB_SPIN_CAP) { atomicAdd(&(bar)[XB_TMO], 1u); break; } } } } while (0)

struct XcdBarrier {
    unsigned* bar; unsigned x;
    volatile LAS unsigned* st;
};

__device__ __forceinline__ XcdBarrier xcd_barrier_post(unsigned* bar, volatile LAS unsigned* st) {
    XcdBarrier b; b.bar = bar; b.x = xb_xcc_id(); b.st = st;
    if (threadIdx.x == 0) (void)xb_add(&bar[XB_XCNT(b.x)], 1u);
    return b;
}
__device__ __forceinline__ void xcd_barrier_complete(unsigned* bar, unsigned x, unsigned& nloc, unsigned& nx) {
    const unsigned G = gridDim.x * gridDim.y * gridDim.z;
    unsigned sum, cnt, mine, sp = 0u;
    for (;;) {
        sum = 0u; cnt = 0u; mine = 0u;
#pragma unroll
        for (unsigned j = 0; j < 16; ++j) { const unsigned c = xb_ld(&bar[XB_XCNT(j)]); sum += c; cnt += (c > 0u) ? 1u : 0u; mine = (j == x) ? c : mine; }
        if (sum == G) break;
        __builtin_amdgcn_s_sleep(1);
        if ((++sp & 255u) == 0u) { if (xb_ld(&bar[XB_TMO])) break; if (sp > XB_SPIN_CAP) { atomicAdd(&bar[XB_TMO], 1u); break; } }
    }
    nloc = mine > 0u ? mine : 1u; nx = cnt > 0u ? cnt : 1u;
}

__device__ __forceinline__ void xcd_barrier(const XcdBarrier& b) {
    asm volatile("s_waitcnt vmcnt(0)" ::: "memory");
    __syncthreads();
    if (threadIdx.x == 0) {
        unsigned* bar = b.bar;
        __builtin_amdgcn_s_waitcnt(0);
        unsigned nloc = b.st[0], nx = b.st[1];
        if (nloc == 0u) { xcd_barrier_complete(bar, b.x, nloc, nx); b.st[0] = nloc; b.st[1] = nx; }
        const unsigned old = xb_add(&bar[XB_XSUB(b.x)], 1u);
        const unsigned gen = old / nloc;
        if (old + 1u == (gen + 1u) * nloc) {
            __builtin_amdgcn_fence(__ATOMIC_RELEASE, "agent");
            asm volatile("s_waitcnt vmcnt(0)" ::: "memory");
            const unsigned og = xb_add(&bar[XB_TOP], 1u);
            const unsigned tg = og / nx;
            if (og + 1u == (tg + 1u) * nx) xb_add(&bar[XB_TOPGEN], 1u);
            else XB_SPIN(xb_ld(&bar[XB_TOPGEN]) == tg, bar);
            __builtin_amdgcn_fence(__ATOMIC_ACQUIRE, "agent");
            xb_add(&bar[XB_XGEN(b.x)], 1u);
            asm volatile("s_waitcnt vmcnt(0)" ::: "memory");
        } else {
            XB_SPIN(xb_ld(&bar[XB_XGEN(b.x)]) == gen, bar);
            __builtin_amdgcn_fence(__ATOMIC_ACQUIRE, "agent");
            asm volatile("s_waitcnt vmcnt(0)" ::: "memory");
        }
    }
    __syncthreads();
}
typedef float f32x16 __attribute__((ext_vector_type(16)));
typedef short s16x4 __attribute__((ext_vector_type(4)));
typedef unsigned u32x2 __attribute__((ext_vector_type(2)));
typedef unsigned u32x4 __attribute__((ext_vector_type(4)));
__device__ __forceinline__ float wave_sum(float v) {
#pragma unroll
    for (int o = 1; o < 64; o <<= 1) v += __shfl_xor(v, o);
    return v;
}
__device__ __forceinline__ float bf_lo(unsigned w) { return __uint_as_float(w << 16); }
__device__ __forceinline__ float bf_hi(unsigned w) { return __uint_as_float(w & 0xffff0000u); }
__device__ __forceinline__ unsigned cvtpk(float lo, float hi) { unsigned r; asm volatile("v_cvt_pk_bf16_f32 %0, %1, %2" : "=v"(r) : "v"(lo), "v"(hi)); return r; }
__device__ __forceinline__ int crow(int r, int hi) { return (r & 3) + 8 * (r >> 2) + 4 * hi; }
__device__ __forceinline__ void p0_transpose_item(const float* W, int ldw, int col0, bf16* WT, int K, int row0, int k0, LAS float* scr, int lane) {
#pragma unroll 8
    for (int i = 0; i < 32; ++i) { const int kk = 2 * i + (lane >> 5); scr[kk * 33 + (lane & 31)] = W[(size_t)(k0 + kk) * ldw + col0 + (lane & 31)]; }
    LDS_WAIT(); asm volatile("" ::: "memory");
    const int c = lane & 7;
#pragma unroll
    for (int j = 0; j < 4; ++j) { const int n = (lane >> 3) + 8 * j; const LAS float* s = scr + (8 * c) * 33 + n;
        v4u o; o.x = pk2(s[0 * 33], s[1 * 33]); o.y = pk2(s[2 * 33], s[3 * 33]); o.z = pk2(s[4 * 33], s[5 * 33]); o.w = pk2(s[6 * 33], s[7 * 33]);
        *(GAS v4u*)(WT + (size_t)(row0 + n) * K + k0 + 8 * c) = o; }
    LDS_WAIT(); asm volatile("" ::: "memory");
}
template <int MODE> __device__ __forceinline__ void p0_weight(const float* W, int ldw, int K, int NOUT, bf16* WT, LAS float* scr, int lane, int gw, int NGW, int& itbase) {
    const int nblk = NOUT / 32, nitems = (K / 64) * nblk;
    int it = gw - (itbase % NGW); if (it < 0) it += NGW;
    for (; it < nitems; it += NGW) { const int kb = it / nblk, nb = it % nblk, n0 = 32 * nb; int c0 = n0;
        if (MODE == 1) { const int pn = n0 >> 8, s = (n0 >> 7) & 1, i = n0 & 127; c0 = s * DFF + 128 * pn + i; }
        if (MODE == 2) { c0 = n0 < 3072 ? n0 : n0 + 16; }
        p0_transpose_item(W, ldw, c0, WT, K, n0, 64 * kb, scr, lane); }
    itbase += nitems;
}
__device__ __forceinline__ void row_to_bf16(const float* xrow, bf16* orow, int lane) {
    const GAS f32x4* xr = (const GAS f32x4*)xrow + lane; GAS unsigned long long* o8 = (GAS unsigned long long*)orow + lane;
#pragma unroll
    for (int j = 0; j < 4; ++j) { const f32x4 v = xr[64 * j]; o8[64 * j] = (unsigned long long)pk2(v.x, v.y) | ((unsigned long long)pk2(v.z, v.w) << 32); }
}
__device__ __forceinline__ void ln_row(f32x4 (&v)[4], const f32x4 (&g)[4], const f32x4 (&b)[4]) {
    float s = 0.f;
#pragma unroll
    for (int j = 0; j < 4; ++j) s += (v[j].x + v[j].y) + (v[j].z + v[j].w);
    const float mean = wave_sum(s) * (1.f / DM); float s2 = 0.f;
#pragma unroll
    for (int j = 0; j < 4; ++j) { v[j] = v[j] - mean; s2 += (v[j].x * v[j].x + v[j].y * v[j].y) + (v[j].z * v[j].z + v[j].w * v[j].w); }
    const float rstd = 1.f / sqrtf(wave_sum(s2) * (1.f / DM) + LN_EPS);
#pragma unroll
    for (int j = 0; j < 4; ++j) v[j] = v[j] * rstd * g[j] + b[j];
}
__device__ __forceinline__ void ln1_gate_phase(LAS unsigned char* lds, const float* R, float* H, bf16* HB, float* B2, const float* g_ln, const float* b_ln,
                                               const float* w_in, const float* w_up, const float* b_gate, int vcu, int G, int tid, int lane, int wave) {
    LAS float* WlrT = (LAS float*)lds;
    LAS float* Wup = (LAS float*)(lds + 65536);
    LAS float* tot = (LAS float*)(lds + 98304);
    for (int e = tid; e < 16384; e += 512) { const int k = e >> 4, i = e & 15; WlrT[i * 1024 + k] = w_in[(size_t)k * 8208 + 3072 + i]; }
    for (int e = tid; e < 8192; e += 512) Wup[e] = w_up[e];
    f32x4 g[4], b[4];
#pragma unroll
    for (int j = 0; j < 4; ++j) { g[j] = ((const GAS f32x4*)g_ln)[64 * j + lane]; b[j] = ((const GAS f32x4*)b_ln)[64 * j + lane]; }
    const f32x4 bias0 = ((const GAS f32x4*)b_gate)[2 * lane], bias1 = ((const GAS f32x4*)b_gate)[2 * lane + 1];
    LDS_WAIT(); __syncthreads();
    for (int ch = vcu; ch < MT / 64; ch += G) {
        f32x4 cum0 = {0.f, 0.f, 0.f, 0.f}, cum1 = {0.f, 0.f, 0.f, 0.f};
#pragma unroll 1
        for (int r = 0; r < 8; ++r) {
            const size_t row = (size_t)ch * 64 + wave * 8 + r;
            f32x4 v[4];
#pragma unroll
            for (int j = 0; j < 4; ++j) v[j] = ((const GAS f32x4*)(R + row * DM))[64 * j + lane];
            ln_row(v, g, b);
#pragma unroll
            for (int j = 0; j < 4; ++j) { ((GAS f32x4*)(H + row * DM))[64 * j + lane] = v[j];
                ((GAS unsigned long long*)(HB + row * DM))[64 * j + lane] = (unsigned long long)pk2(v[j].x, v[j].y) | ((unsigned long long)pk2(v[j].z, v[j].w) << 32); }
            f32x4 z0 = bias0, z1 = bias1;
#pragma unroll 4
            for (int i = 0; i < 16; ++i) { float s = 0.f;
#pragma unroll
                for (int j = 0; j < 4; ++j) { const f32x4 w = *(const LAS f32x4*)(WlrT + i * 1024 + 256 * j + 4 * lane); s += (v[j].x * w.x + v[j].y * w.y) + (v[j].z * w.z + v[j].w * w.w); }
                const float gi = wave_sum(s);
                const f32x4 u0 = *(const LAS f32x4*)(Wup + i * 512 + 8 * lane), u1 = *(const LAS f32x4*)(Wup + i * 512 + 8 * lane + 4);
                z0 = z0 + u0 * gi; z1 = z1 + u1 * gi; }
#pragma unroll
            for (int j = 0; j < 4; ++j) { { const float y = z0[j] * LOG2E, t = fabsf(y); const float l = __builtin_amdgcn_logf(1.0f + __builtin_amdgcn_exp2f(-t)) + fmaxf(-y, 0.f); cum0[j] -= l * 0.0625f; }
                                           { const float y = z1[j] * LOG2E, t = fabsf(y); const float l = __builtin_amdgcn_logf(1.0f + __builtin_amdgcn_exp2f(-t)) + fmaxf(-y, 0.f); cum1[j] -= l * 0.0625f; } }
            GAS f32x4* o = (GAS f32x4*)(B2 + row * 512 + 8 * lane); o[0] = cum0; o[1] = cum1;
        }
        *(LAS f32x4*)(tot + wave * 512 + 8 * lane) = cum0; *(LAS f32x4*)(tot + wave * 512 + 8 * lane + 4) = cum1;
        LDS_WAIT(); __syncthreads();
        if (wave > 0) {
            f32x4 off0 = {0.f, 0.f, 0.f, 0.f}, off1 = {0.f, 0.f, 0.f, 0.f};
            for (int w2 = 0; w2 < wave; ++w2) { off0 = off0 + *(const LAS f32x4*)(tot + w2 * 512 + 8 * lane); off1 = off1 + *(const LAS f32x4*)(tot + w2 * 512 + 8 * lane + 4); }
#pragma unroll
            for (int r = 0; r < 8; ++r) { const size_t row = (size_t)ch * 64 + wave * 8 + r; GAS f32x4* o = (GAS f32x4*)(B2 + row * 512 + 8 * lane); const f32x4 t0 = o[0], t1 = o[1]; o[0] = t0 + off0; o[1] = t1 + off1; }
        }
        LDS_WAIT(); __syncthreads();
    }
}
template <int FINAL> __device__ __forceinline__ void ln_phase(const float* R, float* H, bf16* HB, const float* g_ln, const float* b_ln, int gw, int NGW, int lane) {
    f32x4 g[4], b[4];
#pragma unroll
    for (int j = 0; j < 4; ++j) { g[j] = ((const GAS f32x4*)g_ln)[64 * j + lane]; b[j] = ((const GAS f32x4*)b_ln)[64 * j + lane]; }
    for (int row = gw; row < MT; row += NGW) {
        f32x4 v[4];
#pragma unroll
        for (int j = 0; j < 4; ++j) v[j] = ((const GAS f32x4*)(R + (size_t)row * DM))[64 * j + lane];
        ln_row(v, g, b);
#pragma unroll
        for (int j = 0; j < 4; ++j) { ((GAS f32x4*)(H + (size_t)row * DM))[64 * j + lane] = v[j];
            if (!FINAL) ((GAS unsigned long long*)(HB + (size_t)row * DM))[64 * j + lane] = (unsigned long long)pk2(v[j].x, v[j].y) | ((unsigned long long)pk2(v[j].z, v[j].w) << 32); }
    }
}
constexpr int QT_OFF = 0, QT_S = 272, KT_OFF = 17408, KT_S = 272, PT_OFF = KT_OFF, PT_S = 144, RED_OFF = KT_OFF + 9216, VT_OFF = 34816, VT_S = 576, ST_OFF = 71680, ST_S = 576, KD_OFF = 0, KD_S = 320;
static_assert(ST_OFF + 128 * ST_S <= MISC_OFF, "GLA LDS map");
typedef short v4i16_t __attribute__((ext_vector_type(4)));
#define MFMA32(a, b, c) __builtin_amdgcn_mfma_f32_32x32x16_bf16((a), (b), (c), 0, 0, 0)
__device__ __forceinline__ bf16x8 frag_row(const LAS unsigned char* base, int S, int row, int kcol) { return *(const LAS bf16x8*)(base + row * S + kcol * 2); }
__device__ __forceinline__ s16x4 tr4(const LAS unsigned char* p) { return __builtin_bit_cast(s16x4, __builtin_amdgcn_ds_read_tr16_b64_v4i16((LAS v4i16_t*)p)); }
__device__ __forceinline__ bf16x8 frag_tr(const LAS unsigned char* base, int S, int k0, int c0, int lane) {
    const int hi = lane >> 5, blk = (lane >> 4) & 1, q = (lane & 15) >> 2, p = lane & 3;
    const LAS unsigned char* a = base + (k0 + 8 * hi + q) * S + (c0 + 16 * blk + 4 * p) * 2;
    const s16x4 lo = tr4(a), h4 = tr4(a + 4 * S);
    return (bf16x8){lo[0], lo[1], lo[2], lo[3], h4[0], h4[1], h4[2], h4[3]};
}
__device__ __forceinline__ void gla_stage_v(LAS unsigned char* lds, const bf16* GV, int m0, int h, int tid) {
    const int row = tid >> 3, cs = tid & 7;
    const GAS u32x4* src = (const GAS u32x4*)(GV + (size_t)(m0 + row) * 1024 + h * 256 + 32 * cs);
    LAS u32x4* dst = (LAS u32x4*)(lds + VT_OFF + row * VT_S + 64 * cs);
#pragma unroll
    for (int i = 0; i < 4; ++i) dst[i] = src[i];
}
template <int MODE> __device__ __forceinline__ void gla_stage_qk(LAS unsigned char* lds, const bf16* GQ, const bf16* GK, const float* B2, int m0, int h, int tid) {
    const int row = tid >> 3, cs = tid & 7; const size_t go = (size_t)(m0 + row) * 512 + h * 128 + 16 * cs;
    const GAS u32x4* kp = (const GAS u32x4*)(GK + go); const GAS f32x4* bp = (const GAS f32x4*)(B2 + go);
    const u32x4 k0 = kp[0], k1 = kp[1]; const unsigned kw[8] = {k0[0], k0[1], k0[2], k0[3], k1[0], k1[1], k1[2], k1[3]};
    float bb[16];
#pragma unroll
    for (int i = 0; i < 4; ++i) { const f32x4 t = bp[i]; bb[4 * i] = t.x; bb[4 * i + 1] = t.y; bb[4 * i + 2] = t.z; bb[4 * i + 3] = t.w; }
    if (MODE == 0) {
        const GAS u32x4* qp = (const GAS u32x4*)(GQ + go); const u32x4 q0 = qp[0], q1 = qp[1]; const unsigned qw[8] = {q0[0], q0[1], q0[2], q0[3], q1[0], q1[1], q1[2], q1[3]};
        unsigned oq[8], ok[8];
#pragma unroll
        for (int i = 0; i < 8; ++i) { const float e0 = __builtin_amdgcn_exp2f(bb[2 * i]), e1 = __builtin_amdgcn_exp2f(bb[2 * i + 1]), f0 = __builtin_amdgcn_exp2f(-bb[2 * i]), f1 = __builtin_amdgcn_exp2f(-bb[2 * i + 1]);
            oq[i] = cvtpk(bf_lo(qw[i]) * e0, bf_hi(qw[i]) * e1); ok[i] = cvtpk(bf_lo(kw[i]) * f0, bf_hi(kw[i]) * f1); }
        LAS u32x4* dq = (LAS u32x4*)(lds + QT_OFF + row * QT_S + 32 * cs); LAS u32x4* dk = (LAS u32x4*)(lds + KT_OFF + row * KT_S + 32 * cs);
        dq[0] = (u32x4){oq[0], oq[1], oq[2], oq[3]}; dq[1] = (u32x4){oq[4], oq[5], oq[6], oq[7]};
        dk[0] = (u32x4){ok[0], ok[1], ok[2], ok[3]}; dk[1] = (u32x4){ok[4], ok[5], ok[6], ok[7]};
    } else {
        const GAS f32x4* lp = (const GAS f32x4*)(B2 + (size_t)(m0 + 63) * 512 + h * 128 + 16 * cs);
        float bl[16];
#pragma unroll
        for (int i = 0; i < 4; ++i) { const f32x4 t = lp[i]; bl[4 * i] = t.x; bl[4 * i + 1] = t.y; bl[4 * i + 2] = t.z; bl[4 * i + 3] = t.w; }
        unsigned ok[8];
#pragma unroll
        for (int i = 0; i < 8; ++i) ok[i] = cvtpk(bf_lo(kw[i]) * __builtin_amdgcn_exp2f(bl[2 * i] - bb[2 * i]), bf_hi(kw[i]) * __builtin_amdgcn_exp2f(bl[2 * i + 1] - bb[2 * i + 1]));
        LAS u32x4* dk = (LAS u32x4*)(lds + KD_OFF + row * KD_S + 32 * cs);
        dk[0] = (u32x4){ok[0], ok[1], ok[2], ok[3]}; dk[1] = (u32x4){ok[4], ok[5], ok[6], ok[7]};
    }
}
template <bool F32SRC> __device__ __forceinline__ void gla_stage_s(LAS unsigned char* lds, const void* src, int tid) {
    const int row = tid >> 2, cs = tid & 3; LAS u32x4* dst = (LAS u32x4*)(lds + ST_OFF + row * ST_S + 128 * cs);
    if (F32SRC) { const GAS f32x4* sp = (const GAS f32x4*)((const float*)src + row * 256 + 64 * cs);
#pragma unroll 2
        for (int i = 0; i < 8; ++i) { const f32x4 a = sp[2 * i], b = sp[2 * i + 1]; dst[i] = (u32x4){cvtpk(a.x, a.y), cvtpk(a.z, a.w), cvtpk(b.x, b.y), cvtpk(b.z, b.w)}; }
    } else { const GAS u32x4* sp = (const GAS u32x4*)((const bf16*)src + row * 256 + 64 * cs);
#pragma unroll
        for (int i = 0; i < 8; ++i) dst[i] = sp[i]; }
}
template <bool F32SRC> __device__ __forceinline__ void gla_o_unit(LAS unsigned char* lds, int m0, int h, const bf16* GQ, const bf16* GK, const bf16* GV, const bf16* GR, const float* B2,
                                                                  const void* Ssrc, const float* gnorm, bf16* OA, int tid, int lane, int wave) {
    asm volatile("" : "+v"(tid)); lane = tid & 63; wave = __builtin_amdgcn_readfirstlane(tid >> 6);
    gla_stage_qk<0>(lds, GQ, GK, B2, m0, h, tid); gla_stage_v(lds, GV, m0, h, tid); gla_stage_s<F32SRC>(lds, Ssrc, tid);
    LDS_WAIT(); __syncthreads();
    const int tb = wave & 1, dsl = wave >> 1, r32 = lane & 31, hi = lane >> 5;
    f32x16 att = {0.f, 0.f, 0.f, 0.f, 0.f, 0.f, 0.f, 0.f, 0.f, 0.f, 0.f, 0.f, 0.f, 0.f, 0.f, 0.f};
    const int sb = wave >> 1; const bool do_att = (wave < 4) && (sb <= tb);
    if (do_att) {
#pragma unroll 2
        for (int ks = 0; ks < 8; ++ks) { const bf16x8 a = frag_row(lds + QT_OFF, QT_S, 32 * tb + r32, 16 * ks + 8 * hi), b = frag_row(lds + KT_OFF, KT_S, 32 * sb + r32, 16 * ks + 8 * hi); att = MFMA32(a, b, att); }
    }
    LDS_WAIT(); __syncthreads();
    if (do_att) {
#pragma unroll
        for (int r = 0; r < 16; ++r) { const int t = 32 * tb + crow(r, hi), s = 32 * sb + r32; const float val = (s <= t) ? att[r] : 0.f;
            *(LAS unsigned short*)(lds + PT_OFF + t * PT_S + s * 2) = (unsigned short)(cvtpk(val, val) & 0xffffu); }
    }
    LDS_WAIT(); __syncthreads();
    f32x16 o0 = att, o1 = att;
#pragma unroll
    for (int r = 0; r < 16; ++r) { o0[r] = 0.f; o1[r] = 0.f; }
#pragma unroll 1
    for (int ks = 0; ks < 2 * (tb + 1); ++ks) { const bf16x8 a = frag_row(lds + PT_OFF, PT_S, 32 * tb + r32, 16 * ks + 8 * hi);
        const bf16x8 b0 = frag_tr(lds + VT_OFF, VT_S, 16 * ks, 64 * dsl, lane), b1 = frag_tr(lds + VT_OFF, VT_S, 16 * ks, 64 * dsl + 32, lane);
        o0 = MFMA32(a, b0, o0); o1 = MFMA32(a, b1, o1); }
#pragma unroll 2
    for (int ks = 0; ks < 8; ++ks) { const bf16x8 a = frag_row(lds + QT_OFF, QT_S, 32 * tb + r32, 16 * ks + 8 * hi);
        const bf16x8 b0 = frag_tr(lds + ST_OFF, ST_S, 16 * ks, 64 * dsl, lane), b1 = frag_tr(lds + ST_OFF, ST_S, 16 * ks, 64 * dsl + 32, lane);
        o0 = MFMA32(a, b0, o0); o1 = MFMA32(a, b1, o1); }
    LAS float* red = (LAS float*)(lds + RED_OFF);
#pragma unroll
    for (int r = 0; r < 16; ++r) { float ss = o0[r] * o0[r] + o1[r] * o1[r];
#pragma unroll
        for (int off = 1; off < 32; off <<= 1) ss += __shfl_xor(ss, off);
        if (r32 == 0) red[(32 * tb + crow(r, hi)) * 4 + dsl] = ss; }
    LDS_WAIT(); __syncthreads();
    const int dv0 = h * 256 + 64 * dsl + r32; const float gn0 = gnorm[dv0], gn1 = gnorm[dv0 + 32];
#pragma unroll
    for (int r = 0; r < 16; ++r) { const int t = 32 * tb + crow(r, hi); const f32x4 p = *(const LAS f32x4*)(red + t * 4);
        const float rstd = 1.0f / sqrtf(((p.x + p.y) + (p.z + p.w)) * (1.0f / 256.0f) + LN_EPS); const size_t ro = (size_t)(m0 + t) * 1024 + dv0;
        const float g0 = __uint_as_float((unsigned)GR[ro] << 16), g1 = __uint_as_float((unsigned)GR[ro + 32] << 16);
        OA[ro] = (bf16)(cvtpk(o0[r] * rstd * gn0 * g0, 0.f) & 0xffffu); OA[ro + 32] = (bf16)(cvtpk(o1[r] * rstd * gn1 * g1, 0.f) & 0xffffu); }
}
template <bool SAMPLE, bool VSTAGED> __device__ __forceinline__ void gla_ds_unit(LAS unsigned char* lds, int m0, int h, const bf16* GK, const bf16* GV, const float* B2, float* dst, const float* S0,
                                                                               int tid, int lane, int wave) {
    asm volatile("" : "+v"(tid)); lane = tid & 63; wave = __builtin_amdgcn_readfirstlane(tid >> 6);
    gla_stage_qk<1>(lds, nullptr, GK, B2, m0, h, tid); if (!VSTAGED) gla_stage_v(lds, GV, m0, h, tid);
    LDS_WAIT(); __syncthreads();
    const int ib = wave & 3, cb0 = 4 * (wave >> 2), r32 = lane & 31, hi = lane >> 5;
    f32x16 acc[4];
#pragma unroll
    for (int j = 0; j < 4; ++j)
#pragma unroll
        for (int r = 0; r < 16; ++r) acc[j][r] = 0.f;
#pragma unroll 1
    for (int ks = 0; ks < 4; ++ks) { const bf16x8 a = frag_tr(lds + KD_OFF, KD_S, 16 * ks, 32 * ib, lane);
#pragma unroll
        for (int j = 0; j < 4; ++j) { const bf16x8 b = frag_tr(lds + VT_OFF, VT_S, 16 * ks, 32 * (cb0 + j), lane); acc[j] = MFMA32(a, b, acc[j]); } }
#pragma unroll
    for (int r = 0; r < 16; ++r) { const int dk = 32 * ib + crow(r, hi);
        float dec = 0.f; if (SAMPLE) dec = __builtin_amdgcn_exp2f(((const GAS float*)B2)[(size_t)(m0 + 63) * 512 + h * 128 + dk]);
#pragma unroll
        for (int j = 0; j < 4; ++j) { const int e = dk * 256 + 32 * (cb0 + j) + r32; ((GAS float*)dst)[e] = SAMPLE ? dec * ((const GAS float*)S0)[e] + acc[j][r] : acc[j][r]; }
        if (SAMPLE && (r & 1)) asm volatile("" ::: "memory"); }
}
__device__ __forceinline__ void gla_scan_phase(const float* DS, bf16* STS, const float* B2, float* out_state, int vcu, int G, int tid) {
    for (int item = vcu * 512 + tid; item < 131072; item += G * 512) {
        const int bh = item >> 14, e2 = item & 16383, dk = e2 >> 7, dv = (e2 & 127) * 2, b = bh >> 2, h = bh & 3;
        const float* ds = DS + (size_t)bh * 128 * 32768 + dk * 256 + dv; bf16* st = STS + (size_t)bh * 128 * 32768 + dk * 256 + dv;
        const float* bl = B2 + ((size_t)b * TSEQ + 63) * 512 + h * 128 + dk;
        float s0 = 0.f, s1 = 0.f;
#pragma unroll 8
        for (int c = 0; c < NCHP; ++c) { *(unsigned*)(st + (size_t)c * 32768) = cvtpk(s0, s1);
            const float d0 = ds[(size_t)c * 32768], d1 = ds[(size_t)c * 32768 + 1], dec = __builtin_amdgcn_exp2f(bl[(size_t)c * 64 * 512]);
            s0 = dec * s0 + d0; s1 = dec * s1 + d1; }
        out_state[(size_t)bh * 32768 + dk * 256 + dv] = s0; out_state[(size_t)bh * 32768 + dk * 256 + dv + 1] = s1;
    }
}
constexpr int SB_V_OFF = 0, SB_K_OFF = 32768, SB_FLAG_OFF = 65536, SB_TILE = 16384;
constexpr float SB_DONE_THR = -140.0f;
#define KSWZ(row, colB) ((row) * 256 + ((colB) ^ (((row) & 7) << 4)))
#define SBAR() __builtin_amdgcn_sched_barrier(0)
__device__ __forceinline__ int v_st(int k, int c) { const int kk = (k & ~0xC) | ((k & 4) << 1) | ((k & 8) >> 1); return ((kk >> 3) * 4 + (c >> 5)) * 512 + ((kk & 7) * 32 + (c & 31)) * 2; }
__device__ __forceinline__ int v_rd_base(int lane) { return ((lane & 3) << 3) | (((lane >> 2) & 3) << 6) | (((lane >> 4) & 1) << 5) | (((lane >> 5) & 1) << 8); }
constexpr int v_rd_off(int d0, int ks, int half) { return d0 * 512 + ks * 4096 + half * 2048; }
template <int OFF> __device__ __forceinline__ s16x4 tr_read(int vb) { s16x4 r; asm volatile("ds_read_b64_tr_b16 %0, %1 offset:%2" : "=&v"(r) : "v"(vb), "i"(OFF) : "memory"); return r; }
template <int D0> __device__ __forceinline__ void pv_one(f32x16& od, int vb, bf16x8 pa0, bf16x8 pa1, bf16x8 pa2, bf16x8 pa3) {
    const s16x4 l0 = tr_read<v_rd_off(D0, 0, 0)>(vb), h0 = tr_read<v_rd_off(D0, 0, 1)>(vb), l1 = tr_read<v_rd_off(D0, 1, 0)>(vb), h1 = tr_read<v_rd_off(D0, 1, 1)>(vb);
    const s16x4 l2 = tr_read<v_rd_off(D0, 2, 0)>(vb), h2 = tr_read<v_rd_off(D0, 2, 1)>(vb), l3 = tr_read<v_rd_off(D0, 3, 0)>(vb), h3 = tr_read<v_rd_off(D0, 3, 1)>(vb);
    asm volatile("s_waitcnt lgkmcnt(0)" ::: "memory"); SBAR();
#define PKV(L, H) (bf16x8){L[0], L[1], L[2], L[3], H[0], H[1], H[2], H[3]}
    od = MFMA32(pa0, PKV(l0, h0), od); od = MFMA32(pa1, PKV(l1, h1), od); od = MFMA32(pa2, PKV(l2, h2), od); od = MFMA32(pa3, PKV(l3, h3), od);
#undef PKV
}
__device__ __forceinline__ void sb_qkt(f32x16& p0, f32x16& p1, const LAS unsigned char* Ks, const bf16x8 (&qr)[8], int r32, int hi) {
#pragma unroll
    for (int r = 0; r < 16; ++r) { p0[r] = 0.f; p1[r] = 0.f; }
#pragma unroll
    for (int d0 = 0; d0 < 8; ++d0) { const int cb = (d0 * 16 + hi * 8) * 2;
        const bf16x8 b0 = *(const LAS bf16x8*)(Ks + KSWZ(r32, cb)), b1 = *(const LAS bf16x8*)(Ks + KSWZ(32 + r32, cb));
        p0 = MFMA32(b0, qr[d0], p0); p1 = MFMA32(b1, qr[d0], p1); }
}
struct f4s { float a, b, c, d; };
template <bool MASK> __device__ __forceinline__ f4s sb_group(float x0, float x1, float x2, float x3, float& Hrun, int kb, int qpos, int hi) {
    float l0 = __builtin_amdgcn_logf(1.0f + __builtin_amdgcn_exp2f(-x0)), l1 = __builtin_amdgcn_logf(1.0f + __builtin_amdgcn_exp2f(-x1));
    float l2 = __builtin_amdgcn_logf(1.0f + __builtin_amdgcn_exp2f(-x2)), l3 = __builtin_amdgcn_logf(1.0f + __builtin_amdgcn_exp2f(-x3));
    float k0 = -l0 - x0, k1 = -l1 - x1, k2 = -l2 - x2, k3 = -l3 - x3;
    float b0 = -l0, b1 = -l1, b2 = -l2, b3 = -l3;
    if (MASK) { const bool v0 = kb < qpos, v1 = kb + 1 < qpos, v2 = kb + 2 < qpos, v3 = kb + 3 < qpos;
        k0 = v0 ? k0 : 0.f; k1 = v1 ? k1 : 0.f; k2 = v2 ? k2 : 0.f; k3 = v3 ? k3 : 0.f;
        b0 = v0 ? b0 : -1e30f; b1 = v1 ? b1 : -1e30f; b2 = v2 ? b2 : -1e30f; b3 = v3 ? b3 : -1e30f; }
    const float s2 = k3, s1 = s2 + k2, s0 = s1 + k1, t = s0 + k0;
    const auto rr = __builtin_amdgcn_permlane32_swap(__float_as_uint(t), __float_as_uint(t), false, false);
    const float tlo = __uint_as_float(rr[0]), thi = __uint_as_float(rr[1]);
    const float Hb = Hrun + (hi ? 0.f : thi);
    f4s w; w.a = __builtin_amdgcn_exp2f(b0 + (Hb + s0)); w.b = __builtin_amdgcn_exp2f(b1 + (Hb + s1)); w.c = __builtin_amdgcn_exp2f(b2 + (Hb + s2)); w.d = __builtin_amdgcn_exp2f(b3 + Hb);
    Hrun += tlo + thi; return w;
}
template <bool MASK> __device__ __forceinline__ void sb_tile(f32x16& p0, f32x16& p1, float& R, int kbase, int qpos, int hi) {
    float Hrun = R; const int kb = kbase + 4 * hi;
#define SBG(P, B, KO) do { const f4s w_ = sb_group<MASK>(P[B], P[B + 1], P[B + 2], P[B + 3], Hrun, kb + (KO), qpos, hi); P[B] = w_.a; P[B + 1] = w_.b; P[B + 2] = w_.c; P[B + 3] = w_.d; } while (0)
    SBG(p1, 12, 56); SBG(p1, 8, 48); SBG(p1, 4, 40); SBG(p1, 0, 32); SBG(p0, 12, 24); SBG(p0, 8, 16); SBG(p0, 4, 8); SBG(p0, 0, 0);
#undef SBG
    R = Hrun;
}
template <bool KVF32> __device__ __forceinline__ void sb_unit(LAS unsigned char* lds, const bf16* Q, bf16* O, int nwq, int i0, const void* K0, const void* V0, const void* K1, const void* V1, int split,
                                                              int tid, int lane, int wave) {
    asm volatile("" : "+v"(tid)); lane = tid & 63; wave = __builtin_amdgcn_readfirstlane(tid >> 6);
    const int r32 = lane & 31, hi = lane >> 5;
    const int sr = tid >> 4, sc = (tid & 15) * 8, vst0 = v_st(sr, sc), vst1 = v_st(32 + sr, sc), kst0 = KSWZ(sr, sc * 2), kst1 = KSWZ(32 + sr, sc * 2);
    const int vb0 = (int)(uintptr_t)(lds + SB_V_OFF) + v_rd_base(lane);
    volatile LAS unsigned* flags = (volatile LAS unsigned*)(lds + SB_FLAG_OFF);
    const bool compute = wave < nwq;
    bf16x8 qr[8];
#pragma unroll
    for (int d0 = 0; d0 < 8; ++d0) qr[d0] = (bf16x8){0, 0, 0, 0, 0, 0, 0, 0};
    const bf16* Qw = Q + (size_t)((compute ? wave : 0) * 32 + r32) * 1024 + hi * 8;

    const int qpos = i0 + wave * 32 + r32;
    f32x16 o[4];
#pragma unroll
    for (int d = 0; d < 4; ++d)
#pragma unroll
        for (int r = 0; r < 16; ++r) o[d][r] = 0.f;
    float R = 0.f; bool done = !compute;
    typedef float f32x8 __attribute__((ext_vector_type(8)));
    f32x8 fk0, fk1, fv0, fv1; bf16x8 hk0, hk1, hv0, hv1;
#define SB_LOAD(jt) do { const int p0_ = 64 * (jt) + sr, p1_ = p0_ + 32; \
        if (KVF32) { const float* kb_ = (const float*)(p0_ < split ? K0 : K1); const float* vb_ = (const float*)(p0_ < split ? V0 : V1); const int q0_ = p0_ < split ? p0_ : p0_ - split, q1_ = q0_ + 32; \
            fk0 = *(const GAS f32x8*)(kb_ + (size_t)q0_ * 1024 + sc); fk1 = *(const GAS f32x8*)(kb_ + (size_t)q1_ * 1024 + sc); fv0 = *(const GAS f32x8*)(vb_ + (size_t)q0_ * 1024 + sc); fv1 = *(const GAS f32x8*)(vb_ + (size_t)q1_ * 1024 + sc); } \
        else { const bf16* kb_ = (const bf16*)K0; const bf16* vb_ = (const bf16*)V0; \
            hk0 = *(const GAS bf16x8*)(kb_ + (size_t)p0_ * 1024 + sc); hk1 = *(const GAS bf16x8*)(kb_ + (size_t)p1_ * 1024 + sc); hv0 = *(const GAS bf16x8*)(vb_ + (size_t)p0_ * 1024 + sc); hv1 = *(const GAS bf16x8*)(vb_ + (size_t)p1_ * 1024 + sc); } } while (0)
#define SB_CVT(x) ((bf16x8)__builtin_bit_cast(bf16x8, ((u32x4){cvtpk(x[0], x[1]), cvtpk(x[2], x[3]), cvtpk(x[4], x[5]), cvtpk(x[6], x[7])})))
#define SB_WRITE(buf) do { LAS unsigned char* vb_ = lds + SB_V_OFF + (buf) * SB_TILE; LAS unsigned char* kb_ = lds + SB_K_OFF + (buf) * SB_TILE; \
        if (KVF32) { *(LAS bf16x8*)(vb_ + vst0) = SB_CVT(fv0); *(LAS bf16x8*)(vb_ + vst1) = SB_CVT(fv1); *(LAS bf16x8*)(kb_ + kst0) = SB_CVT(fk0); *(LAS bf16x8*)(kb_ + kst1) = SB_CVT(fk1); } \
        else { *(LAS bf16x8*)(vb_ + vst0) = hv0; *(LAS bf16x8*)(vb_ + vst1) = hv1; *(LAS bf16x8*)(kb_ + kst0) = hk0; *(LAS bf16x8*)(kb_ + kst1) = hk1; } } while (0)
    const int jt_top = (i0 + 32 * nwq - 1) >> 6;
    SB_LOAD(jt_top); SB_WRITE(0);
    LDS_WAIT(); __syncthreads();
    for (int jt = jt_top, it = 0;; --jt, ++it) {
        const int buf = it & 1; const bool has_next = jt > 0;
        if (has_next) SB_LOAD(jt - 1);
        const int wrow_lo = i0 + wave * 32;
        if (!done && (64 * jt < wrow_lo + 31)) {
            {
#pragma unroll
                for (int d0 = 0; d0 < 8; ++d0) qr[d0] = *(const GAS bf16x8*)(Qw + d0 * 16); }
            f32x16 p0, p1; sb_qkt(p0, p1, lds + SB_K_OFF + buf * SB_TILE, qr, r32, hi);
            if (64 * jt + 64 <= wrow_lo) sb_tile<false>(p0, p1, R, 64 * jt, qpos, hi);
            else sb_tile<true>(p0, p1, R, 64 * jt, qpos, hi);
            bf16x8 pa0, pa1, pa2, pa3;
#define PK4(P, BASE, OUT) do { const unsigned a0 = cvtpk(P[BASE + 0], P[BASE + 1]), a1 = cvtpk(P[BASE + 2], P[BASE + 3]), b0 = cvtpk(P[BASE + 4], P[BASE + 5]), b1 = cvtpk(P[BASE + 6], P[BASE + 7]); \
            const auto r0 = __builtin_amdgcn_permlane32_swap(a0, b0, false, false); const auto r1 = __builtin_amdgcn_permlane32_swap(a1, b1, false, false); \
            OUT = __builtin_bit_cast(bf16x8, ((u32x4){r0[0], r1[0], r0[1], r1[1]})); } while (0)
            PK4(p0, 0, pa0); PK4(p0, 8, pa1); PK4(p1, 0, pa2); PK4(p1, 8, pa3);
#undef PK4
            const int vb = vb0 + buf * SB_TILE;
            pv_one<0>(o[0], vb, pa0, pa1, pa2, pa3); pv_one<1>(o[1], vb, pa0, pa1, pa2, pa3); pv_one<2>(o[2], vb, pa0, pa1, pa2, pa3); pv_one<3>(o[3], vb, pa0, pa1, pa2, pa3);
            done = __all(R <= SB_DONE_THR);
        }
        if (has_next) SB_WRITE(buf ^ 1);
        if (lane == 0) flags[buf * 8 + wave] = done ? 1u : 0u;
        LDS_WAIT(); __syncthreads();
        unsigned nd = 0;
#pragma unroll
        for (int w = 0; w < 8; ++w) nd += flags[buf * 8 + w];
        if (nd == 8u || !has_next) break;
    }
#undef SB_LOAD
#undef SB_WRITE
#undef SB_CVT
    if (compute) {
#pragma unroll
        for (int r = 0; r < 16; ++r) { bf16* orow = O + (size_t)(wave * 32 + crow(r, hi)) * 1024 + r32;
#pragma unroll
            for (int d0 = 0; d0 < 4; ++d0) orow[d0 * 32] = (bf16)(cvtpk(o[d0][r], 0.f) & 0xffffu); }
    }
}
#ifndef PHASE_MASK
#define PHASE_MASK 0xFFFFFFFFu
#endif
#define PH(k) ((PHASE_MASK >> (k)) & 1u)
struct Args { const float* in[22]; float* out; unsigned char* ws; };
#define GEMM_PHASE(EPI, A_, Bt_, N_, K_, E_) do { pg8::Gemm g_{(const pg8::bf16_t*)(A_), (const pg8::bf16_t*)(Bt_), MT, (N_), (K_)}; pg8::StaticOrder S_; S_.init(MT, (N_), G, bx); \
        pg8::gemm_phase<EPI, pg8::StaticOrder, true, true>(lds + RING_OFF, g_, S_, (E_)); } while (0)
__global__ void __launch_bounds__(NWAVES * 64, 2) mk_fwd(Args a) {
    extern __shared__ __attribute__((aligned(16))) unsigned char lds_raw[];
    LAS unsigned char* lds = (LAS unsigned char*)lds_raw;
    const int tid = threadIdx.x, lane = tid & 63, wave = __builtin_amdgcn_readfirstlane(tid >> 6);
    const int G = gridDim.x, bx = blockIdx.x, vcu = (G % 8 == 0) ? (bx % 8) * (G / 8) + bx / 8 : bx;
    const int gw = vcu * NWAVES + wave, NGW = G * NWAVES;
    volatile LAS unsigned* MISC = (volatile LAS unsigned*)(lds + MISC_OFF);
    if (tid < 64) MISC[tid] = 0u;
    __syncthreads();
    unsigned char* ws = a.ws; float* out = a.out;
    XcdBarrier bar = xcd_barrier_post((unsigned*)(ws + WS_CTL) + CW_BAR, MISC + 8);
    const float* xp = a.in[0]; const float* xs = a.in[1]; const float* state_gla = a.in[2]; const float* cache_k = a.in[3]; const float* cache_v = a.in[4];
    bf16 *W1IN = (bf16*)(ws + WS_W1IN), *W1OUT = (bf16*)(ws + WS_W1OUT), *WIN = (bf16*)(ws + WS_WIN), *WGLAO = (bf16*)(ws + WS_WGLAO), *WSBO = (bf16*)(ws + WS_WSBO), *WOUT = (bf16*)(ws + WS_WOUT),
         *W2IN = (bf16*)(ws + WS_W2IN), *W2OUT = (bf16*)(ws + WS_W2OUT);
    bf16 *XB = (bf16*)(ws + WS_XB), *HB = (bf16*)(ws + WS_HB), *ACT = (bf16*)(ws + WS_ACT), *GQ = (bf16*)(ws + WS_GQ), *GK = (bf16*)(ws + WS_GK), *GV = (bf16*)(ws + WS_GV), *GR = (bf16*)(ws + WS_GR),
         *SQ = (bf16*)(ws + WS_SQ), *SKB = (bf16*)(ws + WS_SKB), *SVB = (bf16*)(ws + WS_SVB), *GA = (bf16*)(ws + WS_GA), *GB = (bf16*)(ws + WS_GB), *STS = (bf16*)(ws + WS_STS),
         *OA = (bf16*)(ws + WS_OA), *OB = (bf16*)(ws + WS_OB), *MG = (bf16*)(ws + WS_MG);
    float *R = (float*)(ws + WS_R), *H = (float*)(ws + WS_H), *B2 = (float*)(ws + WS_B2), *DS = (float*)(ws + WS_DS);

    if (PH(0)) { LAS float* scr = (LAS float*)(lds + wave * 16384); int itbase = 0;
      p0_weight<1>(a.in[5], 2 * DFF, DM, 2 * DFF, W1IN, scr, lane, gw, NGW, itbase);
      p0_weight<0>(a.in[6], DM, DFF, DM, W1OUT, scr, lane, gw, NGW, itbase);
      p0_weight<2>(a.in[9], 8208, DM, NIN, WIN, scr, lane, gw, NGW, itbase);
      p0_weight<0>(a.in[13], DM, DM, DM, WGLAO, scr, lane, gw, NGW, itbase);
      p0_weight<0>(a.in[14], DM, DM, DM, WSBO, scr, lane, gw, NGW, itbase);
      p0_weight<0>(a.in[15], DM, DM, DM, WOUT, scr, lane, gw, NGW, itbase);
      p0_weight<1>(a.in[18], 2 * DFF, DM, 2 * DFF, W2IN, scr, lane, gw, NGW, itbase);
      p0_weight<0>(a.in[19], DM, DFF, DM, W2OUT, scr, lane, gw, NGW, itbase);
      for (int m = gw; m < MT; m += NGW) row_to_bf16(m < MP ? xp + (size_t)m * DM : xs + (size_t)(m - MP) * DM, XB + (size_t)m * DM, lane); }
    xcd_barrier(bar);
    if (PH(1)) { pg8::EpiSwiGLU E{(pg8::bf16_t*)ACT, DFF}; GEMM_PHASE(pg8::EpiSwiGLU, XB, W1IN, 2 * DFF, DM, E); }
    xcd_barrier(bar);
    if (PH(2)) { pg8::EpiResid E{xp, xs, R, DN_ALPHA, 0.5f}; GEMM_PHASE(pg8::EpiResid, ACT, W1OUT, DM, DFF, E); }
    xcd_barrier(bar);
    if (PH(3)) ln1_gate_phase(lds, R, H, HB, B2, a.in[7], a.in[8], a.in[9], a.in[10], a.in[11], vcu, G, tid, lane, wave);
    xcd_barrier(bar);
    if (PH(4)) { pg8::EpiMixIn E{(pg8::bf16_t*)GQ, (pg8::bf16_t*)GK, (pg8::bf16_t*)GV, (pg8::bf16_t*)GR, (pg8::bf16_t*)SQ, (pg8::bf16_t*)SKB, (pg8::bf16_t*)SVB, (pg8::bf16_t*)GA, (pg8::bf16_t*)GB,
                      out + O_KP, out + O_KS, out + O_VP, out + O_VS};
      GEMM_PHASE(pg8::EpiMixIn, HB, WIN, NIN, DM, E); }
    xcd_barrier(bar);
    if (PH(5)) for (int u = vcu; u < 1024; u += G) { const int bh = u >> 7, c = u & 127, m0 = (bh >> 2) * TSEQ + c * 64; __syncthreads();
        gla_ds_unit<false, false>(lds, m0, bh & 3, GK, GV, B2, DS + (size_t)u * 32768, nullptr, tid, lane, wave); }
    if (PH(6)) for (int u = vcu; u < 128; u += G) { const int h = u & 3, m0 = MP + (u >> 2) * 64; __syncthreads();
#ifndef NO_P6A
        gla_o_unit<true>(lds, m0, h, GQ, GK, GV, GR, B2, state_gla + (size_t)u * 32768, a.in[12], OA, tid, lane, wave); __syncthreads();
#endif
#ifndef NO_P6B
        gla_ds_unit<true, true>(lds, m0, h, GK, GV, B2, out + O_SGS + (size_t)u * 32768, state_gla + (size_t)u * 32768, tid, lane, wave);
#endif
    }
    if (PH(7)) for (int u = vcu; u < 512; u += G) { const int bh = u >> 5, qb = u & 31, b = bh >> 3, h = bh & 7, i0 = qb * 256; __syncthreads();
        const size_t qo = ((size_t)b * TSEQ + i0) * 1024 + h * 128, ko = (size_t)b * TSEQ * 1024 + h * 128;
        sb_unit<false>(lds, SQ + qo, OB + qo, 8, i0, SKB + ko, SVB + ko, nullptr, nullptr, 1 << 30, tid, lane, wave); }
    if (PH(8)) for (int u = vcu; u < 256; u += G) { const int b = u >> 3, h = u & 7; __syncthreads();
        const size_t qo = ((size_t)MP + b * 64) * 1024 + h * 128, co = (size_t)b * 4096 * 1024 + h * 128, no = (size_t)b * 64 * 1024 + h * 128;
        sb_unit<true>(lds, SQ + qo, OB + qo, 2, 4096, cache_k + co, cache_v + co, out + O_KS + no, out + O_VS + no, 4096, tid, lane, wave); }
    xcd_barrier(bar);
    if (PH(9)) gla_scan_phase(DS, STS, B2, out + O_SGP, vcu, G, tid);
    xcd_barrier(bar);
    if (PH(10)) for (int u = vcu; u < 1024; u += G) { const int bh = u >> 7, c = u & 127, m0 = (bh >> 2) * TSEQ + c * 64; __syncthreads();
        gla_o_unit<false>(lds, m0, bh & 3, GQ, GK, GV, GR, B2, STS + (size_t)u * 32768, a.in[12], OA, tid, lane, wave); }
    xcd_barrier(bar);
    if (PH(11)) { pg8::EpiBranch<0> E{(const pg8::bf16_t*)GA, R, nullptr}; GEMM_PHASE(pg8::EpiBranch<0>, OA, WGLAO, DM, DM, E); }
    if (PH(12)) { pg8::EpiBranch<1> E{(const pg8::bf16_t*)GB, R, (pg8::bf16_t*)MG}; GEMM_PHASE(pg8::EpiBranch<1>, OB, WSBO, DM, DM, E); }
    xcd_barrier(bar);
    if (PH(13)) { pg8::EpiResid E{H, H + (size_t)MP * DM, R, DN_ALPHA, 1.0f}; GEMM_PHASE(pg8::EpiResid, MG, WOUT, DM, DM, E); }
    xcd_barrier(bar);
    if (PH(14)) ln_phase<0>(R, H, HB, a.in[16], a.in[17], gw, NGW, lane);
    xcd_barrier(bar);
    if (PH(15)) { pg8::EpiSwiGLU E{(pg8::bf16_t*)ACT, DFF}; GEMM_PHASE(pg8::EpiSwiGLU, HB, W2IN, 2 * DFF, DM, E); }
    xcd_barrier(bar);
    if (PH(16)) { pg8::EpiResid E{H, H + (size_t)MP * DM, R, DN_ALPHA, 0.5f}; GEMM_PHASE(pg8::EpiResid, ACT, W2OUT, DM, DFF, E); }
    xcd_barrier(bar);
    if (PH(17)) ln_phase<1>(R, out + O_Y, nullptr, a.in[20], a.in[21], gw, NGW, lane);
}

extern "C" void kernel_launch(void* const* d_in, const int* in_sizes, int n_in, void* d_out, int out_size, void* d_ws, size_t ws_size, hipStream_t stream) {
    static int grid = 0;
    if (grid == 0) {
        if (n_in != 22 || (size_t)out_size != O_END || ws_size < WS_END) { fprintf(stderr, "kernel_launch: unexpected shapes: n_in %d out %d ws %zu\n", n_in, out_size, ws_size); grid = -1; return; }
        int dev = 0, cus = 0, per_cu = 0;
        if (hipGetDevice(&dev) != hipSuccess || hipDeviceGetAttribute(&cus, hipDeviceAttributeMultiprocessorCount, dev) != hipSuccess) { grid = -1; return; }
        if (hipFuncSetAttribute((const void*)mk_fwd, hipFuncAttributeMaxDynamicSharedMemorySize, LDS_BYTES) != hipSuccess) { fprintf(stderr, "kernel_launch: hipFuncSetAttribute failed\n"); grid = -1; return; }
        if (hipOccupancyMaxActiveBlocksPerMultiprocessor(&per_cu, (const void*)mk_fwd, NWAVES * 64, LDS_BYTES) != hipSuccess || per_cu < 1) fprintf(stderr, "kernel_launch: occupancy query says %d\n", per_cu);
        (void)hipGetLastError();
        grid = cus;
    }
    if (grid < 0) return;
    if (hipMemsetAsync((char*)d_ws + WS_CTL, 0, CTL_ZERO_BYTES, stream) != hipSuccess) return;
    Args a{};
    for (int i = 0; i < 22; ++i) a.in[i] = (const float*)d_in[i];
    a.out = (float*)d_out; a.ws = (unsigned char*)d_ws;
    hipLaunchKernelGGL(mk_fwd, dim3(grid), dim3(NWAVES * 64), LDS_BYTES, stream, a);
    const hipError_t le = hipPeekAtLastError();
    if (le != hipSuccess) fprintf(stderr, "kernel_launch: launch failed: %s\n", hipGetErrorName(le));
}
```

```cpp
#include <hip/hip_runtime.h>
#include <cstdio>
#include <cstdint>
namespace pg8 {
#define PG8_LAS __attribute__((address_space(3)))
typedef unsigned short bf16_t;
typedef short bf16x8 __attribute__((ext_vector_type(8)));
typedef float f32x4 __attribute__((ext_vector_type(4)));
typedef unsigned u32x4 __attribute__((ext_vector_type(4)));
constexpr int BM = 256, BK = 64, HALF = 128, HTB = HALF * BK * 2  , STAGE_BYTES = 8 * HTB, NXCD = 8, WGM = 8;

__host__ __device__ __forceinline__ int lds_byte(int r, int c) { const int st = (r >> 4) * 2 + (c >> 5), rr = r & 15, cc = c & 31, ob = rr * 64 + cc * 2; return st * 1024 + (ob ^ (((ob >> 9) & 1) << 5)); }
__host__ __device__ __forceinline__ void stage_rc(int b, int& R, int& C) { const int st = b / 1024, sb = b % 1024, swz = sb ^ (((sb >> 9) & 1) << 5); R = (st >> 1) * 16 + swz / 64; C = (st & 1) * 32 + (swz % 64) / 2; }
__host__ __device__ __forceinline__ int perm32(int rho) { const int n = rho >> 4, i = rho & 15; return 8 * (i >> 2) + 4 * n + (i & 3); }

struct Unit { int pm, pn; };
struct Gemm { const bf16_t* A; const bf16_t* Bt; int M, N, K; };

struct StaticOrder {
    int nM, nN, nwg, G, c, wgm;
    __host__ __device__ void init(int M, int N, int G_, int c_) { nM = M / BM; nN = N / BM; nwg = nM * nN; G = G_; c = c_; wgm = WGM; }
    __host__ __device__ bool next(int i, Unit& u) const {
        const long L = (long)i * G + c; if (L >= nwg) return false;
        int wgid = (int)L; { const int q = nwg / NXCD, r = nwg % NXCD, xcd = wgid % NXCD, off = wgid / NXCD; wgid = (xcd < r ? xcd * (q + 1) : r * (q + 1) + (xcd - r) * q) + off; }
        const int nig = wgm * nN, gid = wgid / nig, fm = gid * wgm, gsz = (nM - fm) < wgm ? (nM - fm) : wgm;
        u.pm = fm + ((wgid % nig) % gsz); u.pn = (wgid % nig) / gsz; return true;
    }
    __device__ __forceinline__ void a_ready(const Unit&) const {}
    __device__ __forceinline__ void done(const Unit&) const {}
};

struct FfnOrder {
    StaticOrder so; int G, c;
    __host__ __device__ void init(int G_, int c_) { so.init(16384, 5632, G_, c_); G = G_; c = c_; }
    __host__ __device__ bool next(int i, Unit& u) const {
        const long L = (long)i * G + c; if (L >= 1536) return false;
        if (L < 1408) return so.next(i, u);
        const int l2 = (int)L - 1408; u.pm = 64 + (l2 & 7); u.pn = l2 >> 3; return true;
    }
    __device__ __forceinline__ void a_ready(const Unit&) const {}
    __device__ __forceinline__ void done(const Unit&) const {}
};
typedef __bf16 bf16x2c_t __attribute__((ext_vector_type(2))); typedef float f32x2c_t __attribute__((ext_vector_type(2)));
__device__ __forceinline__ unsigned cvt_pk_bf16(float lo, float hi) { const f32x2c_t v = {lo, hi}; const bf16x2c_t b = __builtin_convertvector(v, bf16x2c_t); return __builtin_bit_cast(unsigned, b); }
__device__ __forceinline__ float fast_sigmoid(float x) { return __builtin_amdgcn_rcpf(1.0f + __builtin_amdgcn_exp2f(-1.4426950408889634f * x)); }
struct EpiSwiGLU {
    static constexpr bool PERM = true, AFTER_DRAIN = false;
    bf16_t* O; int ldc;
    __device__ __forceinline__ void operator()(const f32x4 (&acc)[2][2][4][2], const Unit& u, int wr, int wc, int fr, int fq) const {
        const int row0 = u.pm * BM + wr * 64 + fr, col0 = u.pn * HALF + wc * 32 + 8 * fq;
#pragma unroll
        for (int ai = 0; ai < 2; ++ai)
#pragma unroll
            for (int m = 0; m < 4; ++m) { bf16_t* rowp = O + (size_t)(row0 + ai * HALF + m * 16) * ldc + col0;
                float o[8];
#pragma unroll
                for (int n = 0; n < 2; ++n)
#pragma unroll
                    for (int j = 0; j < 4; ++j) { const float g = acc[ai][0][m][n][j], up = acc[ai][1][m][n][j]; o[n * 4 + j] = g * fast_sigmoid(g) * up; }
                u32x4 w; w.x = cvt_pk_bf16(o[0], o[1]); w.y = cvt_pk_bf16(o[2], o[3]); w.z = cvt_pk_bf16(o[4], o[5]); w.w = cvt_pk_bf16(o[6], o[7]);
                *(u32x4*)rowp = w; }
    }
};
template <bool BF> struct EpiResid {
    static constexpr bool PERM = true, AFTER_DRAIN = false;
    const void* base; bf16_t* out; float alpha, beta;
    __device__ __forceinline__ void operator()(const f32x4 (&acc)[2][2][4][2], const Unit& u, int wr, int wc, int fr, int fq) const {
        const int row0 = u.pm * BM + wr * 64 + fr, col0 = u.pn * BM + wc * 32 + 8 * fq;
#pragma unroll
        for (int ai = 0; ai < 2; ++ai)
#pragma unroll
            for (int m = 0; m < 4; ++m) { const size_t ro = (size_t)(row0 + ai * HALF + m * 16) * 1024 + col0;
#pragma unroll
                for (int bj = 0; bj < 2; ++bj) { f32x4 b0, b1;
                    if (BF) { const u32x4 w = *(const u32x4*)((const bf16_t*)base + ro + bj * HALF);
                        b0 = (f32x4){__uint_as_float(w.x << 16), __uint_as_float(w.x & 0xffff0000u), __uint_as_float(w.y << 16), __uint_as_float(w.y & 0xffff0000u)};
                        b1 = (f32x4){__uint_as_float(w.z << 16), __uint_as_float(w.z & 0xffff0000u), __uint_as_float(w.w << 16), __uint_as_float(w.w & 0xffff0000u)}; }
                    else { b0 = *(const f32x4*)((const float*)base + ro + bj * HALF); b1 = *(const f32x4*)((const float*)base + ro + bj * HALF + 4); }
                    const f32x4 v0 = b0 * alpha + acc[ai][bj][m][0] * beta, v1 = b1 * alpha + acc[ai][bj][m][1] * beta;
                    u32x4 w; w.x = cvt_pk_bf16(v0[0], v0[1]); w.y = cvt_pk_bf16(v0[2], v0[3]); w.z = cvt_pk_bf16(v1[0], v1[1]); w.w = cvt_pk_bf16(v1[2], v1[3]);
                    *(u32x4*)(out + ro + bj * HALF) = w; } }
    }
};
template <bool BF> struct SEpiResid {
    const void* base; bf16_t* out; float alpha, beta;
    __device__ __forceinline__ void apply(int row, int col, f32x4 v) const { const size_t o = (size_t)row * 1024 + col; f32x4 b;
        if (BF) { const unsigned long long w = *(const unsigned long long*)((const bf16_t*)base + o); const unsigned lo = (unsigned)w, hi = (unsigned)(w >> 32);
            b = (f32x4){__uint_as_float(lo << 16), __uint_as_float(lo & 0xffff0000u), __uint_as_float(hi << 16), __uint_as_float(hi & 0xffff0000u)}; }
        else b = *(const f32x4*)((const float*)base + o);
        v = b * alpha + v * beta;
        *(unsigned long long*)(out + o) = (unsigned long long)cvt_pk_bf16(v[0], v[1]) | ((unsigned long long)cvt_pk_bf16(v[2], v[3]) << 32); }
};
template <int SECOND> struct SEpiBranch {
    const bf16_t* G; bf16_t* Tb; bf16_t* Mg;
    __device__ __forceinline__ void apply(int row, int col, f32x4 v) const { const size_t o = (size_t)row * 1024 + col;
        const unsigned long long w = *(const unsigned long long*)(G + o); const unsigned lo = (unsigned)w, hi = (unsigned)(w >> 32);
        v = v * (f32x4){__uint_as_float(lo << 16), __uint_as_float(lo & 0xffff0000u), __uint_as_float(hi << 16), __uint_as_float(hi & 0xffff0000u)};
        if (SECOND) { const unsigned long long t = *(const unsigned long long*)(Tb + o); const unsigned tl = (unsigned)t, th = (unsigned)(t >> 32);
            v = v + (f32x4){__uint_as_float(tl << 16), __uint_as_float(tl & 0xffff0000u), __uint_as_float(th << 16), __uint_as_float(th & 0xffff0000u)}; }
        *(unsigned long long*)((SECOND ? Mg : Tb) + o) = (unsigned long long)cvt_pk_bf16(v[0], v[1]) | ((unsigned long long)cvt_pk_bf16(v[2], v[3]) << 32); }
};
struct EpiMixIn {
    static constexpr bool PERM = true, AFTER_DRAIN = false;
    bf16_t *GQ, *GK, *GV, *GR, *SQ, *SKB, *SVB, *GA, *GB; float *okp, *oks, *ovp, *ovs;
    template <int ACT> __device__ __forceinline__ void store_bf(const f32x4 (&acc)[2][2][4][2], bf16_t* dst, int ld, int row0, int col0, float sc) const {
#pragma unroll
        for (int ai = 0; ai < 2; ++ai)
#pragma unroll
            for (int m = 0; m < 4; ++m) { bf16_t* rp = dst + (size_t)(row0 + ai * HALF + m * 16) * ld + col0;
#pragma unroll
                for (int bj = 0; bj < 2; ++bj) { f32x4 v0 = acc[ai][bj][m][0], v1 = acc[ai][bj][m][1];
                    if (ACT == 1) {
#pragma unroll
                        for (int j = 0; j < 4; ++j) { v0[j] = v0[j] * fast_sigmoid(v0[j]); v1[j] = v1[j] * fast_sigmoid(v1[j]); } }
                    else if (ACT == 2) {
#pragma unroll
                        for (int j = 0; j < 4; ++j) { v0[j] = fast_sigmoid(v0[j]); v1[j] = fast_sigmoid(v1[j]); } }
                    else { v0 = v0 * sc; v1 = v1 * sc; }
                    u32x4 w; w.x = cvt_pk_bf16(v0[0], v0[1]); w.y = cvt_pk_bf16(v0[2], v0[3]); w.z = cvt_pk_bf16(v1[0], v1[1]); w.w = cvt_pk_bf16(v1[2], v1[3]);
                    *(u32x4*)(rp + bj * HALF) = w; } }
    }
    __device__ __forceinline__ void store_f32(const f32x4 (&acc)[2][2][4][2], float* dst, int row0, int col0) const {
#pragma unroll
        for (int ai = 0; ai < 2; ++ai)
#pragma unroll
            for (int m = 0; m < 4; ++m) { float* rp = dst + (size_t)(row0 + ai * HALF + m * 16) * 1024 + col0;
#pragma unroll
                for (int bj = 0; bj < 2; ++bj) { *(f32x4*)(rp + bj * HALF) = acc[ai][bj][m][0]; *(f32x4*)(rp + bj * HALF + 4) = acc[ai][bj][m][1]; } }
    }
    __device__ __forceinline__ void operator()(const f32x4 (&acc)[2][2][4][2], const Unit& u, int wr, int wc, int fr, int fq) const {
        const int pn = u.pn, row0 = u.pm * BM + wr * 64 + fr, cw = wc * 32 + 8 * fq;
        if (pn < 2) store_bf<0>(acc, GQ, 512, row0, pn * 256 + cw, 0.08838834764831845f);
        else if (pn < 4) store_bf<0>(acc, GK, 512, row0, (pn - 2) * 256 + cw, 1.0f);
        else if (pn < 8) store_bf<0>(acc, GV, 1024, row0, (pn - 4) * 256 + cw, 1.0f);
        else if (pn < 12) store_bf<1>(acc, GR, 1024, row0, (pn - 8) * 256 + cw, 1.0f);
        else if (pn < 16) store_bf<0>(acc, SQ, 1024, row0, (pn - 12) * 256 + cw, 0.08838834764831845f * 1.4426950408889634f);
        else if (pn < 20) store_bf<0>(acc, SKB, 1024, row0, (pn - 16) * 256 + cw, 1.0f);
        else if (pn < 24) store_bf<0>(acc, SVB, 1024, row0, (pn - 20) * 256 + cw, 1.0f);
        else if (pn < 28) store_bf<2>(acc, GA, 1024, row0, (pn - 24) * 256 + cw, 1.0f);
        else store_bf<2>(acc, GB, 1024, row0, (pn - 28) * 256 + cw, 1.0f);
    }
};
template <int SECOND> struct EpiBranch {
    static constexpr bool PERM = true, AFTER_DRAIN = false;
    const bf16_t* G; bf16_t* Tb; bf16_t* Mg;
    __device__ __forceinline__ void operator()(const f32x4 (&acc)[2][2][4][2], const Unit& u, int wr, int wc, int fr, int fq) const {
        const int row0 = u.pm * BM + wr * 64 + fr, col0 = u.pn * BM + wc * 32 + 8 * fq;
#pragma unroll
        for (int ai = 0; ai < 2; ++ai)
#pragma unroll
            for (int m = 0; m < 4; ++m) { const size_t ro = (size_t)(row0 + ai * HALF + m * 16) * 1024 + col0;
#pragma unroll
                for (int bj = 0; bj < 2; ++bj) { const u32x4 gw = *(const u32x4*)(G + ro + bj * HALF);
                    f32x4 v0 = acc[ai][bj][m][0], v1 = acc[ai][bj][m][1];
                    v0 = v0 * (f32x4){__uint_as_float(gw.x << 16), __uint_as_float(gw.x & 0xffff0000u), __uint_as_float(gw.y << 16), __uint_as_float(gw.y & 0xffff0000u)};
                    v1 = v1 * (f32x4){__uint_as_float(gw.z << 16), __uint_as_float(gw.z & 0xffff0000u), __uint_as_float(gw.w << 16), __uint_as_float(gw.w & 0xffff0000u)};
                    if (SECOND) { const u32x4 tw = *(const u32x4*)(Tb + ro + bj * HALF);
                        v0 = v0 + (f32x4){__uint_as_float(tw.x << 16), __uint_as_float(tw.x & 0xffff0000u), __uint_as_float(tw.y << 16), __uint_as_float(tw.y & 0xffff0000u)};
                        v1 = v1 + (f32x4){__uint_as_float(tw.z << 16), __uint_as_float(tw.z & 0xffff0000u), __uint_as_float(tw.w << 16), __uint_as_float(tw.w & 0xffff0000u)}; }
                    u32x4 w; w.x = cvt_pk_bf16(v0[0], v0[1]); w.y = cvt_pk_bf16(v0[2], v0[3]); w.z = cvt_pk_bf16(v1[0], v1[1]); w.w = cvt_pk_bf16(v1[2], v1[3]);
                    *(u32x4*)((SECOND ? Mg : Tb) + ro + bj * HALF) = w; } }
    }
};
struct EpiNull {
    static constexpr bool PERM = true, AFTER_DRAIN = false; float* sink;
    __device__ __forceinline__ void operator()(const f32x4 (&acc)[2][2][4][2], const Unit& u, int wr, int wc, int fr, int fq) const {
        f32x4 s = {0.f, 0.f, 0.f, 0.f};
#pragma unroll
        for (int ai = 0; ai < 2; ++ai)
#pragma unroll
            for (int bj = 0; bj < 2; ++bj)
#pragma unroll
                for (int m = 0; m < 4; ++m) { s = s + acc[ai][bj][m][0]; s = s + acc[ai][bj][m][1]; }
        if (s[0] + s[1] + s[2] + s[3] == 12345.678f) sink[0] = s[0];
    }
};
template <class Epi, class Sched, bool ALIGN_EPI = false, bool SP2 = false>
__device__ __forceinline__ void gemm_phase(PG8_LAS unsigned char* lds, const Gemm g, const Sched& S, const Epi& E) {
    int tid_ = threadIdx.x; asm volatile("" : "+v"(tid_));
    const int tid = tid_, wid = __builtin_amdgcn_readfirstlane(tid >> 6), lane = tid & 63, wr = wid >> 2, wc = wid & 3, fr = lane & 15, fq = lane >> 4;
    const int K = g.K, nt = K / BK;
    unsigned voffA[2], voffB[2];
#pragma unroll
    for (int i = 0; i < 2; ++i) { int R, C; stage_rc(tid * 16 + i * 8192, R, C); const int Rb = Epi::PERM ? ((R & ~31) + perm32(R & 31)) : R;
        voffA[i] = (unsigned)(R * K + C) * 2u; voffB[i] = (unsigned)(Rb * K + C) * 2u; }
    const size_t kstep = (size_t)(BK * 2);
    const size_t hstep = (size_t)HALF * K * 2;
    const size_t tstep = 2 * hstep;
    const unsigned ldsw = (unsigned)wid * 1024u;
    const int aoff = lds_byte(wr * 64 + fr, fq * 8), boff = lds_byte(wc * 32 + fr, fq * 8);
#define PG8_SA(b, h) (((b) * 2 + (h)) * HTB)
#define PG8_SB(b, h) ((4 + (b) * 2 + (h)) * HTB)
#define PG8_STAGE(bufoff, gbase, voff) do { _Pragma("unroll") for (int _i = 0; _i < 2; ++_i) \
        __builtin_amdgcn_global_load_lds((const unsigned*)((const char*)(gbase) + (voff)[_i]), (PG8_LAS unsigned*)(lds + (bufoff) + ldsw + _i * 8192), 16, 0, 0); } while (0)
#define PG8_LDA(dst, b, h) do { _Pragma("unroll") for (int m = 0; m < 4; ++m) _Pragma("unroll") for (int k = 0; k < 2; ++k) dst[m][k] = *(const PG8_LAS bf16x8*)(lds + PG8_SA(b, h) + aoff + m * 2048 + k * 1024); } while (0)
#define PG8_LDB(dst, b, h) do { _Pragma("unroll") for (int n = 0; n < 2; ++n) _Pragma("unroll") for (int k = 0; k < 2; ++k) dst[n][k] = *(const PG8_LAS bf16x8*)(lds + PG8_SB(b, h) + boff + n * 2048 + k * 1024); } while (0)
#define PG8_MMA(ai, bj, At, Bt) do { __builtin_amdgcn_s_setprio(1); _Pragma("unroll") for (int m = 0; m < 4; ++m) _Pragma("unroll") for (int n = 0; n < 2; ++n) _Pragma("unroll") for (int k = 0; k < 2; ++k) \
        acc[ai][bj][m][n] = __builtin_amdgcn_mfma_f32_16x16x32_bf16(Bt[n][k], At[m][k], acc[ai][bj][m][n], 0, 0, 0); __builtin_amdgcn_s_setprio(0); } while (0)
#define PG8_WAIT_V(n) asm volatile("s_waitcnt vmcnt(" #n ")" ::: "memory")
#define PG8_WAIT_L(n) asm volatile("s_waitcnt lgkmcnt(" #n ")" ::: "memory")
#define PG8_BAR __builtin_amdgcn_s_barrier()
#define PG8_SCHED __builtin_amdgcn_sched_barrier(0)
    Unit cur, nxt; int ui = 0;
    if (!S.next(0, cur)) return;
    f32x4 acc[2][2][4][2];
#pragma unroll
    for (int a = 0; a < 2; ++a)
#pragma unroll
        for (int b = 0; b < 2; ++b)
#pragma unroll
            for (int m = 0; m < 4; ++m)
#pragma unroll
                for (int n = 0; n < 2; ++n) acc[a][b][m][n] = (f32x4){0.f, 0.f, 0.f, 0.f};
    bf16x8 At[4][2], B0[2][2], B1[2][2];
    const char* cA = (const char*)g.A + (size_t)cur.pm * tstep; const char* cB = (const char*)g.Bt + (size_t)cur.pn * tstep;
    S.a_ready(cur);
    if constexpr (SP2) {
        PG8_STAGE(PG8_SB(0, 0), cB, voffB); PG8_STAGE(PG8_SB(0, 1), cB + hstep, voffB); PG8_STAGE(PG8_SA(0, 0), cA, voffA); PG8_STAGE(PG8_SA(0, 1), cA + hstep, voffA);
        if (wr == 1) PG8_BAR;
        PG8_WAIT_V(2); PG8_BAR;
        PG8_STAGE(PG8_SB(1, 0), cB + kstep, voffB); PG8_STAGE(PG8_SA(1, 0), cA + kstep, voffA); PG8_STAGE(PG8_SB(1, 1), cB + hstep + kstep, voffB);
        PG8_WAIT_V(6); PG8_BAR;
    } else {
        PG8_STAGE(PG8_SB(0, 0), cB, voffB); PG8_STAGE(PG8_SA(0, 0), cA, voffA); PG8_STAGE(PG8_SB(0, 1), cB + hstep, voffB); PG8_STAGE(PG8_SA(0, 1), cA + hstep, voffA);
        if (wr == 1) PG8_BAR;
        PG8_WAIT_V(4); PG8_BAR;
        PG8_STAGE(PG8_SB(1, 0), cB + kstep, voffB); PG8_STAGE(PG8_SA(1, 0), cA + kstep, voffA); PG8_STAGE(PG8_SB(1, 1), cB + hstep + kstep, voffB);
        PG8_WAIT_V(6); PG8_BAR;
    }
    for (;;) {
        const bool has_next = S.next(ui + 1, nxt);
        const char* nA = has_next ? (const char*)g.A + (size_t)nxt.pm * tstep : cA; const char* nB = has_next ? (const char*)g.Bt + (size_t)nxt.pn * tstep : cB;
        for (int t = 0; t < nt; t += 2) {
            const bool last = (t == nt - 2);
            const char* a1 = cA + (size_t)(t + 1) * kstep;
            const char* a2 = last ? nA : cA + (size_t)(t + 2) * kstep; const char* b2 = last ? nB : cB + (size_t)(t + 2) * kstep;
            const char* a3 = a2 + kstep; const char* b3 = b2 + kstep;
            if (last && has_next) S.a_ready(nxt);
            if constexpr (SP2) {
            PG8_LDB(B0, 0, 0); PG8_LDB(B1, 0, 1); PG8_SCHED; PG8_LDA(At, 0, 0); PG8_STAGE(PG8_SA(1, 1), a1 + hstep, voffA);
            PG8_WAIT_V(8); PG8_WAIT_L(0); PG8_BAR; PG8_MMA(0, 0, At, B0); PG8_MMA(0, 1, At, B1); PG8_BAR; PG8_SCHED;
            PG8_LDA(At, 0, 1); PG8_STAGE(PG8_SB(0, 0), b2, voffB); PG8_STAGE(PG8_SB(0, 1), b2 + hstep, voffB); PG8_STAGE(PG8_SA(0, 0), a2, voffA);
            PG8_WAIT_V(8); PG8_WAIT_L(0); PG8_BAR; PG8_MMA(1, 0, At, B0); PG8_MMA(1, 1, At, B1); PG8_BAR; PG8_SCHED;
            PG8_LDB(B0, 1, 0); PG8_LDB(B1, 1, 1); PG8_SCHED; PG8_LDA(At, 1, 0); PG8_STAGE(PG8_SA(0, 1), a2 + hstep, voffA);
            PG8_WAIT_V(8); PG8_WAIT_L(0); PG8_BAR; PG8_MMA(0, 0, At, B0); PG8_MMA(0, 1, At, B1); PG8_BAR; PG8_SCHED;
            PG8_LDA(At, 1, 1); PG8_STAGE(PG8_SB(1, 0), b3, voffB); PG8_STAGE(PG8_SB(1, 1), b3 + hstep, voffB); PG8_STAGE(PG8_SA(1, 0), a3, voffA);
            PG8_WAIT_V(8); PG8_WAIT_L(0); PG8_BAR; PG8_MMA(1, 0, At, B0); PG8_MMA(1, 1, At, B1); PG8_BAR; PG8_SCHED;
            } else {
            PG8_LDB(B0, 0, 0); PG8_SCHED; PG8_LDA(At, 0, 0); PG8_STAGE(PG8_SA(1, 1), a1 + hstep, voffA);
            PG8_WAIT_L(8); PG8_BAR; PG8_WAIT_L(0); PG8_MMA(0, 0, At, B0); PG8_BAR; PG8_SCHED;
            PG8_LDB(B1, 0, 1); PG8_STAGE(PG8_SB(0, 0), b2, voffB);
            PG8_BAR; PG8_WAIT_L(0); PG8_MMA(0, 1, At, B1); PG8_BAR;
            PG8_LDA(At, 0, 1); PG8_STAGE(PG8_SA(0, 0), a2, voffA);
            PG8_BAR; PG8_WAIT_L(0); PG8_MMA(1, 0, At, B0); PG8_BAR; PG8_SCHED;
            PG8_STAGE(PG8_SB(0, 1), b2 + hstep, voffB);
            PG8_WAIT_V(6); PG8_BAR; PG8_MMA(1, 1, At, B1); PG8_BAR;
            PG8_LDB(B0, 1, 0); PG8_SCHED; PG8_LDA(At, 1, 0); PG8_STAGE(PG8_SA(0, 1), a2 + hstep, voffA);
            PG8_WAIT_L(8); PG8_BAR; PG8_WAIT_L(0); PG8_MMA(0, 0, At, B0); PG8_BAR; PG8_SCHED;
            PG8_LDB(B1, 1, 1); PG8_STAGE(PG8_SB(1, 0), b3, voffB);
            PG8_BAR; PG8_WAIT_L(0); PG8_MMA(0, 1, At, B1); PG8_BAR;
            PG8_LDA(At, 1, 1); PG8_STAGE(PG8_SA(1, 0), a3, voffA);
            PG8_BAR; PG8_WAIT_L(0); PG8_MMA(1, 0, At, B0); PG8_BAR; PG8_SCHED;
            PG8_STAGE(PG8_SB(1, 1), b3 + hstep, voffB);
            PG8_WAIT_V(6); PG8_BAR; PG8_MMA(1, 1, At, B1); PG8_BAR;
            }
        }
        if constexpr (ALIGN_EPI) { if (wr == 0) PG8_BAR; }
        if constexpr (!Epi::AFTER_DRAIN) { E(acc, cur, wr, wc, fr, fq); S.done(cur); }
        if (!has_next) break;
#pragma unroll
        for (int a = 0; a < 2; ++a)
#pragma unroll
            for (int b = 0; b < 2; ++b)
#pragma unroll
                for (int m = 0; m < 4; ++m)
#pragma unroll
                    for (int n = 0; n < 2; ++n) acc[a][b][m][n] = (f32x4){0.f, 0.f, 0.f, 0.f};
        cur = nxt; cA = nA; cB = nB; ++ui;
        if constexpr (ALIGN_EPI) { if (wr == 1) PG8_BAR; }
    }
    PG8_WAIT_V(0);
    if constexpr (!ALIGN_EPI) { if (wr == 0) PG8_BAR; }
    PG8_BAR;
    if constexpr (Epi::AFTER_DRAIN) { E.fused(acc, cur, wr, wc, fr, fq, lds, wid, lane); S.done(cur); }
#undef PG8_SA
#undef PG8_SB
#undef PG8_STAGE
#undef PG8_LDA
#undef PG8_LDB
#undef PG8_MMA
#undef PG8_WAIT_V
#undef PG8_WAIT_L
#undef PG8_BAR
#undef PG8_SCHED
}
}
constexpr int NWAVES = 8;
constexpr int DM = 1024, MP = 16384, MS = 2048, MT = MP + MS, DFF = 2816, NIN = 8192, TSEQ = 8192, NCHP = 128  ;
constexpr float LN_EPS = 1e-5f;
constexpr float DN_ALPHA = 1.189207115002721f;
constexpr float LOG2E = 1.4426950408889634f;
constexpr size_t O_Y = 0, O_SGP = 18874368, O_KP = 19136512, O_VP = 35913728, O_SGS = 52690944, O_KS = 56885248, O_VS = 58982400, O_END = 61079552;
constexpr size_t MiB = 1u << 20;
constexpr size_t WS_CTL = 0, CTL_ZERO_BYTES = 32768;
constexpr size_t WS_W1IN = 2 * MiB, WS_W1OUT = 13 * MiB, WS_WIN = 19 * MiB, WS_WGLAO = 35 * MiB, WS_WSBO = 37 * MiB, WS_WOUT = 39 * MiB, WS_W2IN = 41 * MiB, WS_W2OUT = 52 * MiB;
constexpr size_t WS_XB = 64 * MiB, WS_HB = 100 * MiB, WS_ACT = 136 * MiB, WS_R = 236 * MiB, WS_H = 308 * MiB;
constexpr size_t WS_GQ = 380 * MiB, WS_GK = 398 * MiB, WS_GV = 416 * MiB, WS_GR = 452 * MiB, WS_SQ = 488 * MiB, WS_SKB = 524 * MiB, WS_SVB = 556 * MiB, WS_GA = 588 * MiB, WS_GB = 624 * MiB;
constexpr size_t WS_B2 = 660 * MiB, WS_DS = 696 * MiB, WS_STS = 824 * MiB, WS_OA = 888 * MiB, WS_OB = 924 * MiB, WS_MG = 960 * MiB, WS_SKB2 = 996 * MiB, WS_SVB2 = 1032 * MiB, WS_END = 1068 * MiB;
constexpr int CW_TMO = 0, CW_BAR = 4096;
constexpr int RING_OFF = 0, RING_BYTES = 131072;
constexpr int LDS_BYTES = 147456;
constexpr int MISC_OFF = LDS_BYTES - 256;
#define GAS __attribute__((address_space(1)))
#define LAS __attribute__((address_space(3)))
typedef unsigned short bf16;
typedef unsigned v4u __attribute__((ext_vector_type(4)));
typedef float f32x4 __attribute__((ext_vector_type(4)));
typedef short bf16x8 __attribute__((ext_vector_type(8)));
typedef GAS unsigned gu32;
typedef GAS unsigned long long gu64;
#define RLX_AGENT __ATOMIC_RELAXED, __HIP_MEMORY_SCOPE_AGENT
#define LDS_WAIT() asm volatile("s_waitcnt lgkmcnt(0)" ::: "memory")
#define VM_WAIT() asm volatile("s_waitcnt vmcnt(0)" ::: "memory")
__device__ __forceinline__ unsigned long long rt() { return __builtin_amdgcn_s_memrealtime(); }
__device__ __forceinline__ unsigned f2bf(float f) { unsigned u = __builtin_bit_cast(unsigned, f); return (u + 0x7fffu + ((u >> 16) & 1u)) >> 16; }
__device__ __forceinline__ unsigned pk2(float lo, float hi) { return f2bf(lo) | (f2bf(hi) << 16); }

#define XB_TMO      128
#define XB_XCNT(j)  (256  + 64 * (j))
#define XB_XSUB(j)  (1280 + 64 * (j))
#define XB_XGEN(j)  (2304 + 64 * (j))
#define XB_TOP      3328
#define XB_TOPGEN   3392
#define XCD_BAR_WORDS 3456
#define XB_SPIN_CAP (1u << 18)

__device__ __forceinline__ unsigned xb_ld(unsigned* p)              { return __hip_atomic_load(p, __ATOMIC_RELAXED, __HIP_MEMORY_SCOPE_AGENT); }
__device__ __forceinline__ unsigned xb_add(unsigned* p, unsigned v) { return __hip_atomic_fetch_add(p, v, __ATOMIC_RELAXED, __HIP_MEMORY_SCOPE_AGENT); }
__device__ __forceinline__ unsigned xb_xcc_id() { return (unsigned)__builtin_amdgcn_s_getreg((3 << 11) | 20) & 0xFu; }
#define XB_SPIN(cond, bar) do { unsigned _sp = 0; while (cond) { __builtin_amdgcn_s_sleep(1); \
    if ((++_sp & 255u) == 0u) { if (xb_ld(&(bar)[XB_TMO])) break; if (_sp > XB_SPIN_CAP) { atomicAdd(&(bar)[XB_TMO], 1u); break; } } } } while (0)

struct XcdBarrier {
    unsigned* bar; unsigned x;
    volatile LAS unsigned* st;
};

__device__ __forceinline__ XcdBarrier xcd_barrier_post(unsigned* bar, volatile LAS unsigned* st) {
    XcdBarrier b; b.bar = bar; b.x = xb_xcc_id(); b.st = st;
    if (threadIdx.x == 0) (void)xb_add(&bar[XB_XCNT(b.x)], 1u);
    return b;
}
__device__ __forceinline__ void xcd_barrier_complete(unsigned* bar, unsigned x, unsigned& nloc, unsigned& nx) {
    const unsigned G = gridDim.x * gridDim.y * gridDim.z;
    unsigned sum, cnt, mine, sp = 0u;
    for (;;) {
        sum = 0u; cnt = 0u; mine = 0u;
#pragma unroll
        for (unsigned j = 0; j < 16; ++j) { const unsigned c = xb_ld(&bar[XB_XCNT(j)]); sum += c; cnt += (c > 0u) ? 1u : 0u; mine = (j == x) ? c : mine; }
        if (sum == G) break;
        __builtin_amdgcn_s_sleep(1);
        if ((++sp & 255u) == 0u) { if (xb_ld(&bar[XB_TMO])) break; if (sp > XB_SPIN_CAP) { atomicAdd(&bar[XB_TMO], 1u); break; } }
    }
    nloc = mine > 0u ? mine : 1u; nx = cnt > 0u ? cnt : 1u;
}

__device__ __forceinline__ void xcd_barrier(const XcdBarrier& b) {
    asm volatile("s_waitcnt vmcnt(0)" ::: "memory");
    __syncthreads();
    if (threadIdx.x == 0) {
        unsigned* bar = b.bar;
        __builtin_amdgcn_s_waitcnt(0);
        unsigned nloc = b.st[0], nx = b.st[1];
        if (nloc == 0u) { xcd_barrier_complete(bar, b.x, nloc, nx); b.st[0] = nloc; b.st[1] = nx; }
        const unsigned old = xb_add(&bar[XB_XSUB(b.x)], 1u);
        const unsigned gen = old / nloc;
        if (old + 1u == (gen + 1u) * nloc) {
            __builtin_amdgcn_fence(__ATOMIC_RELEASE, "agent");
            asm volatile("s_waitcnt vmcnt(0)" ::: "memory");
            const unsigned og = xb_add(&bar[XB_TOP], 1u);
            const unsigned tg = og / nx;
            if (og + 1u == (tg + 1u) * nx) xb_add(&bar[XB_TOPGEN], 1u);
            else XB_SPIN(xb_ld(&bar[XB_TOPGEN]) == tg, bar);
            __builtin_amdgcn_fence(__ATOMIC_ACQUIRE, "agent");
            xb_add(&bar[XB_XGEN(b.x)], 1u);
            asm volatile("s_waitcnt vmcnt(0)" ::: "memory");
        } else {
            XB_SPIN(xb_ld(&bar[XB_XGEN(b.x)]) == gen, bar);
            __builtin_amdgcn_fence(__ATOMIC_ACQUIRE, "agent");
            asm volatile("s_waitcnt vmcnt(0)" ::: "memory");
        }
    }
    __syncthreads();
}
#ifdef TP_A
#define TSTAMP(k, lds_, tid_) do { if (blockIdx.x == 0 && ((k) == TP_A || (k) == TP_B)) { volatile LAS unsigned* M_ = (volatile LAS unsigned*)((lds_) + MISC_OFF); if ((tid_) == 0) { const unsigned long long t_ = __builtin_amdgcn_s_memrealtime(); \
        if ((k) == TP_A) { M_[16] = (unsigned)t_; M_[17] = (unsigned)(t_ >> 32); } \
        if ((k) == TP_B) { const unsigned long long t0_ = ((unsigned long long)M_[17] << 32) | (unsigned long long)M_[16]; const unsigned long long dl_ = t_ + (unsigned long long)TMULT * (t_ - t0_); \
            while (__builtin_amdgcn_s_memrealtime() < dl_) __builtin_amdgcn_s_sleep(8); } } \
        if ((k) == TP_B) __syncthreads(); } } while (0)
#else
#define TSTAMP(k, lds_, tid_) do { } while (0)
#endif
#define WG_BAR() do { asm volatile("s_waitcnt lgkmcnt(0)" ::: "memory"); __builtin_amdgcn_s_barrier(); asm volatile("" ::: "memory"); } while (0)
#define MFMA32(a, b, c) __builtin_amdgcn_mfma_f32_32x32x16_bf16((a), (b), (c), 0, 0, 0)
typedef float f32x16 __attribute__((ext_vector_type(16)));
typedef short s16x4 __attribute__((ext_vector_type(4)));
typedef unsigned u32x2 __attribute__((ext_vector_type(2)));
typedef float f32x2v __attribute__((ext_vector_type(2)));
typedef unsigned u32x4 __attribute__((ext_vector_type(4)));
__device__ __forceinline__ float wave_sum(float v) {
#pragma unroll
    for (int o = 1; o < 64; o <<= 1) v += __shfl_xor(v, o);
    return v;
}
__device__ __forceinline__ float bf_lo(unsigned w) { return __uint_as_float(w << 16); }
__device__ __forceinline__ float bf_hi(unsigned w) { return __uint_as_float(w & 0xffff0000u); }
typedef __bf16 bf16x2_t __attribute__((ext_vector_type(2)));
__device__ __forceinline__ unsigned cvtpk(float lo, float hi) { const f32x2v v = {lo, hi}; const bf16x2_t b = __builtin_convertvector(v, bf16x2_t); return __builtin_bit_cast(unsigned, b); }
__device__ __forceinline__ int crow(int r, int hi) { return (r & 3) + 8 * (r >> 2) + 4 * hi; }
__device__ __forceinline__ void p0_transpose_item(const float* W, int ldw, int col0, bf16* WT, int K, int row0, int k0, LAS float* scr, int lane) {
#pragma unroll 8
    for (int i = 0; i < 32; ++i) { const int kk = 2 * i + (lane >> 5); scr[kk * 33 + (lane & 31)] = W[(size_t)(k0 + kk) * ldw + col0 + (lane & 31)]; }
    LDS_WAIT(); asm volatile("" ::: "memory");
    const int c = lane & 7;
#pragma unroll
    for (int j = 0; j < 4; ++j) { const int n = (lane >> 3) + 8 * j; const LAS float* s = scr + (8 * c) * 33 + n;
        v4u o; o.x = pk2(s[0 * 33], s[1 * 33]); o.y = pk2(s[2 * 33], s[3 * 33]); o.z = pk2(s[4 * 33], s[5 * 33]); o.w = pk2(s[6 * 33], s[7 * 33]);
        *(GAS v4u*)(WT + (size_t)(row0 + n) * K + k0 + 8 * c) = o; }
    LDS_WAIT(); asm volatile("" ::: "memory");
}
template <int MODE> __device__ __forceinline__ void p0_weight(const float* W, int ldw, int K, int NOUT, bf16* WT, LAS float* scr, int lane, int gw, int NGW, int& itbase) {
    const int nblk = NOUT / 32, nitems = (K / 64) * nblk;
    int it = gw - (itbase % NGW); if (it < 0) it += NGW;
    for (; it < nitems; it += NGW) { const int kb = it / nblk, nb = it % nblk, n0 = 32 * nb; int c0 = n0;
        if (MODE == 1) { const int pn = n0 >> 8, s = (n0 >> 7) & 1, i = n0 & 127; c0 = s * DFF + 128 * pn + i; }
        if (MODE == 2) { c0 = n0 < 3072 ? n0 : n0 + 16; }
        p0_transpose_item(W, ldw, c0, WT, K, n0, 64 * kb, scr, lane); }
    itbase += nitems;
}
__device__ __forceinline__ void row_to_bf16(const float* xrow, bf16* orow, int lane) {
    const GAS f32x4* xr = (const GAS f32x4*)xrow + lane; GAS unsigned long long* o8 = (GAS unsigned long long*)orow + lane;
#pragma unroll
    for (int j = 0; j < 4; ++j) { const f32x4 v = xr[64 * j]; o8[64 * j] = (unsigned long long)pk2(v.x, v.y) | ((unsigned long long)pk2(v.z, v.w) << 32); }
}
__device__ __forceinline__ void ln_row(f32x4 (&v)[4], const f32x4 (&g)[4], const f32x4 (&b)[4]) {
    float s = 0.f;
#pragma unroll
    for (int j = 0; j < 4; ++j) s += (v[j].x + v[j].y) + (v[j].z + v[j].w);
    const float mean = wave_sum(s) * (1.f / DM); float s2 = 0.f;
#pragma unroll
    for (int j = 0; j < 4; ++j) { v[j] = v[j] - mean; s2 += (v[j].x * v[j].x + v[j].y * v[j].y) + (v[j].z * v[j].z + v[j].w * v[j].w); }
    const float rstd = 1.f / sqrtf(wave_sum(s2) * (1.f / DM) + LN_EPS);
#pragma unroll
    for (int j = 0; j < 4; ++j) v[j] = v[j] * rstd * g[j] + b[j];
}
constexpr int SG_S = 272, SG_A = 0, SG_B = 64 * 272, SG_BUF = 192 * 272;
template <class Epi> __device__ __forceinline__ void sgemm_unit(LAS unsigned char* lds, const bf16* A, const bf16* Bt, int K, int unit, const Epi& E) {
    int tid = threadIdx.x; asm volatile("" : "+v"(tid));
    const int lane = tid & 63, wave = __builtin_amdgcn_readfirstlane(tid >> 6), r32 = lane & 31, hi = lane >> 5, wm = wave >> 2, wn = wave & 3, mt = unit >> 3, nt = unit & 7, lr = tid >> 3, lc = tid & 7;
    const GAS u32x4* pa = (const GAS u32x4*)(A + (size_t)(64 * mt + lr) * K) + lc;
    const GAS u32x4* pb0 = (const GAS u32x4*)(Bt + (size_t)(128 * nt + lr) * K) + lc;
    const GAS u32x4* pb1 = (const GAS u32x4*)(Bt + (size_t)(128 * nt + 64 + lr) * K) + lc;
    const int wo = lr * SG_S + lc * 16;
    u32x4 a0_0, a1_0, b0_0, b1_0, b2_0, b3_0, a0_1, a1_1, b0_1, b1_1, b2_1, b3_1, a0_2, a1_2, b0_2, b1_2, b2_2, b3_2, a0_3, a1_3, b0_3, b1_3, b2_3, b3_3;
    const int nk = K / 128;
#define SG_LOAD(S, T) do { a0_##S = pa[16 * (T)]; a1_##S = pa[16 * (T) + 8]; b0_##S = pb0[16 * (T)]; b1_##S = pb0[16 * (T) + 8]; b2_##S = pb1[16 * (T)]; b3_##S = pb1[16 * (T) + 8]; } while (0)
#define SG_WRITE(S, BUF) do { LAS unsigned char* nb_ = lds + (BUF) * SG_BUF; *(LAS u32x4*)(nb_ + SG_A + wo) = a0_##S; *(LAS u32x4*)(nb_ + SG_A + wo + 128) = a1_##S; \
        *(LAS u32x4*)(nb_ + SG_B + wo) = b0_##S; *(LAS u32x4*)(nb_ + SG_B + wo + 128) = b1_##S; *(LAS u32x4*)(nb_ + SG_B + 64 * SG_S + wo) = b2_##S; *(LAS u32x4*)(nb_ + SG_B + 64 * SG_S + wo + 128) = b3_##S; } while (0)
#define SG_COMPUTE(BUF) do { const LAS unsigned char* ab_ = lds + (BUF) * SG_BUF + SG_A + (32 * wm + r32) * SG_S + hi * 16; const LAS unsigned char* bb_ = lds + (BUF) * SG_BUF + SG_B + (32 * wn + r32) * SG_S + hi * 16; \
        _Pragma("unroll") for (int ks = 0; ks < 8; ++ks) { const bf16x8 a_ = *(const LAS bf16x8*)(ab_ + ks * 32), b_ = *(const LAS bf16x8*)(bb_ + ks * 32); acc = MFMA32(b_, a_, acc); } } while (0)
#define SG_STEP(I, SL, SW) do { if (kt + (I) + 3 < nk) SG_LOAD(SL, kt + (I) + 3); SG_COMPUTE((I) & 1); if (kt + (I) + 1 < nk) SG_WRITE(SW, ((I) + 1) & 1); WG_BAR(); } while (0)
    SG_LOAD(0, 0); SG_LOAD(1, 1); if (2 < nk) SG_LOAD(2, 2);
    SG_WRITE(0, 0);
    WG_BAR();
    f32x16 acc;
#pragma unroll
    for (int r = 0; r < 16; ++r) acc[r] = 0.f;
    for (int kt = 0; kt < nk; kt += 4) {
        SG_STEP(0, 3, 1);
        if (kt + 1 < nk) SG_STEP(1, 0, 2);
        if (kt + 2 < nk) SG_STEP(2, 1, 3);
        if (kt + 3 < nk) SG_STEP(3, 2, 0);
    }
#undef SG_STEP
#undef SG_LOAD
#undef SG_WRITE
#undef SG_COMPUTE
    const int row = 64 * mt + 32 * wm + r32, col0 = 128 * nt + 32 * wn + 4 * hi;
#pragma unroll
    for (int g = 0; g < 4; ++g) E.apply(row, col0 + 8 * g, (f32x4){acc[4 * g], acc[4 * g + 1], acc[4 * g + 2], acc[4 * g + 3]});
}
__device__ __forceinline__ void ln_load_row(f32x4 (&v)[4], const bf16* Rrow, int lane) {
#pragma unroll
    for (int j2 = 0; j2 < 2; ++j2) { const u32x4 w = ((const GAS u32x4*)Rrow)[64 * j2 + lane];
        v[2 * j2] = (f32x4){bf_lo(w.x), bf_hi(w.x), bf_lo(w.y), bf_hi(w.y)}; v[2 * j2 + 1] = (f32x4){bf_lo(w.z), bf_hi(w.z), bf_lo(w.w), bf_hi(w.w)}; }
}
__device__ __forceinline__ void ln_store_row_bf16(const f32x4 (&v)[4], bf16* Orow, int lane) {
#pragma unroll
    for (int j2 = 0; j2 < 2; ++j2) ((GAS u32x4*)Orow)[64 * j2 + lane] = (u32x4){cvtpk(v[2 * j2].x, v[2 * j2].y), cvtpk(v[2 * j2].z, v[2 * j2].w), cvtpk(v[2 * j2 + 1].x, v[2 * j2 + 1].y), cvtpk(v[2 * j2 + 1].z, v[2 * j2 + 1].w)};
}
constexpr int LW_S = 2064;
__device__ __forceinline__ void ln1_phase(LAS unsigned char* lds, const bf16* R, bf16* HB, float* GLR, const float* g_ln, const float* b_ln, const float* w_in, int vcu, int G, int tid, int lane, int wave) {
    asm volatile("" : "+v"(tid)); lane = tid & 63;
    LAS unsigned char* WH = lds; LAS unsigned char* WL = lds + 16 * LW_S; LAS float* GAM = (LAS float*)(lds + 32 * LW_S); LAS float* BET = GAM + 1024;
    for (int e = tid; e < 16384; e += 512) { const int k = e >> 4, i = e & 15; const float w = w_in[(size_t)k * 8208 + 3072 + i]; const unsigned hb = cvtpk(w, 0.f) & 0xffffu;
        *(LAS unsigned short*)(WH + i * LW_S + k * 2) = (unsigned short)hb; *(LAS unsigned short*)(WL + i * LW_S + k * 2) = (unsigned short)(cvtpk(w - __uint_as_float(hb << 16), 0.f) & 0xffffu); }
    for (int e = tid; e < 1024; e += 512) { GAM[e] = g_ln[e]; BET[e] = b_ln[e]; }
    LDS_WAIT(); __syncthreads();
    const int r = lane & 15, g = lane >> 4;
    for (int bt = vcu + G * wave; bt < MT / 16; bt += G * NWAVES) {
        const int m0 = bt * 16;
        const GAS u32x4* rp = (const GAS u32x4*)(R + (size_t)(m0 + r) * DM + 8 * g);
        float sum = 0.f, sq = 0.f;
#pragma unroll 8
        for (int s = 0; s < 32; ++s) { const u32x4 w = rp[4 * s];
#pragma unroll
            for (int j = 0; j < 4; ++j) { const float a = bf_lo(w[j]), c = bf_hi(w[j]); sum += a + c; sq += a * a + c * c; } }
        sum += __shfl_xor(sum, 16); sq += __shfl_xor(sq, 16); sum += __shfl_xor(sum, 32); sq += __shfl_xor(sq, 32);
        const float mean = sum * (1.f / DM), rstd = 1.f / sqrtf(fmaxf(sq * (1.f / DM) - mean * mean, 0.f) + LN_EPS);
        f32x4 acc = {0.f, 0.f, 0.f, 0.f};
        GAS u32x4* hp = (GAS u32x4*)(HB + (size_t)(m0 + r) * DM + 8 * g);
#pragma unroll 4
        for (int s = 0; s < 32; ++s) { const u32x4 w = rp[4 * s]; const int c0 = 32 * s + 8 * g;
            const f32x4 ga = *(const LAS f32x4*)(GAM + c0), gb = *(const LAS f32x4*)(GAM + c0 + 4), ba = *(const LAS f32x4*)(BET + c0), bb = *(const LAS f32x4*)(BET + c0 + 4);
            u32x4 hw;
            hw[0] = cvtpk((bf_lo(w[0]) - mean) * rstd * ga[0] + ba[0], (bf_hi(w[0]) - mean) * rstd * ga[1] + ba[1]);
            hw[1] = cvtpk((bf_lo(w[1]) - mean) * rstd * ga[2] + ba[2], (bf_hi(w[1]) - mean) * rstd * ga[3] + ba[3]);
            hw[2] = cvtpk((bf_lo(w[2]) - mean) * rstd * gb[0] + bb[0], (bf_hi(w[2]) - mean) * rstd * gb[1] + bb[1]);
            hw[3] = cvtpk((bf_lo(w[3]) - mean) * rstd * gb[2] + bb[2], (bf_hi(w[3]) - mean) * rstd * gb[3] + bb[3]);
            hp[4 * s] = hw;
            const bf16x8 af = __builtin_bit_cast(bf16x8, hw);
            const bf16x8 bh = *(const LAS bf16x8*)(WH + r * LW_S + c0 * 2), bl = *(const LAS bf16x8*)(WL + r * LW_S + c0 * 2);
            acc = __builtin_amdgcn_mfma_f32_16x16x32_bf16(af, bh, acc, 0, 0, 0); acc = __builtin_amdgcn_mfma_f32_16x16x32_bf16(af, bl, acc, 0, 0, 0); }
#pragma unroll
        for (int q = 0; q < 4; ++q) GLR[(size_t)(m0 + 4 * g + q) * 16 + r] = acc[q];
    }
}
struct LnRaw { u32x4 a, b; };
__device__ __forceinline__ void ln_load_raw(LnRaw& q, const bf16* Rrow, int lane) { q.a = ((const GAS u32x4*)Rrow)[lane]; q.b = ((const GAS u32x4*)Rrow)[64 + lane]; }
__device__ __forceinline__ void ln_cvt_raw(const LnRaw& q, f32x4 (&v)[4]) {
    v[0] = (f32x4){bf_lo(q.a.x), bf_hi(q.a.x), bf_lo(q.a.y), bf_hi(q.a.y)}; v[1] = (f32x4){bf_lo(q.a.z), bf_hi(q.a.z), bf_lo(q.a.w), bf_hi(q.a.w)};
    v[2] = (f32x4){bf_lo(q.b.x), bf_hi(q.b.x), bf_lo(q.b.y), bf_hi(q.b.y)}; v[3] = (f32x4){bf_lo(q.b.z), bf_hi(q.b.z), bf_lo(q.b.w), bf_hi(q.b.w)};
}
template <int FINAL> __device__ __forceinline__ void ln_phase(const bf16* R, float* Y, bf16* HB, const float* g_ln, const float* b_ln, int gw, int NGW, int lane) {
    { int t_ = threadIdx.x; asm volatile("" : "+v"(t_)); lane = t_ & 63; }
    f32x4 g[4], b[4];
#pragma unroll
    for (int j = 0; j < 4; ++j) { g[j] = ((const GAS f32x4*)g_ln)[128 * (j >> 1) + 2 * lane + (j & 1)]; b[j] = ((const GAS f32x4*)b_ln)[128 * (j >> 1) + 2 * lane + (j & 1)]; }
    LnRaw q0, q1, q2, q3;
    int row = gw;
    if (row < MT) ln_load_raw(q0, R + (size_t)row * DM, lane);
    if (row + NGW < MT) ln_load_raw(q1, R + (size_t)(row + NGW) * DM, lane);
    if (row + 2 * NGW < MT) ln_load_raw(q2, R + (size_t)(row + 2 * NGW) * DM, lane);
#define LN_STEP(CUR, NXT, I) do { const int r_ = row + (I) * NGW; if (r_ < MT) { if (r_ + 3 * NGW < MT) ln_load_raw(NXT, R + (size_t)(r_ + 3 * NGW) * DM, lane); \
        f32x4 v[4]; ln_cvt_raw(CUR, v); ln_row(v, g, b); \
        if (FINAL) { _Pragma("unroll") for (int j = 0; j < 4; ++j) ((GAS f32x4*)(Y + (size_t)r_ * DM))[128 * (j >> 1) + 2 * lane + (j & 1)] = v[j]; } \
        else ln_store_row_bf16(v, HB + (size_t)r_ * DM, lane); } } while (0)
#pragma unroll 1
    for (; row < MT; row += 4 * NGW) { LN_STEP(q0, q3, 0); LN_STEP(q1, q0, 1); LN_STEP(q2, q1, 2); LN_STEP(q3, q2, 3); }
#undef LN_STEP
}
constexpr int QT_OFF = 0, QT_S = 272, KT_OFF = 17408, KT_S = 272, PT_OFF = KT_OFF, PT_S = 144, RED_OFF = KT_OFF + 9216, KD_OFF = 34816, KD_S = 320, VT_OFF = 55296, VT_S = 576, LB_OFF = 92160, LB_S = 528, WU_OFF = 125952;
static_assert(WU_OFF + 8192 <= MISC_OFF, "GLA LDS map");
typedef short v4i16_t __attribute__((ext_vector_type(4)));
__device__ __forceinline__ bf16x8 frag_row(const LAS unsigned char* base, int S, int row, int kcol) { return *(const LAS bf16x8*)(base + row * S + kcol * 2); }
__device__ __forceinline__ s16x4 tr4(const LAS unsigned char* p) { return __builtin_bit_cast(s16x4, __builtin_amdgcn_ds_read_tr16_b64_v4i16((LAS v4i16_t*)p)); }
__device__ __forceinline__ bf16x8 frag_tr(const LAS unsigned char* base, int S, int k0, int c0, int lane) {
    const int hi = lane >> 5, blk = (lane >> 4) & 1, q = (lane & 15) >> 2, p = lane & 3;
    const LAS unsigned char* a = base + (k0 + 8 * hi + q) * S + (c0 + 16 * blk + 4 * p) * 2;
    const s16x4 lo = tr4(a), h4 = tr4(a + 4 * S);
    return (bf16x8){lo[0], lo[1], lo[2], lo[3], h4[0], h4[1], h4[2], h4[3]};
}
struct GlaIn { f32x4 glr[4]; u32x4 q0, q1, k0, k1, v[4]; };
template <bool WITH_Q> __device__ __forceinline__ void gla_load(GlaIn& x, const bf16* GQ, const bf16* GK, const bf16* GV, const float* GLR, int m0, int h, int tid) {
    const int row = tid >> 3, cs = tid & 7; const unsigned go = (unsigned)(m0 + row) * 512u + (unsigned)(h * 128 + 16 * cs);
    { const int l_ = tid & 63;
#pragma unroll
      for (int i = 0; i < 4; ++i) x.glr[i] = *(const GAS f32x4*)(GLR + ((unsigned)(m0 + 32 * (i >> 1) + (l_ & 31)) * 16u + (unsigned)(8 * (l_ >> 5) + 4 * (i & 1)))); }
    const GAS u32x4* kp = (const GAS u32x4*)(GK + go); x.k0 = kp[0]; x.k1 = kp[1];
    if (WITH_Q) { const GAS u32x4* qp = (const GAS u32x4*)(GQ + go); x.q0 = qp[0]; x.q1 = qp[1]; }
    const GAS u32x4* vp = (const GAS u32x4*)(GV + ((unsigned)(m0 + row) * 1024u + (unsigned)(h * 256 + 32 * cs)));
#pragma unroll
    for (int i = 0; i < 4; ++i) x.v[i] = vp[i];
}
struct GlaGate { bf16x8 whi, wlo; float bias; };
__device__ __forceinline__ void gla_gate_init(GlaGate& gt, const float* w_up, const float* b_gate, int h, int lane, int wave) {
    const int col = h * 128 + 32 * (wave >> 1) + (lane & 31), k0 = 8 * (lane >> 5); float w[8], l[8];
#pragma unroll
    for (int j = 0; j < 8; ++j) { w[j] = ((const GAS float*)w_up)[(k0 + j) * 512 + col]; const unsigned hb = cvtpk(w[j], 0.f) & 0xffffu; l[j] = w[j] - __uint_as_float(hb << 16); }
    gt.whi = __builtin_bit_cast(bf16x8, ((u32x4){cvtpk(w[0], w[1]), cvtpk(w[2], w[3]), cvtpk(w[4], w[5]), cvtpk(w[6], w[7])}));
    gt.wlo = __builtin_bit_cast(bf16x8, ((u32x4){cvtpk(l[0], l[1]), cvtpk(l[2], l[3]), cvtpk(l[4], l[5]), cvtpk(l[6], l[7])}));
    gt.bias = ((const GAS float*)b_gate)[col];
}
__device__ __forceinline__ void gla_lb_tile(LAS unsigned char* lds, const GlaIn& x, const GlaGate& gt, int lane, int wave) {
    const int r32 = lane & 31, hi = lane >> 5, tbw = wave & 1, cb = wave >> 1;
    float base = 0.f;
#pragma unroll
    for (int tbb = 0; tbb < 2; ++tbb) {
        const f32x4 g0 = x.glr[2 * tbb], g1 = x.glr[2 * tbb + 1]; const float gv[8] = {g0.x, g0.y, g0.z, g0.w, g1.x, g1.y, g1.z, g1.w}; float gl[8];
#pragma unroll
        for (int j = 0; j < 8; ++j) { const unsigned hb = cvtpk(gv[j], 0.f) & 0xffffu; gl[j] = gv[j] - __uint_as_float(hb << 16); }
        const bf16x8 ahi = __builtin_bit_cast(bf16x8, ((u32x4){cvtpk(gv[0], gv[1]), cvtpk(gv[2], gv[3]), cvtpk(gv[4], gv[5]), cvtpk(gv[6], gv[7])}));
        const bf16x8 alo = __builtin_bit_cast(bf16x8, ((u32x4){cvtpk(gl[0], gl[1]), cvtpk(gl[2], gl[3]), cvtpk(gl[4], gl[5]), cvtpk(gl[6], gl[7])}));
        f32x16 z;
#pragma unroll
        for (int r = 0; r < 16; ++r) z[r] = gt.bias;
        z = MFMA32(ahi, gt.whi, z); z = MFMA32(alo, gt.whi, z); z = MFMA32(ahi, gt.wlo, z);
        float run = 0.f;
#pragma unroll
        for (int rho = 0; rho < 4; ++rho) { float p[4];
#pragma unroll
            for (int j = 0; j < 4; ++j) { const float y = z[4 * rho + j] * LOG2E, t = fabsf(y); p[j] = -0.0625f * (__builtin_amdgcn_logf(1.0f + __builtin_amdgcn_exp2f(-t)) + fmaxf(-y, 0.f)); }
            p[1] += p[0]; p[2] += p[1]; p[3] += p[2];
            const auto rr = __builtin_amdgcn_permlane32_swap(__float_as_uint(p[3]), __float_as_uint(p[3]), false, false);
            const float tlo = __uint_as_float(rr[0]), thi = __uint_as_float(rr[1]);
            const float off = base + run + (hi ? tlo : 0.f);
            if (tbb == tbw) {
#pragma unroll
                for (int j = 0; j < 4; ++j) *(LAS float*)(lds + LB_OFF + (32 * tbb + 8 * rho + 4 * hi + j) * LB_S + (32 * cb + r32) * 4) = off + p[j]; }
            run += tlo + thi; }
        base += run;
    }
    WG_BAR();
}
template <bool WITH_QK> __device__ __forceinline__ void gla_stage(LAS unsigned char* lds, const GlaIn& x, int tid, bool need_kd = true) {
    const int row = tid >> 3, cs = tid & 7;
    { LAS u32x4* dst = (LAS u32x4*)(lds + VT_OFF + row * VT_S + 64 * cs);
#pragma unroll
      for (int i = 0; i < 4; ++i) dst[i] = x.v[i]; }
    const unsigned kw[8] = {x.k0[0], x.k0[1], x.k0[2], x.k0[3], x.k1[0], x.k1[1], x.k1[2], x.k1[3]};
    float bb[16], bl[16];
#pragma unroll
    for (int q = 0; q < 4; ++q) { const f32x4 t = *(const LAS f32x4*)(lds + LB_OFF + row * LB_S + (16 * cs + 4 * q) * 4), u = *(const LAS f32x4*)(lds + LB_OFF + 63 * LB_S + (16 * cs + 4 * q) * 4);
        bb[4 * q] = t.x; bb[4 * q + 1] = t.y; bb[4 * q + 2] = t.z; bb[4 * q + 3] = t.w; bl[4 * q] = u.x; bl[4 * q + 1] = u.y; bl[4 * q + 2] = u.z; bl[4 * q + 3] = u.w; }
    if (need_kd) {
        unsigned okd[8];
#pragma unroll
        for (int i = 0; i < 8; ++i) okd[i] = cvtpk(bf_lo(kw[i]) * __builtin_amdgcn_exp2f(bl[2 * i] - bb[2 * i]), bf_hi(kw[i]) * __builtin_amdgcn_exp2f(bl[2 * i + 1] - bb[2 * i + 1]));
        LAS u32x4* d = (LAS u32x4*)(lds + KD_OFF + row * KD_S + 32 * cs); d[0] = (u32x4){okd[0], okd[1], okd[2], okd[3]}; d[1] = (u32x4){okd[4], okd[5], okd[6], okd[7]}; }
    if (WITH_QK) {
        const unsigned qw[8] = {x.q0[0], x.q0[1], x.q0[2], x.q0[3], x.q1[0], x.q1[1], x.q1[2], x.q1[3]};
        unsigned oq[8], ok[8];
#pragma unroll
        for (int i = 0; i < 8; ++i) { const float e0 = __builtin_amdgcn_exp2f(bb[2 * i]), e1 = __builtin_amdgcn_exp2f(bb[2 * i + 1]), f0 = __builtin_amdgcn_exp2f(-bb[2 * i]), f1 = __builtin_amdgcn_exp2f(-bb[2 * i + 1]);
            oq[i] = cvtpk(bf_lo(qw[i]) * e0, bf_hi(qw[i]) * e1); ok[i] = cvtpk(bf_lo(kw[i]) * f0, bf_hi(kw[i]) * f1); }
        LAS u32x4* dq = (LAS u32x4*)(lds + QT_OFF + row * QT_S + 32 * cs); LAS u32x4* dk = (LAS u32x4*)(lds + KT_OFF + row * KT_S + 32 * cs);
        dq[0] = (u32x4){oq[0], oq[1], oq[2], oq[3]}; dq[1] = (u32x4){oq[4], oq[5], oq[6], oq[7]};
        dk[0] = (u32x4){ok[0], ok[1], ok[2], ok[3]}; dk[1] = (u32x4){ok[4], ok[5], ok[6], ok[7]};
    }
}
__device__ __forceinline__ void gla_update(f32x16 (&acc)[4], const LAS unsigned char* lds, int lane, int wave) {
    const int hi = lane >> 5;
#pragma unroll
    for (int ib = 0; ib < 4; ++ib)
#pragma unroll
        for (int g = 0; g < 4; ++g) { const f32x4 bl = *(const LAS f32x4*)(lds + LB_OFF + 63 * LB_S + (32 * ib + 8 * g + 4 * hi) * 4);
#pragma unroll
            for (int j = 0; j < 4; ++j) acc[ib][4 * g + j] *= __builtin_amdgcn_exp2f(bl[j]); }
#pragma unroll 1
    for (int ks = 0; ks < 4; ++ks) { const bf16x8 b = frag_tr(lds + VT_OFF, VT_S, 16 * ks, 32 * wave, lane);
#pragma unroll
        for (int ib = 0; ib < 4; ++ib) { const bf16x8 a = frag_tr(lds + KD_OFF, KD_S, 16 * ks, 32 * ib, lane); acc[ib] = MFMA32(a, b, acc[ib]); } }
}
__device__ __forceinline__ void gla_unit_a(LAS unsigned char* lds, int m0, int h, int nch, const bf16* GK, const bf16* GV, const float* GLR, const float* w_up, const float* b_gate,
                                           const float* S0, float* dst, float* lsum, int tid, int lane, int wave) {
    asm volatile("" : "+v"(tid)); lane = tid & 63; wave = __builtin_amdgcn_readfirstlane(tid >> 6);
    const int r32 = lane & 31, hi = lane >> 5;
    f32x16 acc[4];
#pragma unroll
    for (int ib = 0; ib < 4; ++ib)
#pragma unroll
        for (int r = 0; r < 16; ++r) acc[ib][r] = S0 ? ((const GAS float*)S0)[(32 * ib + crow(r, hi)) * 256 + 32 * wave + r32] : 0.f;
    float ls = 0.f;
    GlaGate gt; gla_gate_init(gt, w_up, b_gate, h, lane, wave);
    GlaIn x; gla_load<false>(x, nullptr, GK, GV, GLR, m0, h, tid);
    WG_BAR();
    for (int c = 0; c < nch; ++c) {
        asm volatile("" : "+v"(tid)); lane = tid & 63;
        gla_lb_tile(lds, x, gt, lane, wave);
#ifdef PROBE_LB2
        gla_lb_tile(lds, x, gt, lane, wave);
#endif
#ifdef PROBE_ST2
        gla_stage<false>(lds, x, tid); WG_BAR();
#endif
        gla_stage<false>(lds, x, tid);
        if (c + 1 < nch) gla_load<false>(x, nullptr, GK, GV, GLR, m0 + 64 * (c + 1), h, tid);
        if (tid < 128) ls += *((const LAS float*)(lds + LB_OFF + 63 * LB_S) + tid);
        WG_BAR();
        gla_update(acc, lds, lane, wave);
        WG_BAR();
    }
#pragma unroll
    for (int ib = 0; ib < 4; ++ib)
#pragma unroll
        for (int r = 0; r < 16; ++r) ((GAS float*)dst)[(32 * ib + crow(r, hi)) * 256 + 32 * wave + r32] = acc[ib][r];
    if (lsum && tid < 128) lsum[tid] = ls;
}
__device__ __forceinline__ void gla_unit_c(LAS unsigned char* lds, int m0, int h, int nch, const bf16* GQ, const bf16* GK, const bf16* GV, const bf16* GR, const float* GLR, const float* w_up, const float* b_gate,
                                           const float* Sin, const float* gnorm, bf16* OA, int tid, int lane, int wave) {
    asm volatile("" : "+v"(tid)); lane = tid & 63; wave = __builtin_amdgcn_readfirstlane(tid >> 6);
    const int r32 = lane & 31, hi = lane >> 5;
    f32x16 acc[4];
#pragma unroll
    for (int ib = 0; ib < 4; ++ib)
#pragma unroll
        for (int r = 0; r < 16; ++r) acc[ib][r] = ((const GAS float*)Sin)[(32 * ib + crow(r, hi)) * 256 + 32 * wave + r32];
    GlaGate gt; gla_gate_init(gt, w_up, b_gate, h, lane, wave);
    if (tid < 64) *(LAS f32x4*)(lds + WU_OFF + tid * 16) = ((const GAS f32x4*)(gnorm + h * 256))[tid];
    GlaIn x; gla_load<true>(x, GQ, GK, GV, GLR, m0, h, tid);
    WG_BAR();
    for (int c = 0; c < nch; ++c) { const int mc = m0 + 64 * c;
        TSTAMP(30, lds, tid);
        asm volatile("" : "+v"(tid)); lane = tid & 63;
        gla_lb_tile(lds, x, gt, lane, wave);
#ifdef PROBE_LB2
        gla_lb_tile(lds, x, gt, lane, wave);
#endif
#ifdef PROBE_ST2
        gla_stage<true>(lds, x, tid); WG_BAR();
#endif
        TSTAMP(31, lds, tid);
        gla_stage<true>(lds, x, tid);
        WG_BAR();
        TSTAMP(32, lds, tid);
        const int tb = wave & 1, sb = wave >> 1; const bool do_att = (wave < 4) && (sb <= tb);
        f32x16 att;
#pragma unroll
        for (int r = 0; r < 16; ++r) att[r] = 0.f;
        if (do_att) {
#pragma unroll 2
            for (int ks = 0; ks < 8; ++ks) { const bf16x8 a = frag_row(lds + QT_OFF, QT_S, 32 * tb + r32, 16 * ks + 8 * hi), b = frag_row(lds + KT_OFF, KT_S, 32 * sb + r32, 16 * ks + 8 * hi); att = MFMA32(a, b, att); } }
        WG_BAR();
        if (do_att) {
#pragma unroll
            for (int r = 0; r < 16; ++r) { const int t = 32 * tb + crow(r, hi), s = 32 * sb + r32; const float val = (s <= t) ? att[r] : 0.f;
                *(LAS unsigned short*)(lds + PT_OFF + t * PT_S + s * 2) = (unsigned short)(cvtpk(val, val) & 0xffffu); } }
        WG_BAR();
        TSTAMP(33, lds, tid);
        f32x16 o0, o1;
#pragma unroll
        for (int r = 0; r < 16; ++r) { o0[r] = 0.f; o1[r] = 0.f; }
#pragma unroll
        for (int ks = 0; ks < 4; ++ks) { const bf16x8 b = frag_tr(lds + VT_OFF, VT_S, 16 * ks, 32 * wave, lane);
            if (ks < 2) { const bf16x8 a0 = frag_row(lds + PT_OFF, PT_S, r32, 16 * ks + 8 * hi); o0 = MFMA32(a0, b, o0); }
            const bf16x8 a1 = frag_row(lds + PT_OFF, PT_S, 32 + r32, 16 * ks + 8 * hi); o1 = MFMA32(a1, b, o1); }
#pragma unroll
        for (int ib = 0; ib < 4; ++ib)
#pragma unroll
            for (int s = 0; s < 2; ++s) {
                const bf16x8 b = __builtin_bit_cast(bf16x8, ((u32x4){cvtpk(acc[ib][8 * s], acc[ib][8 * s + 1]), cvtpk(acc[ib][8 * s + 2], acc[ib][8 * s + 3]), cvtpk(acc[ib][8 * s + 4], acc[ib][8 * s + 5]), cvtpk(acc[ib][8 * s + 6], acc[ib][8 * s + 7])}));
                const int kc = (32 * ib + 16 * s + 4 * hi) * 2;
                const u32x2 a0l = *(const LAS u32x2*)(lds + QT_OFF + r32 * QT_S + kc), a0h = *(const LAS u32x2*)(lds + QT_OFF + r32 * QT_S + kc + 16);
                const u32x2 a1l = *(const LAS u32x2*)(lds + QT_OFF + (32 + r32) * QT_S + kc), a1h = *(const LAS u32x2*)(lds + QT_OFF + (32 + r32) * QT_S + kc + 16);
                o0 = MFMA32(__builtin_bit_cast(bf16x8, ((u32x4){a0l[0], a0l[1], a0h[0], a0h[1]})), b, o0);
                o1 = MFMA32(__builtin_bit_cast(bf16x8, ((u32x4){a1l[0], a1l[1], a1h[0], a1h[1]})), b, o1); }
        TSTAMP(34, lds, tid);
        if (c + 1 < nch) gla_load<true>(x, GQ, GK, GV, GLR, mc + 64, h, tid);
        u32x4 grw[4];
        { const GAS u32x4* gp = (const GAS u32x4*)(GR + ((unsigned)(mc + (tid >> 3)) * 1024u + (unsigned)(h * 256 + 32 * (tid & 7))));
#pragma unroll
          for (int i = 0; i < 4; ++i) grw[i] = gp[i]; }
        if (c + 1 < nch) gla_update(acc, lds, lane, wave);
        WG_BAR();
        TSTAMP(35, lds, tid);
#pragma unroll
        for (int r = 0; r < 16; ++r) { *(LAS unsigned short*)(lds + VT_OFF + crow(r, hi) * 528 + (32 * wave + r32) * 2) = (unsigned short)(cvtpk(o0[r], o0[r]) & 0xffffu);
                                       *(LAS unsigned short*)(lds + VT_OFF + (32 + crow(r, hi)) * 528 + (32 * wave + r32) * 2) = (unsigned short)(cvtpk(o1[r], o1[r]) & 0xffffu); }
        WG_BAR();
        TSTAMP(36, lds, tid);
        { const int row = tid >> 3, cs = tid & 7; u32x4 ow[4]; float ss = 0.f;
#pragma unroll
          for (int i = 0; i < 4; ++i) { ow[i] = *(const LAS u32x4*)(lds + VT_OFF + row * 528 + 64 * cs + 16 * i);
#pragma unroll
              for (int j = 0; j < 4; ++j) { const float lo = bf_lo(ow[i][j]), hi2 = bf_hi(ow[i][j]); ss += lo * lo + hi2 * hi2; } }
          ss += __shfl_xor(ss, 1); ss += __shfl_xor(ss, 2); ss += __shfl_xor(ss, 4);
          const float rstd = 1.0f / sqrtf(ss * (1.0f / 256.0f) + LN_EPS);
          const LAS f32x4* gp = (const LAS f32x4*)(lds + WU_OFF + 128 * cs); GAS u32x4* op = (GAS u32x4*)(OA + ((unsigned)(mc + row) * 1024u + (unsigned)(h * 256 + 32 * cs)));
#pragma unroll
          for (int i = 0; i < 4; ++i) { const f32x4 g0 = gp[2 * i], g1 = gp[2 * i + 1]; u32x4 w;
              w[0] = cvtpk(bf_lo(ow[i][0]) * rstd * g0[0] * bf_lo(grw[i][0]), bf_hi(ow[i][0]) * rstd * g0[1] * bf_hi(grw[i][0]));
              w[1] = cvtpk(bf_lo(ow[i][1]) * rstd * g0[2] * bf_lo(grw[i][1]), bf_hi(ow[i][1]) * rstd * g0[3] * bf_hi(grw[i][1]));
              w[2] = cvtpk(bf_lo(ow[i][2]) * rstd * g1[0] * bf_lo(grw[i][2]), bf_hi(ow[i][2]) * rstd * g1[1] * bf_hi(grw[i][2]));
              w[3] = cvtpk(bf_lo(ow[i][3]) * rstd * g1[2] * bf_lo(grw[i][3]), bf_hi(ow[i][3]) * rstd * g1[3] * bf_hi(grw[i][3]));
              op[i] = w; } }
        TSTAMP(37, lds, tid);
    }
}
__device__ __forceinline__ void gla_scan_phase(const float* DSS, float* SIN, const float* LSUM, float* out_state, int vcu, int G, int tid) {
    for (int item = vcu * 512 + tid; item < 131072; item += G * 512) {
        const int bh = item >> 14, e2 = item & 16383, dk = e2 >> 7, dv = (e2 & 127) * 2;
        const size_t eo = (size_t)dk * 256 + dv;
        float s0 = 0.f, s1 = 0.f;
        f32x2v dd[32]; float lg[32];
#pragma unroll
        for (int sc = 0; sc < 32; ++sc) { dd[sc] = *(const GAS f32x2v*)(DSS + (size_t)(bh * 32 + sc) * 32768 + eo); lg[sc] = ((const GAS float*)LSUM)[(bh * 32 + sc) * 128 + dk]; }
#pragma unroll
        for (int sc = 0; sc < 32; ++sc) { *(GAS f32x2v*)(SIN + (size_t)(bh * 32 + sc) * 32768 + eo) = (f32x2v){s0, s1};
            const float dec = __builtin_amdgcn_exp2f(lg[sc]); s0 = dec * s0 + dd[sc].x; s1 = dec * s1 + dd[sc].y; }
        *(f32x2v*)(out_state + (size_t)bh * 32768 + eo) = (f32x2v){s0, s1};
    }
}
constexpr int SB_V_OFF = 0, SB_K_OFF = 32768, SB_FLAG_OFF = 65536, SB_Q_OFF = 66560, SB_TILE = 16384;
constexpr float SB_DONE_THR = -140.0f;
#define KSWZ(row, colB) ((row) * 256 + ((colB) ^ (((row) & 7) << 4)))
#define SBAR() __builtin_amdgcn_sched_barrier(0)
__device__ __forceinline__ int v_st(int k, int c) { const int kk = (k & ~0xC) | ((k & 4) << 1) | ((k & 8) >> 1); return ((kk >> 3) * 4 + (c >> 5)) * 512 + ((kk & 7) * 32 + (c & 31)) * 2; }
__device__ __forceinline__ int v_rd_base(int lane) { return ((lane & 3) << 3) | (((lane >> 2) & 3) << 6) | (((lane >> 4) & 1) << 5) | (((lane >> 5) & 1) << 8); }
constexpr int v_rd_off(int d0, int ks, int half) { return d0 * 512 + ks * 4096 + half * 2048; }
template <int OFF> __device__ __forceinline__ s16x4 tr_read(int vb) { s16x4 r; asm volatile("ds_read_b64_tr_b16 %0, %1 offset:%2" : "=&v"(r) : "v"(vb), "i"(OFF) : "memory"); return r; }
template <int D0> __device__ __forceinline__ void pv_one(f32x16& od, int vb, bf16x8 pa0, bf16x8 pa1, bf16x8 pa2, bf16x8 pa3) {
    const s16x4 l0 = tr_read<v_rd_off(D0, 0, 0)>(vb), h0 = tr_read<v_rd_off(D0, 0, 1)>(vb), l1 = tr_read<v_rd_off(D0, 1, 0)>(vb), h1 = tr_read<v_rd_off(D0, 1, 1)>(vb);
    const s16x4 l2 = tr_read<v_rd_off(D0, 2, 0)>(vb), h2 = tr_read<v_rd_off(D0, 2, 1)>(vb), l3 = tr_read<v_rd_off(D0, 3, 0)>(vb), h3 = tr_read<v_rd_off(D0, 3, 1)>(vb);
    asm volatile("s_waitcnt lgkmcnt(0)" ::: "memory"); SBAR();
#define PKV(L, H) (bf16x8){L[0], L[1], L[2], L[3], H[0], H[1], H[2], H[3]}
    od = MFMA32(pa0, PKV(l0, h0), od); od = MFMA32(pa1, PKV(l1, h1), od); od = MFMA32(pa2, PKV(l2, h2), od); od = MFMA32(pa3, PKV(l3, h3), od);
#undef PKV
}
__device__ __forceinline__ void sb_qkt(f32x16& p0, f32x16& p1, const LAS unsigned char* Ks, const bf16x8 (&qr)[8], int r32, int hi) {
#pragma unroll
    for (int r = 0; r < 16; ++r) { p0[r] = 0.f; p1[r] = 0.f; }
#pragma unroll
    for (int d0 = 0; d0 < 8; ++d0) { const int cb = (d0 * 16 + hi * 8) * 2;
        const bf16x8 b0 = *(const LAS bf16x8*)(Ks + KSWZ(r32, cb)), b1 = *(const LAS bf16x8*)(Ks + KSWZ(32 + r32, cb));
        p0 = MFMA32(b0, qr[d0], p0); p1 = MFMA32(b1, qr[d0], p1); }
}
struct f4s { float a, b, c, d; };
template <bool MASK> __device__ __forceinline__ f4s sb_group(float x0, float x1, float x2, float x3, float& Hrun, int kb, int qpos, int hi) {
    float l0 = __builtin_amdgcn_logf(1.0f + __builtin_amdgcn_exp2f(-x0)), l1 = __builtin_amdgcn_logf(1.0f + __builtin_amdgcn_exp2f(-x1));
    float l2 = __builtin_amdgcn_logf(1.0f + __builtin_amdgcn_exp2f(-x2)), l3 = __builtin_amdgcn_logf(1.0f + __builtin_amdgcn_exp2f(-x3));
    float k0 = -l0 - x0, k1 = -l1 - x1, k2 = -l2 - x2, k3 = -l3 - x3;
    float b0 = -l0, b1 = -l1, b2 = -l2, b3 = -l3;
    if (MASK) { const bool v0 = kb < qpos, v1 = kb + 1 < qpos, v2 = kb + 2 < qpos, v3 = kb + 3 < qpos;
        k0 = v0 ? k0 : 0.f; k1 = v1 ? k1 : 0.f; k2 = v2 ? k2 : 0.f; k3 = v3 ? k3 : 0.f;
        b0 = v0 ? b0 : -1e30f; b1 = v1 ? b1 : -1e30f; b2 = v2 ? b2 : -1e30f; b3 = v3 ? b3 : -1e30f; }
    const float s2 = k3, s1 = s2 + k2, s0 = s1 + k1, t = s0 + k0;
    const auto rr = __builtin_amdgcn_permlane32_swap(__float_as_uint(t), __float_as_uint(t), false, false);
    const float tlo = __uint_as_float(rr[0]), thi = __uint_as_float(rr[1]);
    const float Hb = Hrun + (hi ? 0.f : thi);
    f4s w; w.a = __builtin_amdgcn_exp2f(b0 + (Hb + s0)); w.b = __builtin_amdgcn_exp2f(b1 + (Hb + s1)); w.c = __builtin_amdgcn_exp2f(b2 + (Hb + s2)); w.d = __builtin_amdgcn_exp2f(b3 + Hb);
    Hrun += tlo + thi; return w;
}
template <bool MASK> __device__ __forceinline__ void sb_tile(f32x16& p0, f32x16& p1, float& R, int kbase, int qpos, int hi) {
    float Hrun = R; const int kb = kbase + 4 * hi;
#define SBG(P, B, KO) do { const f4s w_ = sb_group<MASK>(P[B], P[B + 1], P[B + 2], P[B + 3], Hrun, kb + (KO), qpos, hi); P[B] = w_.a; P[B + 1] = w_.b; P[B + 2] = w_.c; P[B + 3] = w_.d; } while (0)
    SBG(p1, 12, 56); SBG(p1, 8, 48); SBG(p1, 4, 40); SBG(p1, 0, 32); SBG(p0, 12, 24); SBG(p0, 8, 16); SBG(p0, 4, 8); SBG(p0, 0, 0);
#undef SBG
    R = Hrun;
}
template <bool KVF32> __device__ __forceinline__ void sb_unit(LAS unsigned char* lds, const bf16* Q, bf16* O, int nwq, int i0, const bf16* KB, const bf16* VB, const float* KC, const float* VC,
                                                              float* OK, float* OV, int own_lo, int tid, int lane, int wave) {
    asm volatile("" : "+v"(tid)); lane = tid & 63; wave = __builtin_amdgcn_readfirstlane(tid >> 6);
    const int r32 = lane & 31, hi = lane >> 5;
    const int sr = tid >> 4, sc = (tid & 15) * 8, vst0 = v_st(sr, sc), vst1 = v_st(32 + sr, sc), kst0 = KSWZ(sr, sc * 2), kst1 = KSWZ(32 + sr, sc * 2);
    const int vb0 = (int)(uintptr_t)(lds + SB_V_OFF) + v_rd_base(lane);
    volatile LAS unsigned* flags = (volatile LAS unsigned*)(lds + SB_FLAG_OFF);
    const bool compute = wave < nwq;
    bf16x8 qr[8];
#pragma unroll
    for (int d0 = 0; d0 < 8; ++d0) qr[d0] = (bf16x8){0, 0, 0, 0, 0, 0, 0, 0};
    const bf16* Qw = Q + (size_t)((compute ? wave : 0) * 32 + r32) * 1024 + hi * 8;
    LAS unsigned char* qlds = lds + SB_Q_OFF + wave * 8192;
    if (compute) {
#pragma unroll
        for (int d0 = 0; d0 < 8; ++d0) *(LAS bf16x8*)(qlds + KSWZ(r32, (d0 * 16 + hi * 8) * 2)) = *(const GAS bf16x8*)(Qw + d0 * 16); }
    const int qpos = i0 + wave * 32 + r32;
    f32x16 o[4];
#pragma unroll
    for (int d = 0; d < 4; ++d)
#pragma unroll
        for (int r = 0; r < 16; ++r) o[d][r] = 0.f;
    float R = 0.f; bool done = !compute;
    typedef float f32x8 __attribute__((ext_vector_type(8)));
    f32x8 fk0, fk1, fv0, fv1; bf16x8 hk0, hk1, hv0, hv1;
    const int kbase = KVF32 ? 4096 : 0;
#define SB_LOAD_BF(jt) do { const int p0_ = 64 * (jt) + sr - kbase; \
        hk0 = *(const GAS bf16x8*)(KB + (size_t)p0_ * 1024 + sc); hk1 = *(const GAS bf16x8*)(KB + (size_t)(p0_ + 32) * 1024 + sc); hv0 = *(const GAS bf16x8*)(VB + (size_t)p0_ * 1024 + sc); hv1 = *(const GAS bf16x8*)(VB + (size_t)(p0_ + 32) * 1024 + sc); } while (0)
#define SB_LOAD_F32(jt) do { const int p0_ = 64 * (jt) + sr; \
        fk0 = *(const GAS f32x8*)(KC + (size_t)p0_ * 1024 + sc); fk1 = *(const GAS f32x8*)(KC + (size_t)(p0_ + 32) * 1024 + sc); fv0 = *(const GAS f32x8*)(VC + (size_t)p0_ * 1024 + sc); fv1 = *(const GAS f32x8*)(VC + (size_t)(p0_ + 32) * 1024 + sc); } while (0)
#define SB_CVT(x) ((bf16x8)__builtin_bit_cast(bf16x8, ((u32x4){cvtpk(x[0], x[1]), cvtpk(x[2], x[3]), cvtpk(x[4], x[5]), cvtpk(x[6], x[7])})))
#define SB_WRITE_BF(buf) do { LAS unsigned char* vb_ = lds + SB_V_OFF + (buf) * SB_TILE; LAS unsigned char* kb_ = lds + SB_K_OFF + (buf) * SB_TILE; \
        *(LAS bf16x8*)(vb_ + vst0) = hv0; *(LAS bf16x8*)(vb_ + vst1) = hv1; *(LAS bf16x8*)(kb_ + kst0) = hk0; *(LAS bf16x8*)(kb_ + kst1) = hk1; } while (0)
#define SB_WRITE_F32(buf) do { LAS unsigned char* vb_ = lds + SB_V_OFF + (buf) * SB_TILE; LAS unsigned char* kb_ = lds + SB_K_OFF + (buf) * SB_TILE; \
        *(LAS bf16x8*)(vb_ + vst0) = SB_CVT(fv0); *(LAS bf16x8*)(vb_ + vst1) = SB_CVT(fv1); *(LAS bf16x8*)(kb_ + kst0) = SB_CVT(fk0); *(LAS bf16x8*)(kb_ + kst1) = SB_CVT(fk1); } while (0)
#define SB_F4(x, a) ((f32x4){__uint_as_float((unsigned)(unsigned short)x[a] << 16), __uint_as_float((unsigned)(unsigned short)x[a + 1] << 16), __uint_as_float((unsigned)(unsigned short)x[a + 2] << 16), __uint_as_float((unsigned)(unsigned short)x[a + 3] << 16)})
#define SB_STORE_OWN(jt) do { const size_t o0_ = (size_t)(64 * (jt) + sr - own_lo) * 1024 + sc, o1_ = o0_ + 32 * 1024; \
        *(GAS f32x4*)(OK + o0_) = SB_F4(hk0, 0); *(GAS f32x4*)(OK + o0_ + 4) = SB_F4(hk0, 4); *(GAS f32x4*)(OK + o1_) = SB_F4(hk1, 0); *(GAS f32x4*)(OK + o1_ + 4) = SB_F4(hk1, 4); \
        *(GAS f32x4*)(OV + o0_) = SB_F4(hv0, 0); *(GAS f32x4*)(OV + o0_ + 4) = SB_F4(hv0, 4); *(GAS f32x4*)(OV + o1_) = SB_F4(hv1, 0); *(GAS f32x4*)(OV + o1_ + 4) = SB_F4(hv1, 4); } while (0)
    const int jt_top = (i0 + 32 * nwq - 1) >> 6;
    SB_LOAD_BF(jt_top); SB_WRITE_BF(0); SB_STORE_OWN(jt_top);
    WG_BAR();
    for (int jt = jt_top, it = 0;; --jt, ++it) {
        const int buf = it & 1; const bool has_next = jt > 0;
        if (has_next) { if (KVF32) SB_LOAD_F32(jt - 1); else SB_LOAD_BF(jt - 1); }
        const int wrow_lo = i0 + wave * 32;
        if (!done && (64 * jt < wrow_lo + 31)) {
#pragma unroll
            for (int d0 = 0; d0 < 8; ++d0) qr[d0] = *(const LAS bf16x8*)(qlds + KSWZ(r32, (d0 * 16 + hi * 8) * 2));
            f32x16 p0, p1; sb_qkt(p0, p1, lds + SB_K_OFF + buf * SB_TILE, qr, r32, hi);
            if (64 * jt + 64 <= wrow_lo) sb_tile<false>(p0, p1, R, 64 * jt, qpos, hi);
            else sb_tile<true>(p0, p1, R, 64 * jt, qpos, hi);
            bf16x8 pa0, pa1, pa2, pa3;
#define PK4(P, BASE, OUT) do { const unsigned a0 = cvtpk(P[BASE + 0], P[BASE + 1]), a1 = cvtpk(P[BASE + 2], P[BASE + 3]), b0 = cvtpk(P[BASE + 4], P[BASE + 5]), b1 = cvtpk(P[BASE + 6], P[BASE + 7]); \
            const auto r0 = __builtin_amdgcn_permlane32_swap(a0, b0, false, false); const auto r1 = __builtin_amdgcn_permlane32_swap(a1, b1, false, false); \
            OUT = __builtin_bit_cast(bf16x8, ((u32x4){r0[0], r1[0], r0[1], r1[1]})); } while (0)
            PK4(p0, 0, pa0); PK4(p0, 8, pa1); PK4(p1, 0, pa2); PK4(p1, 8, pa3);
#undef PK4
            const int vb = vb0 + buf * SB_TILE;
            pv_one<0>(o[0], vb, pa0, pa1, pa2, pa3); pv_one<1>(o[1], vb, pa0, pa1, pa2, pa3); pv_one<2>(o[2], vb, pa0, pa1, pa2, pa3); pv_one<3>(o[3], vb, pa0, pa1, pa2, pa3);
            done = __all(R <= SB_DONE_THR);
        }
        if (has_next) { if (KVF32) SB_WRITE_F32(buf ^ 1); else { SB_WRITE_BF(buf ^ 1); if (64 * (jt - 1) >= own_lo) SB_STORE_OWN(jt - 1); } }
        if (lane == 0) flags[buf * 8 + wave] = done ? 1u : 0u;
        WG_BAR();
        unsigned nd = 0;
#pragma unroll
        for (int w = 0; w < 8; ++w) nd += flags[buf * 8 + w];
        if ((nd == 8u && (KVF32 || 64 * (jt - 1) < own_lo)) || !has_next) break;
    }
#undef SB_LOAD_BF
#undef SB_LOAD_F32
#undef SB_WRITE_BF
#undef SB_WRITE_F32
#undef SB_CVT
#undef SB_F4
#undef SB_STORE_OWN
    if (compute) {
#pragma unroll
        for (int r = 0; r < 16; ++r) { bf16* orow = O + (size_t)(wave * 32 + crow(r, hi)) * 1024 + r32;
#pragma unroll
            for (int d0 = 0; d0 < 4; ++d0) orow[d0 * 32] = (bf16)(cvtpk(o[d0][r], 0.f) & 0xffffu); }
    }
}
#ifndef PHASE_MASK
#define PHASE_MASK 0xFFFFFFFFu
#endif
#define PH(k) ((PHASE_MASK >> (k)) & 1u)
#ifndef DUP_MASK
#define DUP_MASK 0u
#endif
#define REP(k) for (int rep_ = 0; rep_ < 1 + (int)((DUP_MASK >> (k)) & 1u); ++rep_)
#define STAMP(k) TSTAMP(k, lds, tid)
#ifdef DBL_BAR
#define XBAR() do { xcd_barrier(bar); xcd_barrier(bar); } while (0)
#else
#define XBAR() xcd_barrier(bar)
#endif
struct Args { const float* in[22]; float* out; unsigned char* ws; };
#define GEMM_PHASE(EPI, M_, A_, Bt_, N_, K_, E_) do { pg8::Gemm g_{(const pg8::bf16_t*)(A_), (const pg8::bf16_t*)(Bt_), (M_), (N_), (K_)}; pg8::StaticOrder S_; S_.init((M_), (N_), G, bx); \
        pg8::gemm_phase<EPI, pg8::StaticOrder, true, true>(lds + RING_OFF, g_, S_, (E_)); } while (0)
__global__ void __launch_bounds__(NWAVES * 64, 2) mk_fwd(Args a) {
    extern __shared__ __attribute__((aligned(16))) unsigned char lds_raw[];
    LAS unsigned char* lds = (LAS unsigned char*)lds_raw;
    const int tid = threadIdx.x, lane = tid & 63, wave = __builtin_amdgcn_readfirstlane(tid >> 6);
    const int G = gridDim.x, bx = blockIdx.x, vcu = (G % 8 == 0) ? (bx % 8) * (G / 8) + bx / 8 : bx;
    const int gw = vcu * NWAVES + wave, NGW = G * NWAVES;
#ifndef SF_MASK
#define SF_MASK 1
#endif
    const bool small_first = (vcu & SF_MASK) == SF_MASK && SF_MASK != 0;
    volatile LAS unsigned* MISC = (volatile LAS unsigned*)(lds + MISC_OFF);
    if (tid < 64) MISC[tid] = 0u;
    __syncthreads();
    unsigned char* ws = a.ws; float* out = a.out;
    XcdBarrier bar = xcd_barrier_post((unsigned*)(ws + WS_CTL) + CW_BAR, MISC + 8);
    const float* xp = a.in[0]; const float* xs = a.in[1]; const float* state_gla = a.in[2]; const float* cache_k = a.in[3]; const float* cache_v = a.in[4];
    bf16 *W1IN = (bf16*)(ws + WS_W1IN), *W1OUT = (bf16*)(ws + WS_W1OUT), *WIN = (bf16*)(ws + WS_WIN), *WGLAO = (bf16*)(ws + WS_WGLAO), *WSBO = (bf16*)(ws + WS_WSBO), *WOUT = (bf16*)(ws + WS_WOUT),
         *W2IN = (bf16*)(ws + WS_W2IN), *W2OUT = (bf16*)(ws + WS_W2OUT);
    bf16 *XB = (bf16*)(ws + WS_XB), *HB = (bf16*)(ws + WS_HB), *ACT = (bf16*)(ws + WS_ACT), *GQ = (bf16*)(ws + WS_GQ), *GK = (bf16*)(ws + WS_GK), *GV = (bf16*)(ws + WS_GV), *GR = (bf16*)(ws + WS_GR),
         *SQ = (bf16*)(ws + WS_SQ), *SKB = (bf16*)(ws + WS_SKB2), *SVB = (bf16*)(ws + WS_SVB2), *GA = (bf16*)(ws + WS_GA), *GB = (bf16*)(ws + WS_GB),
         *OA = (bf16*)(ws + WS_OA), *OB = (bf16*)(ws + WS_OB), *MG = (bf16*)(ws + WS_MG), *TB = (bf16*)(ws + WS_R + 40 * MiB);
    bf16* R = (bf16*)(ws + WS_R); float *GLR = (float*)(ws + WS_H), *LSUM = (float*)(ws + WS_B2), *DS = (float*)(ws + WS_DS), *SIN = (float*)(ws + WS_STS);

    STAMP(0);
    if (PH(0)) REP(0) { LAS float* scr = (LAS float*)(lds + wave * 16384); int itbase = 0;
      p0_weight<1>(a.in[5], 2 * DFF, DM, 2 * DFF, W1IN, scr, lane, gw, NGW, itbase);
      for (int m = gw; m < MT; m += NGW) row_to_bf16(m < MP ? xp + (size_t)m * DM : xs + (size_t)(m - MP) * DM, XB + (size_t)m * DM, lane); }
    XBAR(); STAMP(1);
    if (PH(1)) REP(1) { pg8::EpiSwiGLU E{(pg8::bf16_t*)ACT, DFF}; GEMM_PHASE(pg8::EpiSwiGLU, MT, XB, W1IN, 2 * DFF, DM, E);
      { const int nlast = (MT / 256) * (2 * DFF / 256) - 6 * G;
        if (G == 256 && bx >= nlast) { __syncthreads(); LAS float* scr = (LAS float*)(lds + wave * 16384); int itbase = 0; const int gw2 = (bx - nlast) * NWAVES + wave, NGW2 = (G - nlast) * NWAVES;
          p0_weight<0>(a.in[6], DM, DFF, DM, W1OUT, scr, lane, gw2, NGW2, itbase);
          p0_weight<2>(a.in[9], 8208, DM, NIN, WIN, scr, lane, gw2, NGW2, itbase);
          p0_weight<0>(a.in[13], DM, DM, DM, WGLAO, scr, lane, gw2, NGW2, itbase);
          p0_weight<0>(a.in[14], DM, DM, DM, WSBO, scr, lane, gw2, NGW2, itbase);
          p0_weight<0>(a.in[15], DM, DM, DM, WOUT, scr, lane, gw2, NGW2, itbase);
          p0_weight<1>(a.in[18], 2 * DFF, DM, 2 * DFF, W2IN, scr, lane, gw2, NGW2, itbase); }
        else if (G != 256) { __syncthreads(); LAS float* scr = (LAS float*)(lds + wave * 16384); int itbase = 0;
          p0_weight<0>(a.in[6], DM, DFF, DM, W1OUT, scr, lane, gw, NGW, itbase);
          p0_weight<2>(a.in[9], 8208, DM, NIN, WIN, scr, lane, gw, NGW, itbase);
          p0_weight<0>(a.in[13], DM, DM, DM, WGLAO, scr, lane, gw, NGW, itbase);
          p0_weight<0>(a.in[14], DM, DM, DM, WSBO, scr, lane, gw, NGW, itbase);
          p0_weight<0>(a.in[15], DM, DM, DM, WOUT, scr, lane, gw, NGW, itbase);
          p0_weight<1>(a.in[18], 2 * DFF, DM, 2 * DFF, W2IN, scr, lane, gw, NGW, itbase);
          p0_weight<0>(a.in[19], DM, DFF, DM, W2OUT, scr, lane, gw, NGW, itbase); } }
#ifdef PROBE_NULL_P1
      { pg8::EpiNull EN{(float*)R}; GEMM_PHASE(pg8::EpiNull, MT, XB, W1IN, 2 * DFF, DM, EN); }
#endif
    }
    XBAR(); STAMP(2);
#define P2_SMALL() do { pg8::SEpiResid<true> E{XB + (size_t)MP * DM, (pg8::bf16_t*)R + (size_t)MP * DM, DN_ALPHA, 0.5f}; for (int u = vcu; u < 256; u += G) { __syncthreads(); sgemm_unit(lds, ACT + (size_t)MP * DFF, W1OUT, DFF, u, E); } } while (0)
    if (PH(2)) REP(2) { if (small_first) { P2_SMALL(); __syncthreads(); }
      { pg8::EpiResid<true> E{XB, (pg8::bf16_t*)R, DN_ALPHA, 0.5f}; GEMM_PHASE(pg8::EpiResid<true>, MP, ACT, W1OUT, DM, DFF, E); }
      if (!small_first) P2_SMALL(); }
    XBAR(); STAMP(3);
    if (PH(3)) REP(3) ln1_phase(lds, R, HB, GLR, a.in[7], a.in[8], a.in[9], vcu, G, tid, lane, wave);
    XBAR(); STAMP(4);
#ifdef STAGGER_P4
    { const unsigned g4 = (unsigned)(bx >> 3) & 3u; const unsigned long long t0 = __builtin_amdgcn_s_memrealtime(); while (__builtin_amdgcn_s_memrealtime() - t0 < (unsigned long long)(g4 * STAGGER_P4)) __builtin_amdgcn_s_sleep(8); }
#endif
    if (PH(4)) REP(4) { pg8::EpiMixIn E{(pg8::bf16_t*)GQ, (pg8::bf16_t*)GK, (pg8::bf16_t*)GV, (pg8::bf16_t*)GR, (pg8::bf16_t*)SQ, (pg8::bf16_t*)SKB, (pg8::bf16_t*)SVB, (pg8::bf16_t*)GA, (pg8::bf16_t*)GB,
                      out + O_KP, out + O_KS, out + O_VP, out + O_VS};
      GEMM_PHASE(pg8::EpiMixIn, MT, HB, WIN, NIN, DM, E);
#ifdef PROBE_BF_P4
      { pg8::EpiMixIn E2 = E; E2.okp = nullptr; GEMM_PHASE(pg8::EpiMixIn, MT, HB, WIN, NIN, DM, E2); }
#endif
#ifdef PROBE_NULL_P1
#endif
#ifdef PROBE_NULL_P4
      { pg8::EpiNull EN{(float*)R}; GEMM_PHASE(pg8::EpiNull, MT, HB, WIN, NIN, DM, EN); }
#endif
    }
    XBAR(); STAMP(5);
#ifndef P5_ROT
#define P5_ROT 3
#endif
#pragma unroll 1
    for (int st_ = 0; st_ < 3; ++st_) { const int kind_ = (st_ + (P5_ROT > 1 ? vcu % P5_ROT : 0)) % 3;
      if (kind_ == 0 && PH(5)) REP(5) for (int u = vcu; u < 512; u += G) { __syncthreads();
        if (u < 256) { const int bh = u >> 5, sc = u & 31, m0 = (bh >> 2) * TSEQ + sc * 256;
            gla_unit_a(lds, m0, bh & 3, 4, GK, GV, GLR, a.in[10], a.in[11], nullptr, DS + (size_t)u * 32768, LSUM + u * 128, tid, lane, wave); }
        else if (u < 384) { const int su = u - 256, h = su & 3, m0 = MP + (su >> 2) * 64;
            gla_unit_a(lds, m0, h, 1, GK, GV, GLR, a.in[10], a.in[11], state_gla + (size_t)su * 32768, out + O_SGS + (size_t)su * 32768, nullptr, tid, lane, wave); }
        else { const int su = u - 384, h = su & 3, m0 = MP + (su >> 2) * 64;
            gla_unit_c(lds, m0, h, 1, GQ, GK, GV, GR, GLR, a.in[10], a.in[11], state_gla + (size_t)su * 32768, a.in[12], OA, tid, lane, wave); } }
      if (kind_ == 1 && PH(7)) REP(7) for (int u = vcu; u < 512; u += G) { const int bh = u >> 5, qb = u & 31, b = bh >> 3, h = bh & 7, i0 = qb * 256; __syncthreads();
        const size_t qo = ((size_t)b * TSEQ + i0) * 1024 + h * 128, ko = (size_t)b * TSEQ * 1024 + h * 128;
        sb_unit<false>(lds, SQ + qo, OB + qo, 8, i0, SKB + ko, SVB + ko, nullptr, nullptr, out + O_KP + qo, out + O_VP + qo, i0, tid, lane, wave); }
      if (kind_ == 2 && PH(8)) REP(8) for (int u = vcu; u < 256; u += G) { const int b = u >> 3, h = u & 7; __syncthreads();
        const size_t qo = ((size_t)MP + b * 64) * 1024 + h * 128, co = (size_t)b * 4096 * 1024 + h * 128, no = (size_t)b * 64 * 1024 + h * 128;
        sb_unit<true>(lds, SQ + qo, OB + qo, 2, 4096, SKB + qo, SVB + qo, cache_k + co, cache_v + co, out + O_KS + no, out + O_VS + no, 4096, tid, lane, wave); }
    }
    XBAR(); STAMP(6);
    if (PH(9)) REP(9) gla_scan_phase(DS, SIN, LSUM, out + O_SGP, vcu, G, tid);
    XBAR(); STAMP(7);
    if (PH(10)) REP(10) for (int u = vcu; u < 256; u += G) { __syncthreads();
        { const int bh = u >> 5, sc = u & 31, m0 = (bh >> 2) * TSEQ + sc * 256;
            gla_unit_c(lds, m0, bh & 3, 4, GQ, GK, GV, GR, GLR, a.in[10], a.in[11], SIN + (size_t)u * 32768, a.in[12], OA, tid, lane, wave); } }
    XBAR(); STAMP(8);
#define P8_SMALL() do { { pg8::SEpiBranch<0> E{(const pg8::bf16_t*)GA + (size_t)MP * DM, (pg8::bf16_t*)TB + (size_t)MP * DM, nullptr}; for (int u = vcu; u < 256; u += G) { __syncthreads(); sgemm_unit(lds, OA + (size_t)MP * DM, WGLAO, DM, u, E); } } \
      { pg8::SEpiBranch<1> E{(const pg8::bf16_t*)GB + (size_t)MP * DM, (pg8::bf16_t*)TB + (size_t)MP * DM, (pg8::bf16_t*)MG + (size_t)MP * DM}; for (int u = vcu; u < 256; u += G) { __syncthreads(); sgemm_unit(lds, OB + (size_t)MP * DM, WSBO, DM, u, E); } } } while (0)
    if (PH(11)) REP(11) { if (small_first) { P8_SMALL(); __syncthreads(); }
      { pg8::EpiBranch<0> E{(const pg8::bf16_t*)GA, (pg8::bf16_t*)TB, nullptr}; GEMM_PHASE(pg8::EpiBranch<0>, MP, OA, WGLAO, DM, DM, E); }
      { pg8::EpiBranch<1> E{(const pg8::bf16_t*)GB, (pg8::bf16_t*)TB, (pg8::bf16_t*)MG}; GEMM_PHASE(pg8::EpiBranch<1>, MP, OB, WSBO, DM, DM, E); }
      if (!small_first) P8_SMALL(); }
    XBAR(); STAMP(9);
#define P9_SMALL() do { pg8::SEpiResid<true> E{HB + (size_t)MP * DM, (pg8::bf16_t*)R + (size_t)MP * DM, DN_ALPHA, 1.0f}; for (int u = vcu; u < 256; u += G) { __syncthreads(); sgemm_unit(lds, MG + (size_t)MP * DM, WOUT, DM, u, E); } } while (0)
    if (PH(13)) REP(13) { if (small_first) { P9_SMALL(); __syncthreads(); }
      { pg8::EpiResid<true> E{HB, (pg8::bf16_t*)R, DN_ALPHA, 1.0f}; GEMM_PHASE(pg8::EpiResid<true>, MP, MG, WOUT, DM, DM, E); }
      if (!small_first) P9_SMALL(); }
    XBAR(); STAMP(10);
    if (PH(14)) REP(14) ln_phase<0>(R, nullptr, HB, a.in[16], a.in[17], gw, NGW, lane);
    XBAR(); STAMP(11);
    if (PH(15)) REP(15) { pg8::EpiSwiGLU E{(pg8::bf16_t*)ACT, DFF}; GEMM_PHASE(pg8::EpiSwiGLU, MT, HB, W2IN, 2 * DFF, DM, E);
      { const int nlast = (MT / 256) * (2 * DFF / 256) - 6 * G;
        if (G == 256 && bx >= nlast) { __syncthreads(); int t2 = threadIdx.x; asm volatile("" : "+v"(t2)); const int lane2 = t2 & 63, wave2 = __builtin_amdgcn_readfirstlane(t2 >> 6);
          LAS float* scr = (LAS float*)(lds + wave2 * 16384); int itbase = 0; const int gw2 = (bx - nlast) * NWAVES + wave2, NGW2 = (G - nlast) * NWAVES;
          p0_weight<0>(a.in[19], DM, DFF, DM, W2OUT, scr, lane2, gw2, NGW2, itbase); } } }
    XBAR(); STAMP(12);
#define P12_SMALL() do { pg8::SEpiResid<true> E{HB + (size_t)MP * DM, (pg8::bf16_t*)R + (size_t)MP * DM, DN_ALPHA, 0.5f}; for (int u = vcu; u < 256; u += G) { __syncthreads(); sgemm_unit(lds, ACT + (size_t)MP * DFF, W2OUT, DFF, u, E); } } while (0)
    if (PH(16)) REP(16) { if (small_first) { P12_SMALL(); __syncthreads(); }
      { pg8::EpiResid<true> E{HB, (pg8::bf16_t*)R, DN_ALPHA, 0.5f}; GEMM_PHASE(pg8::EpiResid<true>, MP, ACT, W2OUT, DM, DFF, E); }
      if (!small_first) P12_SMALL(); }
    XBAR(); STAMP(13);
    if (PH(17)) REP(17) ln_phase<1>(R, out + O_Y, nullptr, a.in[20], a.in[21], gw, NGW, lane);
#ifdef TP_A
    XBAR(); STAMP(14);
#endif
#ifdef PROBE_A0
    XBAR(); STAMP(14);
    __syncthreads();
    if (bx == 0) {
#define TS(k) (((unsigned long long)MISC[17 + 2 * (k)] << 32) | (unsigned long long)MISC[16 + 2 * (k)])
        const float tA = (float)(long long)(TS(PROBE_A1) - TS(PROBE_A0)) * 0.01f, tB = (float)(long long)(TS(PROBE_B1) - TS(PROBE_B0)) * 0.01f;
        const float c = sqrtf(tA);
        for (int i = tid; i < MS * DM; i += 512) out[O_Y + (size_t)MP * DM + i] = c;
        if (tid == 0) out[O_VS] += tB;
    }
#endif
}

extern "C" void kernel_launch(void* const* d_in, const int* in_sizes, int n_in, void* d_out, int out_size, void* d_ws, size_t ws_size, hipStream_t stream) {
    static int grid = 0;
    if (grid == 0) {
        if (n_in != 22 || (size_t)out_size != O_END || ws_size < WS_END) { fprintf(stderr, "kernel_launch: unexpected shapes: n_in %d out %d ws %zu\n", n_in, out_size, ws_size); grid = -1; return; }
        int dev = 0, cus = 0, per_cu = 0;
        if (hipGetDevice(&dev) != hipSuccess || hipDeviceGetAttribute(&cus, hipDeviceAttributeMultiprocessorCount, dev) != hipSuccess) { grid = -1; return; }
        if (hipFuncSetAttribute((const void*)mk_fwd, hipFuncAttributeMaxDynamicSharedMemorySize, LDS_BYTES) != hipSuccess) { fprintf(stderr, "kernel_launch: hipFuncSetAttribute failed\n"); grid = -1; return; }
        if (hipOccupancyMaxActiveBlocksPerMultiprocessor(&per_cu, (const void*)mk_fwd, NWAVES * 64, LDS_BYTES) != hipSuccess || per_cu < 1) fprintf(stderr, "kernel_launch: occupancy query says %d\n", per_cu);
        (void)hipGetLastError();
        grid = cus;
    }
    if (grid < 0) return;
    if (hipMemsetAsync((char*)d_ws + WS_CTL, 0, CTL_ZERO_BYTES, stream) != hipSuccess) return;
    Args a{};
    for (int i = 0; i < 22; ++i) a.in[i] = (const float*)d_in[i];
    a.out = (float*)d_out; a.ws = (unsigned char*)d_ws;
    hipLaunchKernelGGL(mk_fwd, dim3(grid), dim3(NWAVES * 64), LDS_BYTES, stream, a);
    const hipError_t le = hipPeekAtLastError();
    if (le != hipSuccess) fprintf(stderr, "kernel_launch: launch failed: %s\n", hipGetErrorName(le));
}
```

```cpp
#include <hip/hip_runtime.h>
#include <cstdio>
#include <cstdint>
namespace pg8 {
#define PG8_LAS __attribute__((address_space(3)))
typedef unsigned short bf16_t;
typedef short bf16x8 __attribute__((ext_vector_type(8)));
typedef float f32x4 __attribute__((ext_vector_type(4)));
typedef unsigned u32x4 __attribute__((ext_vector_type(4)));
constexpr int BM = 256, BK = 64, HALF = 128, HTB = HALF * BK * 2  , STAGE_BYTES = 8 * HTB, NXCD = 8, WGM = 8;

__host__ __device__ __forceinline__ int lds_byte(int r, int c) { const int st = (r >> 4) * 2 + (c >> 5), rr = r & 15, cc = c & 31, ob = rr * 64 + cc * 2; return st * 1024 + (ob ^ (((ob >> 9) & 1) << 5)); }
__host__ __device__ __forceinline__ void stage_rc(int b, int& R, int& C) { const int st = b / 1024, sb = b % 1024, swz = sb ^ (((sb >> 9) & 1) << 5); R = (st >> 1) * 16 + swz / 64; C = (st & 1) * 32 + (swz % 64) / 2; }
__host__ __device__ __forceinline__ int perm32(int rho) { const int n = rho >> 4, i = rho & 15; return 8 * (i >> 2) + 4 * n + (i & 3); }

struct Unit { int pm, pn; };
struct Gemm { const bf16_t* A; const bf16_t* Bt; int M, N, K; };

struct StaticOrder {
    int nM, nN, nwg, G, c, wgm;
    __host__ __device__ void init(int M, int N, int G_, int c_) { nM = M / BM; nN = N / BM; nwg = nM * nN; G = G_; c = c_; wgm = WGM; }
    __host__ __device__ bool next(int i, Unit& u) const {
        const long L = (long)i * G + c; if (L >= nwg) return false;
        int wgid = (int)L; { const int q = nwg / NXCD, r = nwg % NXCD, xcd = wgid % NXCD, off = wgid / NXCD; wgid = (xcd < r ? xcd * (q + 1) : r * (q + 1) + (xcd - r) * q) + off; }
        const int nig = wgm * nN, gid = wgid / nig, fm = gid * wgm, gsz = (nM - fm) < wgm ? (nM - fm) : wgm;
        u.pm = fm + ((wgid % nig) % gsz); u.pn = (wgid % nig) / gsz; return true;
    }
    __device__ __forceinline__ void a_ready(const Unit&) const {}
    __device__ __forceinline__ void done(const Unit&) const {}
};

struct FfnOrder {
    StaticOrder so; int G, c;
    __host__ __device__ void init(int G_, int c_) { so.init(16384, 5632, G_, c_); G = G_; c = c_; }
    __host__ __device__ bool next(int i, Unit& u) const {
        const long L = (long)i * G + c; if (L >= 1536) return false;
        if (L < 1408) return so.next(i, u);
        const int l2 = (int)L - 1408; u.pm = 64 + (l2 & 7); u.pn = l2 >> 3; return true;
    }
    __device__ __forceinline__ void a_ready(const Unit&) const {}
    __device__ __forceinline__ void done(const Unit&) const {}
};
typedef __bf16 bf16x2c_t __attribute__((ext_vector_type(2))); typedef float f32x2c_t __attribute__((ext_vector_type(2)));
__device__ __forceinline__ unsigned cvt_pk_bf16(float lo, float hi) { const f32x2c_t v = {lo, hi}; const bf16x2c_t b = __builtin_convertvector(v, bf16x2c_t); return __builtin_bit_cast(unsigned, b); }
__device__ __forceinline__ float fast_sigmoid(float x) { return __builtin_amdgcn_rcpf(1.0f + __builtin_amdgcn_exp2f(-1.4426950408889634f * x)); }
struct EpiSwiGLU {
    static constexpr bool PERM = true, AFTER_DRAIN = false;
    bf16_t* O; int ldc;
    __device__ __forceinline__ void operator()(const f32x4 (&acc)[2][2][4][2], const Unit& u, int wr, int wc, int fr, int fq) const {
        const int row0 = u.pm * BM + wr * 64 + fr, col0 = u.pn * HALF + wc * 32 + 8 * fq;
#pragma unroll
        for (int ai = 0; ai < 2; ++ai)
#pragma unroll
            for (int m = 0; m < 4; ++m) { bf16_t* rowp = O + (size_t)(row0 + ai * HALF + m * 16) * ldc + col0;
                float o[8];
#pragma unroll
                for (int n = 0; n < 2; ++n)
#pragma unroll
                    for (int j = 0; j < 4; ++j) { const float g = acc[ai][0][m][n][j], up = acc[ai][1][m][n][j]; o[n * 4 + j] = g * fast_sigmoid(g) * up; }
                u32x4 w; w.x = cvt_pk_bf16(o[0], o[1]); w.y = cvt_pk_bf16(o[2], o[3]); w.z = cvt_pk_bf16(o[4], o[5]); w.w = cvt_pk_bf16(o[6], o[7]);
                *(u32x4*)rowp = w; }
    }
};
template <bool BF> struct EpiResid {
    static constexpr bool PERM = true, AFTER_DRAIN = false;
    const void* base; bf16_t* out; float alpha, beta;
    __device__ __forceinline__ void operator()(const f32x4 (&acc)[2][2][4][2], const Unit& u, int wr, int wc, int fr, int fq) const {
        const int row0 = u.pm * BM + wr * 64 + fr, col0 = u.pn * BM + wc * 32 + 8 * fq;
#pragma unroll
        for (int ai = 0; ai < 2; ++ai)
#pragma unroll
            for (int m = 0; m < 4; ++m) { const size_t ro = (size_t)(row0 + ai * HALF + m * 16) * 1024 + col0;
#pragma unroll
                for (int bj = 0; bj < 2; ++bj) { f32x4 b0, b1;
                    if (BF) { const u32x4 w = *(const u32x4*)((const bf16_t*)base + ro + bj * HALF);
                        b0 = (f32x4){__uint_as_float(w.x << 16), __uint_as_float(w.x & 0xffff0000u), __uint_as_float(w.y << 16), __uint_as_float(w.y & 0xffff0000u)};
                        b1 = (f32x4){__uint_as_float(w.z << 16), __uint_as_float(w.z & 0xffff0000u), __uint_as_float(w.w << 16), __uint_as_float(w.w & 0xffff0000u)}; }
                    else { b0 = *(const f32x4*)((const float*)base + ro + bj * HALF); b1 = *(const f32x4*)((const float*)base + ro + bj * HALF + 4); }
                    const f32x4 v0 = b0 * alpha + acc[ai][bj][m][0] * beta, v1 = b1 * alpha + acc[ai][bj][m][1] * beta;
                    u32x4 w; w.x = cvt_pk_bf16(v0[0], v0[1]); w.y = cvt_pk_bf16(v0[2], v0[3]); w.z = cvt_pk_bf16(v1[0], v1[1]); w.w = cvt_pk_bf16(v1[2], v1[3]);
                    *(u32x4*)(out + ro + bj * HALF) = w; } }
    }
};
template <bool BF> struct SEpiResid {
    const void* base; bf16_t* out; float alpha, beta;
    __device__ __forceinline__ void apply(int row, int col, f32x4 v) const { const size_t o = (size_t)row * 1024 + col; f32x4 b;
        if (BF) { const unsigned long long w = *(const unsigned long long*)((const bf16_t*)base + o); const unsigned lo = (unsigned)w, hi = (unsigned)(w >> 32);
            b = (f32x4){__uint_as_float(lo << 16), __uint_as_float(lo & 0xffff0000u), __uint_as_float(hi << 16), __uint_as_float(hi & 0xffff0000u)}; }
        else b = *(const f32x4*)((const float*)base + o);
        v = b * alpha + v * beta;
        *(unsigned long long*)(out + o) = (unsigned long long)cvt_pk_bf16(v[0], v[1]) | ((unsigned long long)cvt_pk_bf16(v[2], v[3]) << 32); }
};
template <int SECOND> struct SEpiBranch {
    const bf16_t* G; bf16_t* Tb; bf16_t* Mg;
    __device__ __forceinline__ void apply(int row, int col, f32x4 v) const { const size_t o = (size_t)row * 1024 + col;
        const unsigned long long w = *(const unsigned long long*)(G + o); const unsigned lo = (unsigned)w, hi = (unsigned)(w >> 32);
        v = v * (f32x4){__uint_as_float(lo << 16), __uint_as_float(lo & 0xffff0000u), __uint_as_float(hi << 16), __uint_as_float(hi & 0xffff0000u)};
        if (SECOND) { const unsigned long long t = *(const unsigned long long*)(Tb + o); const unsigned tl = (unsigned)t, th = (unsigned)(t >> 32);
            v = v + (f32x4){__uint_as_float(tl << 16), __uint_as_float(tl & 0xffff0000u), __uint_as_float(th << 16), __uint_as_float(th & 0xffff0000u)}; }
        *(unsigned long long*)((SECOND ? Mg : Tb) + o) = (unsigned long long)cvt_pk_bf16(v[0], v[1]) | ((unsigned long long)cvt_pk_bf16(v[2], v[3]) << 32); }
};
struct SEpiBranch2 {
    const bf16_t* Ga; const bf16_t* Gb; bf16_t* Mg;
    __device__ __forceinline__ void apply2(int row, int col, f32x4 v0, f32x4 v1) const { const size_t o = (size_t)row * 1024 + col;
        const unsigned long long wa = *(const unsigned long long*)(Ga + o), wb = *(const unsigned long long*)(Gb + o); const unsigned al = (unsigned)wa, ah = (unsigned)(wa >> 32), bl = (unsigned)wb, bh = (unsigned)(wb >> 32);
        const f32x4 v = v0 * (f32x4){__uint_as_float(al << 16), __uint_as_float(al & 0xffff0000u), __uint_as_float(ah << 16), __uint_as_float(ah & 0xffff0000u)}
                      + v1 * (f32x4){__uint_as_float(bl << 16), __uint_as_float(bl & 0xffff0000u), __uint_as_float(bh << 16), __uint_as_float(bh & 0xffff0000u)};
        *(unsigned long long*)(Mg + o) = (unsigned long long)cvt_pk_bf16(v[0], v[1]) | ((unsigned long long)cvt_pk_bf16(v[2], v[3]) << 32); }
};
struct EpiMixIn {
    static constexpr bool PERM = true, AFTER_DRAIN = false;
    bf16_t *GQ, *GK, *GV, *GR, *SQ, *SKB, *SVB, *GA, *GB; float *okp, *oks, *ovp, *ovs;
    template <int ACT> __device__ __forceinline__ void store_bf(const f32x4 (&acc)[2][2][4][2], bf16_t* dst, int ld, int row0, int col0, float sc) const {
#pragma unroll
        for (int ai = 0; ai < 2; ++ai)
#pragma unroll
            for (int m = 0; m < 4; ++m) { bf16_t* rp = dst + (size_t)(row0 + ai * HALF + m * 16) * ld + col0;
#pragma unroll
                for (int bj = 0; bj < 2; ++bj) { f32x4 v0 = acc[ai][bj][m][0], v1 = acc[ai][bj][m][1];
                    if (ACT == 1) {
#pragma unroll
                        for (int j = 0; j < 4; ++j) { v0[j] = v0[j] * fast_sigmoid(v0[j]); v1[j] = v1[j] * fast_sigmoid(v1[j]); } }
                    else if (ACT == 2) {
#pragma unroll
                        for (int j = 0; j < 4; ++j) { v0[j] = fast_sigmoid(v0[j]); v1[j] = fast_sigmoid(v1[j]); } }
                    else { v0 = v0 * sc; v1 = v1 * sc; }
                    u32x4 w; w.x = cvt_pk_bf16(v0[0], v0[1]); w.y = cvt_pk_bf16(v0[2], v0[3]); w.z = cvt_pk_bf16(v1[0], v1[1]); w.w = cvt_pk_bf16(v1[2], v1[3]);
                    *(u32x4*)(rp + bj * HALF) = w; } }
    }
    __device__ __forceinline__ void store_f32(const f32x4 (&acc)[2][2][4][2], float* dst, int row0, int col0) const {
#pragma unroll
        for (int ai = 0; ai < 2; ++ai)
#pragma unroll
            for (int m = 0; m < 4; ++m) { float* rp = dst + (size_t)(row0 + ai * HALF + m * 16) * 1024 + col0;
#pragma unroll
                for (int bj = 0; bj < 2; ++bj) { *(f32x4*)(rp + bj * HALF) = acc[ai][bj][m][0]; *(f32x4*)(rp + bj * HALF + 4) = acc[ai][bj][m][1]; } }
    }
    __device__ __forceinline__ void operator()(const f32x4 (&acc)[2][2][4][2], const Unit& u, int wr, int wc, int fr, int fq) const {
        const int pn = u.pn, row0 = u.pm * BM + wr * 64 + fr, cw = wc * 32 + 8 * fq;
        if (pn < 2) store_bf<0>(acc, GQ, 512, row0, pn * 256 + cw, 0.08838834764831845f);
        else if (pn < 4) store_bf<0>(acc, GK, 512, row0, (pn - 2) * 256 + cw, 1.0f);
        else if (pn < 8) store_bf<0>(acc, GV, 1024, row0, (pn - 4) * 256 + cw, 1.0f);
        else if (pn < 12) store_bf<1>(acc, GR, 1024, row0, (pn - 8) * 256 + cw, 1.0f);
        else if (pn < 16) store_bf<0>(acc, SQ, 1024, row0, (pn - 12) * 256 + cw, 0.08838834764831845f * 1.4426950408889634f);
        else if (pn < 20) store_bf<0>(acc, SKB, 1024, row0, (pn - 16) * 256 + cw, 1.0f);
        else if (pn < 24) store_bf<0>(acc, SVB, 1024, row0, (pn - 20) * 256 + cw, 1.0f);
        else if (pn < 28) store_bf<2>(acc, GA, 1024, row0, (pn - 24) * 256 + cw, 1.0f);
        else store_bf<2>(acc, GB, 1024, row0, (pn - 28) * 256 + cw, 1.0f);
    }
};
template <int SECOND> struct EpiBranch {
    static constexpr bool PERM = true, AFTER_DRAIN = false;
    const bf16_t* G; bf16_t* Tb; bf16_t* Mg;
    __device__ __forceinline__ void operator()(const f32x4 (&acc)[2][2][4][2], const Unit& u, int wr, int wc, int fr, int fq) const {
        const int row0 = u.pm * BM + wr * 64 + fr, col0 = u.pn * BM + wc * 32 + 8 * fq;
#pragma unroll
        for (int ai = 0; ai < 2; ++ai)
#pragma unroll
            for (int m = 0; m < 4; ++m) { const size_t ro = (size_t)(row0 + ai * HALF + m * 16) * 1024 + col0;
#pragma unroll
                for (int bj = 0; bj < 2; ++bj) { const u32x4 gw = *(const u32x4*)(G + ro + bj * HALF);
                    f32x4 v0 = acc[ai][bj][m][0], v1 = acc[ai][bj][m][1];
                    v0 = v0 * (f32x4){__uint_as_float(gw.x << 16), __uint_as_float(gw.x & 0xffff0000u), __uint_as_float(gw.y << 16), __uint_as_float(gw.y & 0xffff0000u)};
                    v1 = v1 * (f32x4){__uint_as_float(gw.z << 16), __uint_as_float(gw.z & 0xffff0000u), __uint_as_float(gw.w << 16), __uint_as_float(gw.w & 0xffff0000u)};
                    if (SECOND) { const u32x4 tw = *(const u32x4*)(Tb + ro + bj * HALF);
                        v0 = v0 + (f32x4){__uint_as_float(tw.x << 16), __uint_as_float(tw.x & 0xffff0000u), __uint_as_float(tw.y << 16), __uint_as_float(tw.y & 0xffff0000u)};
                        v1 = v1 + (f32x4){__uint_as_float(tw.z << 16), __uint_as_float(tw.z & 0xffff0000u), __uint_as_float(tw.w << 16), __uint_as_float(tw.w & 0xffff0000u)}; }
                    u32x4 w; w.x = cvt_pk_bf16(v0[0], v0[1]); w.y = cvt_pk_bf16(v0[2], v0[3]); w.z = cvt_pk_bf16(v1[0], v1[1]); w.w = cvt_pk_bf16(v1[2], v1[3]);
                    *(u32x4*)((SECOND ? Mg : Tb) + ro + bj * HALF) = w; } }
    }
};
struct EpiNull {
    static constexpr bool PERM = true, AFTER_DRAIN = false; float* sink;
    __device__ __forceinline__ void operator()(const f32x4 (&acc)[2][2][4][2], const Unit& u, int wr, int wc, int fr, int fq) const {
        f32x4 s = {0.f, 0.f, 0.f, 0.f};
#pragma unroll
        for (int ai = 0; ai < 2; ++ai)
#pragma unroll
            for (int bj = 0; bj < 2; ++bj)
#pragma unroll
                for (int m = 0; m < 4; ++m) { s = s + acc[ai][bj][m][0]; s = s + acc[ai][bj][m][1]; }
        if (s[0] + s[1] + s[2] + s[3] == 12345.678f) sink[0] = s[0];
    }
};
template <class Epi, class Sched, bool ALIGN_EPI = false, bool SP2 = false>
__device__ __forceinline__ void gemm_phase(PG8_LAS unsigned char* lds, const Gemm g, const Sched& S, const Epi& E) {
    int tid_ = threadIdx.x; asm volatile("" : "+v"(tid_));
    const int tid = tid_, wid = __builtin_amdgcn_readfirstlane(tid >> 6), lane = tid & 63, wr = wid >> 2, wc = wid & 3, fr = lane & 15, fq = lane >> 4;
    const int K = g.K, nt = K / BK;
    unsigned voffA[2], voffB[2];
#pragma unroll
    for (int i = 0; i < 2; ++i) { int R, C; stage_rc(tid * 16 + i * 8192, R, C); const int Rb = Epi::PERM ? ((R & ~31) + perm32(R & 31)) : R;
        voffA[i] = (unsigned)(R * K + C) * 2u; voffB[i] = (unsigned)(Rb * K + C) * 2u; }
    const size_t kstep = (size_t)(BK * 2);
    const size_t hstep = (size_t)HALF * K * 2;
    const size_t tstep = 2 * hstep;
    const unsigned ldsw = (unsigned)wid * 1024u;
    const int aoff = lds_byte(wr * 64 + fr, fq * 8), boff = lds_byte(wc * 32 + fr, fq * 8);
#define PG8_SA(b, h) (((b) * 2 + (h)) * HTB)
#define PG8_SB(b, h) ((4 + (b) * 2 + (h)) * HTB)
#define PG8_STAGE(bufoff, gbase, voff) do { _Pragma("unroll") for (int _i = 0; _i < 2; ++_i) \
        __builtin_amdgcn_global_load_lds((const unsigned*)((const char*)(gbase) + (voff)[_i]), (PG8_LAS unsigned*)(lds + (bufoff) + ldsw + _i * 8192), 16, 0, 0); } while (0)
#define PG8_LDA(dst, b, h) do { _Pragma("unroll") for (int m = 0; m < 4; ++m) _Pragma("unroll") for (int k = 0; k < 2; ++k) dst[m][k] = *(const PG8_LAS bf16x8*)(lds + PG8_SA(b, h) + aoff + m * 2048 + k * 1024); } while (0)
#define PG8_LDB(dst, b, h) do { _Pragma("unroll") for (int n = 0; n < 2; ++n) _Pragma("unroll") for (int k = 0; k < 2; ++k) dst[n][k] = *(const PG8_LAS bf16x8*)(lds + PG8_SB(b, h) + boff + n * 2048 + k * 1024); } while (0)
#define PG8_MMA(ai, bj, At, Bt) do { __builtin_amdgcn_s_setprio(1); _Pragma("unroll") for (int m = 0; m < 4; ++m) _Pragma("unroll") for (int n = 0; n < 2; ++n) _Pragma("unroll") for (int k = 0; k < 2; ++k) \
        acc[ai][bj][m][n] = __builtin_amdgcn_mfma_f32_16x16x32_bf16(Bt[n][k], At[m][k], acc[ai][bj][m][n], 0, 0, 0); __builtin_amdgcn_s_setprio(0); } while (0)
#define PG8_WAIT_V(n) asm volatile("s_waitcnt vmcnt(" #n ")" ::: "memory")
#define PG8_WAIT_L(n) asm volatile("s_waitcnt lgkmcnt(" #n ")" ::: "memory")
#define PG8_BAR __builtin_amdgcn_s_barrier()
#define PG8_SCHED __builtin_amdgcn_sched_barrier(0)
    Unit cur, nxt; int ui = 0;
    if (!S.next(0, cur)) return;
    f32x4 acc[2][2][4][2];
#pragma unroll
    for (int a = 0; a < 2; ++a)
#pragma unroll
        for (int b = 0; b < 2; ++b)
#pragma unroll
            for (int m = 0; m < 4; ++m)
#pragma unroll
                for (int n = 0; n < 2; ++n) acc[a][b][m][n] = (f32x4){0.f, 0.f, 0.f, 0.f};
    bf16x8 At[4][2], B0[2][2], B1[2][2];
    const char* cA = (const char*)g.A + (size_t)cur.pm * tstep; const char* cB = (const char*)g.Bt + (size_t)cur.pn * tstep;
    S.a_ready(cur);
    if constexpr (SP2) {
        PG8_STAGE(PG8_SB(0, 0), cB, voffB); PG8_STAGE(PG8_SB(0, 1), cB + hstep, voffB); PG8_STAGE(PG8_SA(0, 0), cA, voffA); PG8_STAGE(PG8_SA(0, 1), cA + hstep, voffA);
        if (wr == 1) PG8_BAR;
        PG8_WAIT_V(2); PG8_BAR;
        PG8_STAGE(PG8_SB(1, 0), cB + kstep, voffB); PG8_STAGE(PG8_SA(1, 0), cA + kstep, voffA); PG8_STAGE(PG8_SB(1, 1), cB + hstep + kstep, voffB);
        PG8_WAIT_V(6); PG8_BAR;
    } else {
        PG8_STAGE(PG8_SB(0, 0), cB, voffB); PG8_STAGE(PG8_SA(0, 0), cA, voffA); PG8_STAGE(PG8_SB(0, 1), cB + hstep, voffB); PG8_STAGE(PG8_SA(0, 1), cA + hstep, voffA);
        if (wr == 1) PG8_BAR;
        PG8_WAIT_V(4); PG8_BAR;
        PG8_STAGE(PG8_SB(1, 0), cB + kstep, voffB); PG8_STAGE(PG8_SA(1, 0), cA + kstep, voffA); PG8_STAGE(PG8_SB(1, 1), cB + hstep + kstep, voffB);
        PG8_WAIT_V(6); PG8_BAR;
    }
    for (;;) {
        const bool has_next = S.next(ui + 1, nxt);
        const char* nA = has_next ? (const char*)g.A + (size_t)nxt.pm * tstep : cA; const char* nB = has_next ? (const char*)g.Bt + (size_t)nxt.pn * tstep : cB;
        for (int t = 0; t < nt; t += 2) {
            const bool last = (t == nt - 2);
            const char* a1 = cA + (size_t)(t + 1) * kstep;
            const char* a2 = last ? nA : cA + (size_t)(t + 2) * kstep; const char* b2 = last ? nB : cB + (size_t)(t + 2) * kstep;
            const char* a3 = a2 + kstep; const char* b3 = b2 + kstep;
            if (last && has_next) S.a_ready(nxt);
            if constexpr (SP2) {
            PG8_LDB(B0, 0, 0); PG8_LDB(B1, 0, 1); PG8_SCHED; PG8_LDA(At, 0, 0); PG8_STAGE(PG8_SA(1, 1), a1 + hstep, voffA);
            PG8_WAIT_V(8); PG8_WAIT_L(0); PG8_BAR; PG8_MMA(0, 0, At, B0); PG8_MMA(0, 1, At, B1); PG8_BAR; PG8_SCHED;
            PG8_LDA(At, 0, 1); PG8_STAGE(PG8_SB(0, 0), b2, voffB); PG8_STAGE(PG8_SB(0, 1), b2 + hstep, voffB); PG8_STAGE(PG8_SA(0, 0), a2, voffA);
            PG8_WAIT_V(8); PG8_WAIT_L(0); PG8_BAR; PG8_MMA(1, 0, At, B0); PG8_MMA(1, 1, At, B1); PG8_BAR; PG8_SCHED;
            PG8_LDB(B0, 1, 0); PG8_LDB(B1, 1, 1); PG8_SCHED; PG8_LDA(At, 1, 0); PG8_STAGE(PG8_SA(0, 1), a2 + hstep, voffA);
            PG8_WAIT_V(8); PG8_WAIT_L(0); PG8_BAR; PG8_MMA(0, 0, At, B0); PG8_MMA(0, 1, At, B1); PG8_BAR; PG8_SCHED;
            PG8_LDA(At, 1, 1); PG8_STAGE(PG8_SB(1, 0), b3, voffB); PG8_STAGE(PG8_SB(1, 1), b3 + hstep, voffB); PG8_STAGE(PG8_SA(1, 0), a3, voffA);
            PG8_WAIT_V(8); PG8_WAIT_L(0); PG8_BAR; PG8_MMA(1, 0, At, B0); PG8_MMA(1, 1, At, B1); PG8_BAR; PG8_SCHED;
            } else {
            PG8_LDB(B0, 0, 0); PG8_SCHED; PG8_LDA(At, 0, 0); PG8_STAGE(PG8_SA(1, 1), a1 + hstep, voffA);
            PG8_WAIT_L(8); PG8_BAR; PG8_WAIT_L(0); PG8_MMA(0, 0, At, B0); PG8_BAR; PG8_SCHED;
            PG8_LDB(B1, 0, 1); PG8_STAGE(PG8_SB(0, 0), b2, voffB);
            PG8_BAR; PG8_WAIT_L(0); PG8_MMA(0, 1, At, B1); PG8_BAR;
            PG8_LDA(At, 0, 1); PG8_STAGE(PG8_SA(0, 0), a2, voffA);
            PG8_BAR; PG8_WAIT_L(0); PG8_MMA(1, 0, At, B0); PG8_BAR; PG8_SCHED;
            PG8_STAGE(PG8_SB(0, 1), b2 + hstep, voffB);
            PG8_WAIT_V(6); PG8_BAR; PG8_MMA(1, 1, At, B1); PG8_BAR;
            PG8_LDB(B0, 1, 0); PG8_SCHED; PG8_LDA(At, 1, 0); PG8_STAGE(PG8_SA(0, 1), a2 + hstep, voffA);
            PG8_WAIT_L(8); PG8_BAR; PG8_WAIT_L(0); PG8_MMA(0, 0, At, B0); PG8_BAR; PG8_SCHED;
            PG8_LDB(B1, 1, 1); PG8_STAGE(PG8_SB(1, 0), b3, voffB);
            PG8_BAR; PG8_WAIT_L(0); PG8_MMA(0, 1, At, B1); PG8_BAR;
            PG8_LDA(At, 1, 1); PG8_STAGE(PG8_SA(1, 0), a3, voffA);
            PG8_BAR; PG8_WAIT_L(0); PG8_MMA(1, 0, At, B0); PG8_BAR; PG8_SCHED;
            PG8_STAGE(PG8_SB(1, 1), b3 + hstep, voffB);
            PG8_WAIT_V(6); PG8_BAR; PG8_MMA(1, 1, At, B1); PG8_BAR;
            }
        }
        if constexpr (ALIGN_EPI) { if (wr == 0) PG8_BAR; }
        if constexpr (!Epi::AFTER_DRAIN) { E(acc, cur, wr, wc, fr, fq); S.done(cur); }
        if (!has_next) break;
#pragma unroll
        for (int a = 0; a < 2; ++a)
#pragma unroll
            for (int b = 0; b < 2; ++b)
#pragma unroll
                for (int m = 0; m < 4; ++m)
#pragma unroll
                    for (int n = 0; n < 2; ++n) acc[a][b][m][n] = (f32x4){0.f, 0.f, 0.f, 0.f};
        cur = nxt; cA = nA; cB = nB; ++ui;
        if constexpr (ALIGN_EPI) { if (wr == 1) PG8_BAR; }
    }
    PG8_WAIT_V(0);
    if constexpr (!ALIGN_EPI) { if (wr == 0) PG8_BAR; }
    PG8_BAR;
    if constexpr (Epi::AFTER_DRAIN) { E.fused(acc, cur, wr, wc, fr, fq, lds, wid, lane); S.done(cur); }
#undef PG8_SA
#undef PG8_SB
#undef PG8_STAGE
#undef PG8_LDA
#undef PG8_LDB
#undef PG8_MMA
#undef PG8_WAIT_V
#undef PG8_WAIT_L
#undef PG8_BAR
#undef PG8_SCHED
}
}
constexpr int NWAVES = 8;
constexpr int DM = 1024, MP = 16384, MS = 2048, MT = MP + MS, DFF = 2816, NIN = 8192, TSEQ = 8192, NCHP = 128  ;
constexpr float LN_EPS = 1e-5f;
constexpr float DN_ALPHA = 1.189207115002721f;
constexpr float LOG2E = 1.4426950408889634f;
constexpr size_t O_Y = 0, O_SGP = 18874368, O_KP = 19136512, O_VP = 35913728, O_SGS = 52690944, O_KS = 56885248, O_VS = 58982400, O_END = 61079552;
constexpr size_t MiB = 1u << 20;
constexpr size_t WS_CTL = 0, CTL_ZERO_BYTES = 32768;
constexpr size_t WS_W1IN = 2 * MiB, WS_W1OUT = 13 * MiB, WS_WIN = 19 * MiB, WS_WGLAO = 35 * MiB, WS_WSBO = 37 * MiB, WS_WOUT = 39 * MiB, WS_W2IN = 41 * MiB, WS_W2OUT = 52 * MiB;
constexpr size_t WS_XB = 64 * MiB, WS_HB = 100 * MiB, WS_ACT = 136 * MiB, WS_R = 236 * MiB, WS_H = 308 * MiB;
constexpr size_t WS_GQ = 380 * MiB, WS_GK = 398 * MiB, WS_GV = 416 * MiB, WS_GR = 452 * MiB, WS_SQ = 488 * MiB, WS_SKB = 524 * MiB, WS_SVB = 556 * MiB, WS_GA = 588 * MiB, WS_GB = 624 * MiB;
constexpr size_t WS_B2 = 660 * MiB, WS_DS = 696 * MiB, WS_STS = 824 * MiB, WS_OA = 888 * MiB, WS_OB = 924 * MiB, WS_MG = 960 * MiB, WS_SKB2 = 996 * MiB, WS_SVB2 = 1032 * MiB, WS_END = 1068 * MiB;
constexpr int CW_TMO = 0, CW_BAR = 4096;
constexpr int RING_OFF = 0, RING_BYTES = 131072;
constexpr int LDS_BYTES = 147456;
constexpr int MISC_OFF = LDS_BYTES - 256;
#define GAS __attribute__((address_space(1)))
#define LAS __attribute__((address_space(3)))
typedef unsigned short bf16;
typedef unsigned v4u __attribute__((ext_vector_type(4)));
typedef float f32x4 __attribute__((ext_vector_type(4)));
typedef short bf16x8 __attribute__((ext_vector_type(8)));
typedef GAS unsigned gu32;
typedef GAS unsigned long long gu64;
#define RLX_AGENT __ATOMIC_RELAXED, __HIP_MEMORY_SCOPE_AGENT
#define LDS_WAIT() asm volatile("s_waitcnt lgkmcnt(0)" ::: "memory")
#define VM_WAIT() asm volatile("s_waitcnt vmcnt(0)" ::: "memory")
__device__ __forceinline__ unsigned long long rt() { return __builtin_amdgcn_s_memrealtime(); }
__device__ __forceinline__ unsigned f2bf(float f) { unsigned u = __builtin_bit_cast(unsigned, f); return (u + 0x7fffu + ((u >> 16) & 1u)) >> 16; }
__device__ __forceinline__ unsigned pk2(float lo, float hi) { return f2bf(lo) | (f2bf(hi) << 16); }

#define XB_TMO      128
#define XB_XCNT(j)  (256  + 64 * (j))
#define XB_XSUB(j)  (1280 + 64 * (j))
#define XB_XGEN(j)  (2304 + 64 * (j))
#define XB_TOP      3328
#define XB_TOPGEN   3392
#define XCD_BAR_WORDS 3456
#define XB_SPIN_CAP (1u << 18)

__device__ __forceinline__ unsigned xb_ld(unsigned* p)              { return __hip_atomic_load(p, __ATOMIC_RELAXED, __HIP_MEMORY_SCOPE_AGENT); }
__device__ __forceinline__ unsigned xb_add(unsigned* p, unsigned v) { return __hip_atomic_fetch_add(p, v, __ATOMIC_RELAXED, __HIP_MEMORY_SCOPE_AGENT); }
__device__ __forceinline__ unsigned xb_xcc_id() { return (unsigned)__builtin_amdgcn_s_getreg((3 << 11) | 20) & 0xFu; }
#define XB_SPIN(cond, bar) do { unsigned _sp = 0; while (cond) { __builtin_amdgcn_s_sleep(1); \
    if ((++_sp & 255u) == 0u) { if (xb_ld(&(bar)[XB_TMO])) break; if (_sp > XB_SPIN_CAP) { atomicAdd(&(bar)[XB_TMO], 1u); break; } } } } while (0)

struct XcdBarrier {
    unsigned* bar; unsigned x;
    volatile LAS unsigned* st;
};

__device__ __forceinline__ XcdBarrier xcd_barrier_post(unsigned* bar, volatile LAS unsigned* st) {
    XcdBarrier b; b.bar = bar; b.x = xb_xcc_id(); b.st = st;
    if (threadIdx.x == 0) (void)xb_add(&bar[XB_XCNT(b.x)], 1u);
    return b;
}
__device__ __forceinline__ void xcd_barrier_complete(unsigned* bar, unsigned x, unsigned& nloc, unsigned& nx) {
    const unsigned G = gridDim.x * gridDim.y * gridDim.z;
    unsigned sum, cnt, mine, sp = 0u;
    for (;;) {
        sum = 0u; cnt = 0u; mine = 0u;
#pragma unroll
        for (unsigned j = 0; j < 16; ++j) { const unsigned c = xb_ld(&bar[XB_XCNT(j)]); sum += c; cnt += (c > 0u) ? 1u : 0u; mine = (j == x) ? c : mine; }
        if (sum == G) break;
        __builtin_amdgcn_s_sleep(1);
        if ((++sp & 255u) == 0u) { if (xb_ld(&bar[XB_TMO])) break; if (sp > XB_SPIN_CAP) { atomicAdd(&bar[XB_TMO], 1u); break; } }
    }
    nloc = mine > 0u ? mine : 1u; nx = cnt > 0u ? cnt : 1u;
}

__device__ __forceinline__ void xcd_barrier(const XcdBarrier& b) {
    asm volatile("s_waitcnt vmcnt(0)" ::: "memory");
    __syncthreads();
    if (threadIdx.x == 0) {
        unsigned* bar = b.bar;
        __builtin_amdgcn_s_waitcnt(0);
        unsigned nloc = b.st[0], nx = b.st[1];
        if (nloc == 0u) { xcd_barrier_complete(bar, b.x, nloc, nx); b.st[0] = nloc; b.st[1] = nx; }
        const unsigned old = xb_add(&bar[XB_XSUB(b.x)], 1u);
        const unsigned gen = old / nloc;
        if (old + 1u == (gen + 1u) * nloc) {
            __builtin_amdgcn_fence(__ATOMIC_RELEASE, "agent");
            asm volatile("s_waitcnt vmcnt(0)" ::: "memory");
            const unsigned og = xb_add(&bar[XB_TOP], 1u);
            const unsigned tg = og / nx;
            if (og + 1u == (tg + 1u) * nx) xb_add(&bar[XB_TOPGEN], 1u);
            else XB_SPIN(xb_ld(&bar[XB_TOPGEN]) == tg, bar);
            __builtin_amdgcn_fence(__ATOMIC_ACQUIRE, "agent");
            xb_add(&bar[XB_XGEN(b.x)], 1u);
            asm volatile("s_waitcnt vmcnt(0)" ::: "memory");
        } else {
            XB_SPIN(xb_ld(&bar[XB_XGEN(b.x)]) == gen, bar);
            __builtin_amdgcn_fence(__ATOMIC_ACQUIRE, "agent");
            asm volatile("s_waitcnt vmcnt(0)" ::: "memory");
        }
    }
    __syncthreads();
}
#ifdef TP_A
#define TSTAMP(k, lds_, tid_) do { if (blockIdx.x == 0 && ((k) == TP_A || (k) == TP_B)) { volatile LAS unsigned* M_ = (volatile LAS unsigned*)((lds_) + MISC_OFF); if ((tid_) == 0) { const unsigned long long t_ = __builtin_amdgcn_s_memrealtime(); \
        if ((k) == TP_A) { M_[16] = (unsigned)t_; M_[17] = (unsigned)(t_ >> 32); } \
        if ((k) == TP_B) { const unsigned long long t0_ = ((unsigned long long)M_[17] << 32) | (unsigned long long)M_[16]; const unsigned long long dl_ = t_ + (unsigned long long)TMULT * (t_ - t0_); \
            while (__builtin_amdgcn_s_memrealtime() < dl_) __builtin_amdgcn_s_sleep(8); } } \
        if ((k) == TP_B) __syncthreads(); } } while (0)
#else
#define TSTAMP(k, lds_, tid_) do { } while (0)
#endif
#define WG_BAR() do { asm volatile("s_waitcnt lgkmcnt(0)" ::: "memory"); __builtin_amdgcn_s_barrier(); asm volatile("" ::: "memory"); } while (0)
#define MFMA32(a, b, c) __builtin_amdgcn_mfma_f32_32x32x16_bf16((a), (b), (c), 0, 0, 0)
typedef float f32x16 __attribute__((ext_vector_type(16)));
typedef short s16x4 __attribute__((ext_vector_type(4)));
typedef unsigned u32x2 __attribute__((ext_vector_type(2)));
typedef float f32x2v __attribute__((ext_vector_type(2)));
typedef unsigned u32x4 __attribute__((ext_vector_type(4)));
__device__ __forceinline__ float wave_sum(float v) {
#pragma unroll
    for (int o = 1; o < 64; o <<= 1) v += __shfl_xor(v, o);
    return v;
}
__device__ __forceinline__ float bf_lo(unsigned w) { return __uint_as_float(w << 16); }
__device__ __forceinline__ float bf_hi(unsigned w) { return __uint_as_float(w & 0xffff0000u); }
typedef __bf16 bf16x2_t __attribute__((ext_vector_type(2)));
__device__ __forceinline__ unsigned cvtpk(float lo, float hi) { const f32x2v v = {lo, hi}; const bf16x2_t b = __builtin_convertvector(v, bf16x2_t); return __builtin_bit_cast(unsigned, b); }
__device__ __forceinline__ int crow(int r, int hi) { return (r & 3) + 8 * (r >> 2) + 4 * hi; }
__device__ __forceinline__ void p0_transpose_item(const float* W, int ldw, int col0, bf16* WT, int K, int row0, int k0, LAS float* scr, int lane) {
#pragma unroll 8
    for (int i = 0; i < 32; ++i) { const int kk = 2 * i + (lane >> 5); scr[kk * 33 + (lane & 31)] = W[(size_t)(k0 + kk) * ldw + col0 + (lane & 31)]; }
    LDS_WAIT(); asm volatile("" ::: "memory");
    const int c = lane & 7;
#pragma unroll
    for (int j = 0; j < 4; ++j) { const int n = (lane >> 3) + 8 * j; const LAS float* s = scr + (8 * c) * 33 + n;
        v4u o; o.x = pk2(s[0 * 33], s[1 * 33]); o.y = pk2(s[2 * 33], s[3 * 33]); o.z = pk2(s[4 * 33], s[5 * 33]); o.w = pk2(s[6 * 33], s[7 * 33]);
        *(GAS v4u*)(WT + (size_t)(row0 + n) * K + k0 + 8 * c) = o; }
    LDS_WAIT(); asm volatile("" ::: "memory");
}
template <int MODE> __device__ __forceinline__ void p0_weight(const float* W, int ldw, int K, int NOUT, bf16* WT, LAS float* scr, int lane, int gw, int NGW, int& itbase) {
    const int nblk = NOUT / 32, nitems = (K / 64) * nblk;
    int it = gw - (itbase % NGW); if (it < 0) it += NGW;
    for (; it < nitems; it += NGW) { const int kb = it / nblk, nb = it % nblk, n0 = 32 * nb; int c0 = n0;
        if (MODE == 1) { const int pn = n0 >> 8, s = (n0 >> 7) & 1, i = n0 & 127; c0 = s * DFF + 128 * pn + i; }
        if (MODE == 2) { c0 = n0 < 3072 ? n0 : n0 + 16; }
        p0_transpose_item(W, ldw, c0, WT, K, n0, 64 * kb, scr, lane); }
    itbase += nitems;
}
__device__ __forceinline__ void row_to_bf16(const float* xrow, bf16* orow, int lane) {
    const GAS f32x4* xr = (const GAS f32x4*)xrow + lane; GAS unsigned long long* o8 = (GAS unsigned long long*)orow + lane;
#pragma unroll
    for (int j = 0; j < 4; ++j) { const f32x4 v = xr[64 * j]; o8[64 * j] = (unsigned long long)pk2(v.x, v.y) | ((unsigned long long)pk2(v.z, v.w) << 32); }
}
__device__ __forceinline__ void ln_row(f32x4 (&v)[4], const f32x4 (&g)[4], const f32x4 (&b)[4]) {
    float s = 0.f;
#pragma unroll
    for (int j = 0; j < 4; ++j) s += (v[j].x + v[j].y) + (v[j].z + v[j].w);
    const float mean = wave_sum(s) * (1.f / DM); float s2 = 0.f;
#pragma unroll
    for (int j = 0; j < 4; ++j) { v[j] = v[j] - mean; s2 += (v[j].x * v[j].x + v[j].y * v[j].y) + (v[j].z * v[j].z + v[j].w * v[j].w); }
    const float rstd = 1.f / sqrtf(wave_sum(s2) * (1.f / DM) + LN_EPS);
#pragma unroll
    for (int j = 0; j < 4; ++j) v[j] = v[j] * rstd * g[j] + b[j];
}
constexpr int SG_S = 272, SG_A = 0, SG_B = 64 * 272, SG_BUF = 192 * 272;
template <class Epi> __device__ __forceinline__ void sgemm_unit(LAS unsigned char* lds, const bf16* A, const bf16* Bt, int K, int unit, const Epi& E) {
    int tid = threadIdx.x; asm volatile("" : "+v"(tid));
    const int lane = tid & 63, wave = __builtin_amdgcn_readfirstlane(tid >> 6), r32 = lane & 31, hi = lane >> 5, wm = wave >> 2, wn = wave & 3, mt = unit >> 3, nt = unit & 7, lr = tid >> 3, lc = tid & 7;
    const GAS u32x4* pa = (const GAS u32x4*)(A + (size_t)(64 * mt + lr) * K) + lc;
    const GAS u32x4* pb0 = (const GAS u32x4*)(Bt + (size_t)(128 * nt + lr) * K) + lc;
    const GAS u32x4* pb1 = (const GAS u32x4*)(Bt + (size_t)(128 * nt + 64 + lr) * K) + lc;
    const int wo = lr * SG_S + lc * 16;
    u32x4 a0_0, a1_0, b0_0, b1_0, b2_0, b3_0, a0_1, a1_1, b0_1, b1_1, b2_1, b3_1, a0_2, a1_2, b0_2, b1_2, b2_2, b3_2, a0_3, a1_3, b0_3, b1_3, b2_3, b3_3;
    const int nk = K / 128;
#define SG_LOAD(S, T) do { a0_##S = pa[16 * (T)]; a1_##S = pa[16 * (T) + 8]; b0_##S = pb0[16 * (T)]; b1_##S = pb0[16 * (T) + 8]; b2_##S = pb1[16 * (T)]; b3_##S = pb1[16 * (T) + 8]; } while (0)
#define SG_WRITE(S, BUF) do { LAS unsigned char* nb_ = lds + (BUF) * SG_BUF; *(LAS u32x4*)(nb_ + SG_A + wo) = a0_##S; *(LAS u32x4*)(nb_ + SG_A + wo + 128) = a1_##S; \
        *(LAS u32x4*)(nb_ + SG_B + wo) = b0_##S; *(LAS u32x4*)(nb_ + SG_B + wo + 128) = b1_##S; *(LAS u32x4*)(nb_ + SG_B + 64 * SG_S + wo) = b2_##S; *(LAS u32x4*)(nb_ + SG_B + 64 * SG_S + wo + 128) = b3_##S; } while (0)
#define SG_COMPUTE(BUF) do { const LAS unsigned char* ab_ = lds + (BUF) * SG_BUF + SG_A + (32 * wm + r32) * SG_S + hi * 16; const LAS unsigned char* bb_ = lds + (BUF) * SG_BUF + SG_B + (32 * wn + r32) * SG_S + hi * 16; \
        _Pragma("unroll") for (int ks = 0; ks < 8; ++ks) { const bf16x8 a_ = *(const LAS bf16x8*)(ab_ + ks * 32), b_ = *(const LAS bf16x8*)(bb_ + ks * 32); acc = MFMA32(b_, a_, acc); } } while (0)
#define SG_STEP(I, SL, SW) do { if (kt + (I) + 3 < nk) SG_LOAD(SL, kt + (I) + 3); SG_COMPUTE((I) & 1); if (kt + (I) + 1 < nk) SG_WRITE(SW, ((I) + 1) & 1); WG_BAR(); } while (0)
    SG_LOAD(0, 0); SG_LOAD(1, 1); if (2 < nk) SG_LOAD(2, 2);
    SG_WRITE(0, 0);
    WG_BAR();
    f32x16 acc;
#pragma unroll
    for (int r = 0; r < 16; ++r) acc[r] = 0.f;
    for (int kt = 0; kt < nk; kt += 4) {
        SG_STEP(0, 3, 1);
        if (kt + 1 < nk) SG_STEP(1, 0, 2);
        if (kt + 2 < nk) SG_STEP(2, 1, 3);
        if (kt + 3 < nk) SG_STEP(3, 2, 0);
    }
#undef SG_STEP
#undef SG_LOAD
#undef SG_WRITE
#undef SG_COMPUTE
    const int row = 64 * mt + 32 * wm + r32, col0 = 128 * nt + 32 * wn + 4 * hi;
#pragma unroll
    for (int g = 0; g < 4; ++g) E.apply(row, col0 + 8 * g, (f32x4){acc[4 * g], acc[4 * g + 1], acc[4 * g + 2], acc[4 * g + 3]});
}

template <class Epi> __device__ __forceinline__ void sgemm_unit2(LAS unsigned char* lds, const bf16* A0, const bf16* Bt0, const bf16* A1, const bf16* Bt1, int unit, const Epi& E) {
    int tid = threadIdx.x; asm volatile("" : "+v"(tid));
    const int lane = tid & 63, wave = __builtin_amdgcn_readfirstlane(tid >> 6), r32 = lane & 31, hi = lane >> 5, wm = wave >> 2, wn = wave & 3, mt = unit >> 3, nt = unit & 7, lr = tid >> 3, lc = tid & 7;
    constexpr int K = 1024, nk1 = 8, nk = 16;
    const unsigned oa = (unsigned)(64 * mt + lr) * K + 8u * lc, ob0 = (unsigned)(128 * nt + lr) * K + 8u * lc, ob1 = ob0 + 64u * K;
    const int wo = lr * SG_S + lc * 16;
    u32x4 a0_0, a1_0, b0_0, b1_0, b2_0, b3_0, a0_1, a1_1, b0_1, b1_1, b2_1, b3_1, a0_2, a1_2, b0_2, b1_2, b2_2, b3_2, a0_3, a1_3, b0_3, b1_3, b2_3, b3_3;
#define SG_LOAD(S, T) do { const int t_ = (T); const bf16* A_ = t_ < nk1 ? A0 : A1; const bf16* B_ = t_ < nk1 ? Bt0 : Bt1; const unsigned ko_ = 128u * (unsigned)(t_ & (nk1 - 1)); \
        const GAS u32x4* pa_ = (const GAS u32x4*)(A_ + (oa + ko_)); const GAS u32x4* pb0_ = (const GAS u32x4*)(B_ + (ob0 + ko_)); const GAS u32x4* pb1_ = (const GAS u32x4*)(B_ + (ob1 + ko_)); \
        a0_##S = pa_[0]; a1_##S = pa_[8]; b0_##S = pb0_[0]; b1_##S = pb0_[8]; b2_##S = pb1_[0]; b3_##S = pb1_[8]; } while (0)
#define SG_WRITE(S, BUF) do { LAS unsigned char* nb_ = lds + (BUF) * SG_BUF; *(LAS u32x4*)(nb_ + SG_A + wo) = a0_##S; *(LAS u32x4*)(nb_ + SG_A + wo + 128) = a1_##S; \
        *(LAS u32x4*)(nb_ + SG_B + wo) = b0_##S; *(LAS u32x4*)(nb_ + SG_B + wo + 128) = b1_##S; *(LAS u32x4*)(nb_ + SG_B + 64 * SG_S + wo) = b2_##S; *(LAS u32x4*)(nb_ + SG_B + 64 * SG_S + wo + 128) = b3_##S; } while (0)
#define SG_COMPUTE(BUF, ACC) do { const LAS unsigned char* ab_ = lds + (BUF) * SG_BUF + SG_A + (32 * wm + r32) * SG_S + hi * 16; const LAS unsigned char* bb_ = lds + (BUF) * SG_BUF + SG_B + (32 * wn + r32) * SG_S + hi * 16; \
        _Pragma("unroll") for (int ks = 0; ks < 8; ++ks) { const bf16x8 a_ = *(const LAS bf16x8*)(ab_ + ks * 32), b_ = *(const LAS bf16x8*)(bb_ + ks * 32); ACC = MFMA32(b_, a_, ACC); } } while (0)
#define SG_STEP(I, SL, SW, ACC) do { if (kt + (I) + 3 < nk) SG_LOAD(SL, kt + (I) + 3); SG_COMPUTE((I) & 1, ACC); if (kt + (I) + 1 < nk) SG_WRITE(SW, ((I) + 1) & 1); WG_BAR(); } while (0)
    SG_LOAD(0, 0); SG_LOAD(1, 1); SG_LOAD(2, 2);
    SG_WRITE(0, 0);
    WG_BAR();
    f32x16 acc0, acc1;
#pragma unroll
    for (int r = 0; r < 16; ++r) { acc0[r] = 0.f; acc1[r] = 0.f; }
#pragma unroll 1
    for (int kt = 0; kt < nk1; kt += 4) { SG_STEP(0, 3, 1, acc0); SG_STEP(1, 0, 2, acc0); SG_STEP(2, 1, 3, acc0); SG_STEP(3, 2, 0, acc0); }
#pragma unroll 1
    for (int kt = nk1; kt < nk; kt += 4) { SG_STEP(0, 3, 1, acc1); SG_STEP(1, 0, 2, acc1); SG_STEP(2, 1, 3, acc1); SG_STEP(3, 2, 0, acc1); }
#undef SG_STEP
#undef SG_LOAD
#undef SG_WRITE
#undef SG_COMPUTE
    const int row = 64 * mt + 32 * wm + r32, col0 = 128 * nt + 32 * wn + 4 * hi;
#pragma unroll
    for (int g = 0; g < 4; ++g) E.apply2(row, col0 + 8 * g, (f32x4){acc0[4 * g], acc0[4 * g + 1], acc0[4 * g + 2], acc0[4 * g + 3]}, (f32x4){acc1[4 * g], acc1[4 * g + 1], acc1[4 * g + 2], acc1[4 * g + 3]});
}
__device__ __forceinline__ void ln_load_row(f32x4 (&v)[4], const bf16* Rrow, int lane) {
#pragma unroll
    for (int j2 = 0; j2 < 2; ++j2) { const u32x4 w = ((const GAS u32x4*)Rrow)[64 * j2 + lane];
        v[2 * j2] = (f32x4){bf_lo(w.x), bf_hi(w.x), bf_lo(w.y), bf_hi(w.y)}; v[2 * j2 + 1] = (f32x4){bf_lo(w.z), bf_hi(w.z), bf_lo(w.w), bf_hi(w.w)}; }
}
__device__ __forceinline__ void ln_store_row_bf16(const f32x4 (&v)[4], bf16* Orow, int lane) {
#pragma unroll
    for (int j2 = 0; j2 < 2; ++j2) ((GAS u32x4*)Orow)[64 * j2 + lane] = (u32x4){cvtpk(v[2 * j2].x, v[2 * j2].y), cvtpk(v[2 * j2].z, v[2 * j2].w), cvtpk(v[2 * j2 + 1].x, v[2 * j2 + 1].y), cvtpk(v[2 * j2 + 1].z, v[2 * j2 + 1].w)};
}
constexpr int LW_S = 2064;
__device__ __forceinline__ void ln1_phase(LAS unsigned char* lds, const bf16* R, bf16* HB, float* GLR, const float* g_ln, const float* b_ln, const float* w_in, int vcu, int G, int tid, int lane, int wave) {
    asm volatile("" : "+v"(tid)); lane = tid & 63;
    LAS unsigned char* WH = lds; LAS unsigned char* WL = lds + 16 * LW_S; LAS float* GAM = (LAS float*)(lds + 32 * LW_S); LAS float* BET = GAM + 1024;
    for (int e = tid; e < 16384; e += 512) { const int k = e >> 4, i = e & 15; const float w = w_in[(size_t)k * 8208 + 3072 + i]; const unsigned hb = cvtpk(w, 0.f) & 0xffffu;
        *(LAS unsigned short*)(WH + i * LW_S + k * 2) = (unsigned short)hb; *(LAS unsigned short*)(WL + i * LW_S + k * 2) = (unsigned short)(cvtpk(w - __uint_as_float(hb << 16), 0.f) & 0xffffu); }
    for (int e = tid; e < 1024; e += 512) { GAM[e] = g_ln[e]; BET[e] = b_ln[e]; }
    LDS_WAIT(); __syncthreads();
    const int r = lane & 15, g = lane >> 4;
    for (int bt = vcu + G * wave; bt < MT / 16; bt += G * NWAVES) {
        const int m0 = bt * 16;
        const GAS u32x4* rp = (const GAS u32x4*)(R + (size_t)(m0 + r) * DM + 8 * g);
        float sum = 0.f, sq = 0.f;
#pragma unroll 8
        for (int s = 0; s < 32; ++s) { const u32x4 w = rp[4 * s];
#pragma unroll
            for (int j = 0; j < 4; ++j) { const float a = bf_lo(w[j]), c = bf_hi(w[j]); sum += a + c; sq += a * a + c * c; } }
        sum += __shfl_xor(sum, 16); sq += __shfl_xor(sq, 16); sum += __shfl_xor(sum, 32); sq += __shfl_xor(sq, 32);
        const float mean = sum * (1.f / DM), rstd = 1.f / sqrtf(fmaxf(sq * (1.f / DM) - mean * mean, 0.f) + LN_EPS);
        f32x4 acc = {0.f, 0.f, 0.f, 0.f};
        GAS u32x4* hp = (GAS u32x4*)(HB + (size_t)(m0 + r) * DM + 8 * g);
#pragma unroll 4
        for (int s = 0; s < 32; ++s) { const u32x4 w = rp[4 * s]; const int c0 = 32 * s + 8 * g;
            const f32x4 ga = *(const LAS f32x4*)(GAM + c0), gb = *(const LAS f32x4*)(GAM + c0 + 4), ba = *(const LAS f32x4*)(BET + c0), bb = *(const LAS f32x4*)(BET + c0 + 4);
            u32x4 hw;
            hw[0] = cvtpk((bf_lo(w[0]) - mean) * rstd * ga[0] + ba[0], (bf_hi(w[0]) - mean) * rstd * ga[1] + ba[1]);
            hw[1] = cvtpk((bf_lo(w[1]) - mean) * rstd * ga[2] + ba[2], (bf_hi(w[1]) - mean) * rstd * ga[3] + ba[3]);
            hw[2] = cvtpk((bf_lo(w[2]) - mean) * rstd * gb[0] + bb[0], (bf_hi(w[2]) - mean) * rstd * gb[1] + bb[1]);
            hw[3] = cvtpk((bf_lo(w[3]) - mean) * rstd * gb[2] + bb[2], (bf_hi(w[3]) - mean) * rstd * gb[3] + bb[3]);
            hp[4 * s] = hw;
            const bf16x8 af = __builtin_bit_cast(bf16x8, hw);
            const bf16x8 bh = *(const LAS bf16x8*)(WH + r * LW_S + c0 * 2), bl = *(const LAS bf16x8*)(WL + r * LW_S + c0 * 2);
            acc = __builtin_amdgcn_mfma_f32_16x16x32_bf16(af, bh, acc, 0, 0, 0); acc = __builtin_amdgcn_mfma_f32_16x16x32_bf16(af, bl, acc, 0, 0, 0); }
#pragma unroll
        for (int q = 0; q < 4; ++q) GLR[(size_t)(m0 + 4 * g + q) * 16 + r] = acc[q];
    }
}
template <int FINAL> __device__ __forceinline__ void ln_phase(const bf16* R, float* Y, bf16* HB, const float* g_ln, const float* b_ln, int gw, int NGW, int lane) {
    { int t_ = threadIdx.x; asm volatile("" : "+v"(t_)); lane = t_ & 63; }
    f32x4 g[4], b[4];
#pragma unroll
    for (int j = 0; j < 4; ++j) { g[j] = ((const GAS f32x4*)g_ln)[128 * (j >> 1) + 2 * lane + (j & 1)]; b[j] = ((const GAS f32x4*)b_ln)[128 * (j >> 1) + 2 * lane + (j & 1)]; }
    f32x4 v[4];
    int row = gw;
    if (row < MT) ln_load_row(v, R + (size_t)row * DM, lane);
    for (; row < MT; row += NGW) {
        f32x4 nv[4]; const int nrow = row + NGW;
        if (nrow < MT) ln_load_row(nv, R + (size_t)nrow * DM, lane);
        ln_row(v, g, b);
        if (FINAL) {
#pragma unroll
            for (int j = 0; j < 4; ++j) ((GAS f32x4*)(Y + (size_t)row * DM))[128 * (j >> 1) + 2 * lane + (j & 1)] = v[j]; }
        else ln_store_row_bf16(v, HB + (size_t)row * DM, lane);
#pragma unroll
        for (int j = 0; j < 4; ++j) v[j] = nv[j];
    }
}
constexpr int QT_OFF = 0, QT_S = 272, KT_OFF = 17408, KT_S = 272, PT_OFF = KT_OFF, PT_S = 144, RED_OFF = KT_OFF + 9216, KD_OFF = 34816, KD_S = 320, VT_OFF = 55296, VT_S = 576, LB_OFF = 92160, LB_S = 528, WU_OFF = 125952;
static_assert(WU_OFF + 8192 <= MISC_OFF, "GLA LDS map");
typedef short v4i16_t __attribute__((ext_vector_type(4)));
__device__ __forceinline__ bf16x8 frag_row(const LAS unsigned char* base, int S, int row, int kcol) { return *(const LAS bf16x8*)(base + row * S + kcol * 2); }
__device__ __forceinline__ s16x4 tr4(const LAS unsigned char* p) { return __builtin_bit_cast(s16x4, __builtin_amdgcn_ds_read_tr16_b64_v4i16((LAS v4i16_t*)p)); }
__device__ __forceinline__ bf16x8 frag_tr(const LAS unsigned char* base, int S, int k0, int c0, int lane) {
    const int hi = lane >> 5, blk = (lane >> 4) & 1, q = (lane & 15) >> 2, p = lane & 3;
    const LAS unsigned char* a = base + (k0 + 8 * hi + q) * S + (c0 + 16 * blk + 4 * p) * 2;
    const s16x4 lo = tr4(a), h4 = tr4(a + 4 * S);
    return (bf16x8){lo[0], lo[1], lo[2], lo[3], h4[0], h4[1], h4[2], h4[3]};
}
struct GlaIn { f32x4 glr[4]; u32x4 q0, q1, k0, k1, v[4]; };
template <bool WITH_Q> __device__ __forceinline__ void gla_load(GlaIn& x, const bf16* GQ, const bf16* GK, const bf16* GV, const float* GLR, int m0, int h, int tid) {
    const int row = tid >> 3, cs = tid & 7; const unsigned go = (unsigned)(m0 + row) * 512u + (unsigned)(h * 128 + 16 * cs);
    { const int l_ = tid & 63;
#pragma unroll
      for (int i = 0; i < 4; ++i) x.glr[i] = *(const GAS f32x4*)(GLR + ((unsigned)(m0 + 32 * (i >> 1) + (l_ & 31)) * 16u + (unsigned)(8 * (l_ >> 5) + 4 * (i & 1)))); }
    const GAS u32x4* kp = (const GAS u32x4*)(GK + go); x.k0 = kp[0]; x.k1 = kp[1];
    if (WITH_Q) { const GAS u32x4* qp = (const GAS u32x4*)(GQ + go); x.q0 = qp[0]; x.q1 = qp[1]; }
    const GAS u32x4* vp = (const GAS u32x4*)(GV + ((unsigned)(m0 + row) * 1024u + (unsigned)(h * 256 + 32 * cs)));
#pragma unroll
    for (int i = 0; i < 4; ++i) x.v[i] = vp[i];
}
struct GlaGate { bf16x8 whi, wlo; float bias; };
__device__ __forceinline__ void gla_gate_init(GlaGate& gt, const float* w_up, const float* b_gate, int h, int lane, int wave) {
    const int col = h * 128 + 32 * (wave >> 1) + (lane & 31), k0 = 8 * (lane >> 5); float w[8], l[8];
#pragma unroll
    for (int j = 0; j < 8; ++j) { w[j] = ((const GAS float*)w_up)[(k0 + j) * 512 + col]; const unsigned hb = cvtpk(w[j], 0.f) & 0xffffu; l[j] = w[j] - __uint_as_float(hb << 16); }
    gt.whi = __builtin_bit_cast(bf16x8, ((u32x4){cvtpk(w[0], w[1]), cvtpk(w[2], w[3]), cvtpk(w[4], w[5]), cvtpk(w[6], w[7])}));
    gt.wlo = __builtin_bit_cast(bf16x8, ((u32x4){cvtpk(l[0], l[1]), cvtpk(l[2], l[3]), cvtpk(l[4], l[5]), cvtpk(l[6], l[7])}));
    gt.bias = ((const GAS float*)b_gate)[col];
}
__device__ __forceinline__ void gla_lb_tile(LAS unsigned char* lds, const GlaIn& x, const GlaGate& gt, int lane, int wave) {
    const int r32 = lane & 31, hi = lane >> 5, tbw = wave & 1, cb = wave >> 1;
    float base = 0.f;
#pragma unroll
    for (int tbb = 0; tbb < 2; ++tbb) {
        const f32x4 g0 = x.glr[2 * tbb], g1 = x.glr[2 * tbb + 1]; const float gv[8] = {g0.x, g0.y, g0.z, g0.w, g1.x, g1.y, g1.z, g1.w}; float gl[8];
#pragma unroll
        for (int j = 0; j < 8; ++j) { const unsigned hb = cvtpk(gv[j], 0.f) & 0xffffu; gl[j] = gv[j] - __uint_as_float(hb << 16); }
        const bf16x8 ahi = __builtin_bit_cast(bf16x8, ((u32x4){cvtpk(gv[0], gv[1]), cvtpk(gv[2], gv[3]), cvtpk(gv[4], gv[5]), cvtpk(gv[6], gv[7])}));
        const bf16x8 alo = __builtin_bit_cast(bf16x8, ((u32x4){cvtpk(gl[0], gl[1]), cvtpk(gl[2], gl[3]), cvtpk(gl[4], gl[5]), cvtpk(gl[6], gl[7])}));
        f32x16 z;
#pragma unroll
        for (int r = 0; r < 16; ++r) z[r] = gt.bias;
        z = MFMA32(ahi, gt.whi, z); z = MFMA32(alo, gt.whi, z); z = MFMA32(ahi, gt.wlo, z);
        float run = 0.f;
#pragma unroll
        for (int rho = 0; rho < 4; ++rho) { float p[4];
#pragma unroll
            for (int j = 0; j < 4; ++j) { const float y = z[4 * rho + j] * LOG2E, t = fabsf(y); p[j] = -0.0625f * (__builtin_amdgcn_logf(1.0f + __builtin_amdgcn_exp2f(-t)) + fmaxf(-y, 0.f)); }
            p[1] += p[0]; p[2] += p[1]; p[3] += p[2];
            const auto rr = __builtin_amdgcn_permlane32_swap(__float_as_uint(p[3]), __float_as_uint(p[3]), false, false);
            const float tlo = __uint_as_float(rr[0]), thi = __uint_as_float(rr[1]);
            const float off = base + run + (hi ? tlo : 0.f);
            if (tbb == tbw) {
#pragma unroll
                for (int j = 0; j < 4; ++j) *(LAS float*)(lds + LB_OFF + (32 * tbb + 8 * rho + 4 * hi + j) * LB_S + (32 * cb + r32) * 4) = off + p[j]; }
            run += tlo + thi; }
        base += run;
    }
    WG_BAR();
}
template <bool WITH_QK> __device__ __forceinline__ void gla_stage(LAS unsigned char* lds, const GlaIn& x, int tid, bool need_kd = true) {
    const int row = tid >> 3, cs = tid & 7;
    { LAS u32x4* dst = (LAS u32x4*)(lds + VT_OFF + row * VT_S + 64 * cs);
#pragma unroll
      for (int i = 0; i < 4; ++i) dst[i] = x.v[i]; }
    const unsigned kw[8] = {x.k0[0], x.k0[1], x.k0[2], x.k0[3], x.k1[0], x.k1[1], x.k1[2], x.k1[3]};
    float bb[16], bl[16];
#pragma unroll
    for (int q = 0; q < 4; ++q) { const f32x4 t = *(const LAS f32x4*)(lds + LB_OFF + row * LB_S + (16 * cs + 4 * q) * 4), u = *(const LAS f32x4*)(lds + LB_OFF + 63 * LB_S + (16 * cs + 4 * q) * 4);
        bb[4 * q] = t.x; bb[4 * q + 1] = t.y; bb[4 * q + 2] = t.z; bb[4 * q + 3] = t.w; bl[4 * q] = u.x; bl[4 * q + 1] = u.y; bl[4 * q + 2] = u.z; bl[4 * q + 3] = u.w; }
    if (need_kd) {
        unsigned okd[8];
#pragma unroll
        for (int i = 0; i < 8; ++i) okd[i] = cvtpk(bf_lo(kw[i]) * __builtin_amdgcn_exp2f(bl[2 * i] - bb[2 * i]), bf_hi(kw[i]) * __builtin_amdgcn_exp2f(bl[2 * i + 1] - bb[2 * i + 1]));
        LAS u32x4* d = (LAS u32x4*)(lds + KD_OFF + row * KD_S + 32 * cs); d[0] = (u32x4){okd[0], okd[1], okd[2], okd[3]}; d[1] = (u32x4){okd[4], okd[5], okd[6], okd[7]}; }
    if (WITH_QK) {
        const unsigned qw[8] = {x.q0[0], x.q0[1], x.q0[2], x.q0[3], x.q1[0], x.q1[1], x.q1[2], x.q1[3]};
        unsigned oq[8], ok[8];
#pragma unroll
        for (int i = 0; i < 8; ++i) { const float e0 = __builtin_amdgcn_exp2f(bb[2 * i]), e1 = __builtin_amdgcn_exp2f(bb[2 * i + 1]), f0 = __builtin_amdgcn_exp2f(-bb[2 * i]), f1 = __builtin_amdgcn_exp2f(-bb[2 * i + 1]);
            oq[i] = cvtpk(bf_lo(qw[i]) * e0, bf_hi(qw[i]) * e1); ok[i] = cvtpk(bf_lo(kw[i]) * f0, bf_hi(kw[i]) * f1); }
        LAS u32x4* dq = (LAS u32x4*)(lds + QT_OFF + row * QT_S + 32 * cs); LAS u32x4* dk = (LAS u32x4*)(lds + KT_OFF + row * KT_S + 32 * cs);
        dq[0] = (u32x4){oq[0], oq[1], oq[2], oq[3]}; dq[1] = (u32x4){oq[4], oq[5], oq[6], oq[7]};
        dk[0] = (u32x4){ok[0], ok[1], ok[2], ok[3]}; dk[1] = (u32x4){ok[4], ok[5], ok[6], ok[7]};
    }
}
__device__ __forceinline__ void gla_update(f32x16 (&acc)[4], const LAS unsigned char* lds, int lane, int wave) {
    const int hi = lane >> 5;
#pragma unroll
    for (int ib = 0; ib < 4; ++ib)
#pragma unroll
        for (int g = 0; g < 4; ++g) { const f32x4 bl = *(const LAS f32x4*)(lds + LB_OFF + 63 * LB_S + (32 * ib + 8 * g + 4 * hi) * 4);
#pragma unroll
            for (int j = 0; j < 4; ++j) acc[ib][4 * g + j] *= __builtin_amdgcn_exp2f(bl[j]); }
#pragma unroll 1
    for (int ks = 0; ks < 4; ++ks) { const bf16x8 b = frag_tr(lds + VT_OFF, VT_S, 16 * ks, 32 * wave, lane);
#pragma unroll
        for (int ib = 0; ib < 4; ++ib) { const bf16x8 a = frag_tr(lds + KD_OFF, KD_S, 16 * ks, 32 * ib, lane); acc[ib] = MFMA32(a, b, acc[ib]); } }
}
__device__ __forceinline__ void gla_unit_a(LAS unsigned char* lds, int m0, int h, int nch, const bf16* GK, const bf16* GV, const float* GLR, const float* w_up, const float* b_gate,
                                           const float* S0, float* dst, float* lsum, int tid, int lane, int wave) {
    asm volatile("" : "+v"(tid)); lane = tid & 63; wave = __builtin_amdgcn_readfirstlane(tid >> 6);
    const int r32 = lane & 31, hi = lane >> 5;
    f32x16 acc[4];
#pragma unroll
    for (int ib = 0; ib < 4; ++ib)
#pragma unroll
        for (int r = 0; r < 16; ++r) acc[ib][r] = S0 ? ((const GAS float*)S0)[(32 * ib + crow(r, hi)) * 256 + 32 * wave + r32] : 0.f;
    float ls = 0.f;
    GlaGate gt; gla_gate_init(gt, w_up, b_gate, h, lane, wave);
    GlaIn x; gla_load<false>(x, nullptr, GK, GV, GLR, m0, h, tid);
    WG_BAR();
    for (int c = 0; c < nch; ++c) {
        asm volatile("" : "+v"(tid)); lane = tid & 63;
        gla_lb_tile(lds, x, gt, lane, wave);
#ifdef PROBE_LB2
        gla_lb_tile(lds, x, gt, lane, wave);
#endif
#ifdef PROBE_ST2
        gla_stage<false>(lds, x, tid); WG_BAR();
#endif
        gla_stage<false>(lds, x, tid);
        if (c + 1 < nch) gla_load<false>(x, nullptr, GK, GV, GLR, m0 + 64 * (c + 1), h, tid);
        if (tid < 128) ls += *((const LAS float*)(lds + LB_OFF + 63 * LB_S) + tid);
        WG_BAR();
        gla_update(acc, lds, lane, wave);
        WG_BAR();
    }
#pragma unroll
    for (int ib = 0; ib < 4; ++ib)
#pragma unroll
        for (int r = 0; r < 16; ++r) ((GAS float*)dst)[(32 * ib + crow(r, hi)) * 256 + 32 * wave + r32] = acc[ib][r];
    if (lsum && tid < 128) lsum[tid] = ls;
}
__device__ __forceinline__ void gla_unit_c(LAS unsigned char* lds, int m0, int h, int nch, const bf16* GQ, const bf16* GK, const bf16* GV, const bf16* GR, const float* GLR, const float* w_up, const float* b_gate,
                                           const float* Sin, const float* gnorm, bf16* OA, int tid, int lane, int wave) {
    asm volatile("" : "+v"(tid)); lane = tid & 63; wave = __builtin_amdgcn_readfirstlane(tid >> 6);
    const int r32 = lane & 31, hi = lane >> 5;
    f32x16 acc[4];
#pragma unroll
    for (int ib = 0; ib < 4; ++ib)
#pragma unroll
        for (int r = 0; r < 16; ++r) acc[ib][r] = ((const GAS float*)Sin)[(32 * ib + crow(r, hi)) * 256 + 32 * wave + r32];
    GlaGate gt; gla_gate_init(gt, w_up, b_gate, h, lane, wave);
    if (tid < 64) *(LAS f32x4*)(lds + WU_OFF + tid * 16) = ((const GAS f32x4*)(gnorm + h * 256))[tid];
    GlaIn x; gla_load<true>(x, GQ, GK, GV, GLR, m0, h, tid);
    WG_BAR();
    for (int c = 0; c < nch; ++c) { const int mc = m0 + 64 * c;
        TSTAMP(30, lds, tid);
        asm volatile("" : "+v"(tid)); lane = tid & 63;
        gla_lb_tile(lds, x, gt, lane, wave);
#ifdef PROBE_LB2
        gla_lb_tile(lds, x, gt, lane, wave);
#endif
#ifdef PROBE_ST2
        gla_stage<true>(lds, x, tid); WG_BAR();
#endif
        TSTAMP(31, lds, tid);
        gla_stage<true>(lds, x, tid);
        WG_BAR();
        TSTAMP(32, lds, tid);
        const int tb = wave & 1, sb = wave >> 1; const bool do_att = (wave < 4) && (sb <= tb);
        f32x16 att;
#pragma unroll
        for (int r = 0; r < 16; ++r) att[r] = 0.f;
        if (do_att) {
#pragma unroll 2
            for (int ks = 0; ks < 8; ++ks) { const bf16x8 a = frag_row(lds + QT_OFF, QT_S, 32 * tb + r32, 16 * ks + 8 * hi), b = frag_row(lds + KT_OFF, KT_S, 32 * sb + r32, 16 * ks + 8 * hi); att = MFMA32(a, b, att); } }
        WG_BAR();
        if (do_att) {
#pragma unroll
            for (int r = 0; r < 16; ++r) { const int t = 32 * tb + crow(r, hi), s = 32 * sb + r32; const float val = (s <= t) ? att[r] : 0.f;
                *(LAS unsigned short*)(lds + PT_OFF + t * PT_S + s * 2) = (unsigned short)(cvtpk(val, val) & 0xffffu); } }
        WG_BAR();
        TSTAMP(33, lds, tid);
        f32x16 o0, o1;
#pragma unroll
        for (int r = 0; r < 16; ++r) { o0[r] = 0.f; o1[r] = 0.f; }
#pragma unroll
        for (int ks = 0; ks < 4; ++ks) { const bf16x8 b = frag_tr(lds + VT_OFF, VT_S, 16 * ks, 32 * wave, lane);
            if (ks < 2) { const bf16x8 a0 = frag_row(lds + PT_OFF, PT_S, r32, 16 * ks + 8 * hi); o0 = MFMA32(a0, b, o0); }
            const bf16x8 a1 = frag_row(lds + PT_OFF, PT_S, 32 + r32, 16 * ks + 8 * hi); o1 = MFMA32(a1, b, o1); }
#pragma unroll
        for (int ib = 0; ib < 4; ++ib)
#pragma unroll
            for (int s = 0; s < 2; ++s) {
                const bf16x8 b = __builtin_bit_cast(bf16x8, ((u32x4){cvtpk(acc[ib][8 * s], acc[ib][8 * s + 1]), cvtpk(acc[ib][8 * s + 2], acc[ib][8 * s + 3]), cvtpk(acc[ib][8 * s + 4], acc[ib][8 * s + 5]), cvtpk(acc[ib][8 * s + 6], acc[ib][8 * s + 7])}));
                const int kc = (32 * ib + 16 * s + 4 * hi) * 2;
                const u32x2 a0l = *(const LAS u32x2*)(lds + QT_OFF + r32 * QT_S + kc), a0h = *(const LAS u32x2*)(lds + QT_OFF + r32 * QT_S + kc + 16);
                const u32x2 a1l = *(const LAS u32x2*)(lds + QT_OFF + (32 + r32) * QT_S + kc), a1h = *(const LAS u32x2*)(lds + QT_OFF + (32 + r32) * QT_S + kc + 16);
                o0 = MFMA32(__builtin_bit_cast(bf16x8, ((u32x4){a0l[0], a0l[1], a0h[0], a0h[1]})), b, o0);
                o1 = MFMA32(__builtin_bit_cast(bf16x8, ((u32x4){a1l[0], a1l[1], a1h[0], a1h[1]})), b, o1); }
        TSTAMP(34, lds, tid);
        if (c + 1 < nch) gla_load<true>(x, GQ, GK, GV, GLR, mc + 64, h, tid);
        u32x4 grw[4];
        { const GAS u32x4* gp = (const GAS u32x4*)(GR + ((unsigned)(mc + (tid >> 3)) * 1024u + (unsigned)(h * 256 + 32 * (tid & 7))));
#pragma unroll
          for (int i = 0; i < 4; ++i) grw[i] = gp[i]; }
        if (c + 1 < nch) gla_update(acc, lds, lane, wave);
        WG_BAR();
        TSTAMP(35, lds, tid);
#pragma unroll
        for (int r = 0; r < 16; ++r) { *(LAS unsigned short*)(lds + VT_OFF + crow(r, hi) * 528 + (32 * wave + r32) * 2) = (unsigned short)(cvtpk(o0[r], o0[r]) & 0xffffu);
                                       *(LAS unsigned short*)(lds + VT_OFF + (32 + crow(r, hi)) * 528 + (32 * wave + r32) * 2) = (unsigned short)(cvtpk(o1[r], o1[r]) & 0xffffu); }
        WG_BAR();
        TSTAMP(36, lds, tid);
        { const int row = tid >> 3, cs = tid & 7; u32x4 ow[4]; float ss = 0.f;
#pragma unroll
          for (int i = 0; i < 4; ++i) { ow[i] = *(const LAS u32x4*)(lds + VT_OFF + row * 528 + 64 * cs + 16 * i);
#pragma unroll
              for (int j = 0; j < 4; ++j) { const float lo = bf_lo(ow[i][j]), hi2 = bf_hi(ow[i][j]); ss += lo * lo + hi2 * hi2; } }
          ss += __shfl_xor(ss, 1); ss += __shfl_xor(ss, 2); ss += __shfl_xor(ss, 4);
          const float rstd = 1.0f / sqrtf(ss * (1.0f / 256.0f) + LN_EPS);
          const LAS f32x4* gp = (const LAS f32x4*)(lds + WU_OFF + 128 * cs); GAS u32x4* op = (GAS u32x4*)(OA + ((unsigned)(mc + row) * 1024u + (unsigned)(h * 256 + 32 * cs)));
#pragma unroll
          for (int i = 0; i < 4; ++i) { const f32x4 g0 = gp[2 * i], g1 = gp[2 * i + 1]; u32x4 w;
              w[0] = cvtpk(bf_lo(ow[i][0]) * rstd * g0[0] * bf_lo(grw[i][0]), bf_hi(ow[i][0]) * rstd * g0[1] * bf_hi(grw[i][0]));
              w[1] = cvtpk(bf_lo(ow[i][1]) * rstd * g0[2] * bf_lo(grw[i][1]), bf_hi(ow[i][1]) * rstd * g0[3] * bf_hi(grw[i][1]));
              w[2] = cvtpk(bf_lo(ow[i][2]) * rstd * g1[0] * bf_lo(grw[i][2]), bf_hi(ow[i][2]) * rstd * g1[1] * bf_hi(grw[i][2]));
              w[3] = cvtpk(bf_lo(ow[i][3]) * rstd * g1[2] * bf_lo(grw[i][3]), bf_hi(ow[i][3]) * rstd * g1[3] * bf_hi(grw[i][3]));
              op[i] = w; } }
        TSTAMP(37, lds, tid);
    }
}
__device__ __forceinline__ void gla_scan_phase(const float* DSS, float* SIN, const float* LSUM, float* out_state, int vcu, int G, int tid) {
    for (int item = vcu * 512 + tid; item < 131072; item += G * 512) {
        const int bh = item >> 14, e2 = item & 16383, dk = e2 >> 7, dv = (e2 & 127) * 2;
        const size_t eo = (size_t)dk * 256 + dv;
        float s0 = 0.f, s1 = 0.f;
        f32x2v dd[32]; float lg[32];
#pragma unroll
        for (int sc = 0; sc < 32; ++sc) { dd[sc] = *(const GAS f32x2v*)(DSS + (size_t)(bh * 32 + sc) * 32768 + eo); lg[sc] = ((const GAS float*)LSUM)[(bh * 32 + sc) * 128 + dk]; }
#pragma unroll
        for (int sc = 0; sc < 32; ++sc) { *(GAS f32x2v*)(SIN + (size_t)(bh * 32 + sc) * 32768 + eo) = (f32x2v){s0, s1};
            const float dec = __builtin_amdgcn_exp2f(lg[sc]); s0 = dec * s0 + dd[sc].x; s1 = dec * s1 + dd[sc].y; }
        *(f32x2v*)(out_state + (size_t)bh * 32768 + eo) = (f32x2v){s0, s1};
    }
}
constexpr int SB_V_OFF = 0, SB_K_OFF = 32768, SB_FLAG_OFF = 65536, SB_Q_OFF = 66560, SB_TILE = 16384;
constexpr float SB_DONE_THR = -140.0f;
#define KSWZ(row, colB) ((row) * 256 + ((colB) ^ (((row) & 7) << 4)))
#define SBAR() __builtin_amdgcn_sched_barrier(0)
__device__ __forceinline__ int v_st(int k, int c) { const int kk = (k & ~0xC) | ((k & 4) << 1) | ((k & 8) >> 1); return ((kk >> 3) * 4 + (c >> 5)) * 512 + ((kk & 7) * 32 + (c & 31)) * 2; }
__device__ __forceinline__ int v_rd_base(int lane) { return ((lane & 3) << 3) | (((lane >> 2) & 3) << 6) | (((lane >> 4) & 1) << 5) | (((lane >> 5) & 1) << 8); }
constexpr int v_rd_off(int d0, int ks, int half) { return d0 * 512 + ks * 4096 + half * 2048; }
template <int OFF> __device__ __forceinline__ s16x4 tr_read(int vb) { s16x4 r; asm volatile("ds_read_b64_tr_b16 %0, %1 offset:%2" : "=&v"(r) : "v"(vb), "i"(OFF) : "memory"); return r; }
template <int D0> __device__ __forceinline__ void pv_one(f32x16& od, int vb, bf16x8 pa0, bf16x8 pa1, bf16x8 pa2, bf16x8 pa3) {
    const s16x4 l0 = tr_read<v_rd_off(D0, 0, 0)>(vb), h0 = tr_read<v_rd_off(D0, 0, 1)>(vb), l1 = tr_read<v_rd_off(D0, 1, 0)>(vb), h1 = tr_read<v_rd_off(D0, 1, 1)>(vb);
    const s16x4 l2 = tr_read<v_rd_off(D0, 2, 0)>(vb), h2 = tr_read<v_rd_off(D0, 2, 1)>(vb), l3 = tr_read<v_rd_off(D0, 3, 0)>(vb), h3 = tr_read<v_rd_off(D0, 3, 1)>(vb);
    asm volatile("s_waitcnt lgkmcnt(0)" ::: "memory"); SBAR();
#define PKV(L, H) (bf16x8){L[0], L[1], L[2], L[3], H[0], H[1], H[2], H[3]}
    od = MFMA32(pa0, PKV(l0, h0), od); od = MFMA32(pa1, PKV(l1, h1), od); od = MFMA32(pa2, PKV(l2, h2), od); od = MFMA32(pa3, PKV(l3, h3), od);
#undef PKV
}
__device__ __forceinline__ void sb_qkt(f32x16& p0, f32x16& p1, const LAS unsigned char* Ks, const bf16x8 (&qr)[8], int r32, int hi) {
#pragma unroll
    for (int r = 0; r < 16; ++r) { p0[r] = 0.f; p1[r] = 0.f; }
#pragma unroll
    for (int d0 = 0; d0 < 8; ++d0) { const int cb = (d0 * 16 + hi * 8) * 2;
        const bf16x8 b0 = *(const LAS bf16x8*)(Ks + KSWZ(r32, cb)), b1 = *(const LAS bf16x8*)(Ks + KSWZ(32 + r32, cb));
        p0 = MFMA32(b0, qr[d0], p0); p1 = MFMA32(b1, qr[d0], p1); }
}
struct f4s { float a, b, c, d; };
template <bool MASK> __device__ __forceinline__ f4s sb_group(float x0, float x1, float x2, float x3, float& Hrun, int kb, int qpos, int hi) {
    float l0 = __builtin_amdgcn_logf(1.0f + __builtin_amdgcn_exp2f(-x0)), l1 = __builtin_amdgcn_logf(1.0f + __builtin_amdgcn_exp2f(-x1));
    float l2 = __builtin_amdgcn_logf(1.0f + __builtin_amdgcn_exp2f(-x2)), l3 = __builtin_amdgcn_logf(1.0f + __builtin_amdgcn_exp2f(-x3));
    float k0 = -l0 - x0, k1 = -l1 - x1, k2 = -l2 - x2, k3 = -l3 - x3;
    float b0 = -l0, b1 = -l1, b2 = -l2, b3 = -l3;
    if (MASK) { const bool v0 = kb < qpos, v1 = kb + 1 < qpos, v2 = kb + 2 < qpos, v3 = kb + 3 < qpos;
        k0 = v0 ? k0 : 0.f; k1 = v1 ? k1 : 0.f; k2 = v2 ? k2 : 0.f; k3 = v3 ? k3 : 0.f;
        b0 = v0 ? b0 : -1e30f; b1 = v1 ? b1 : -1e30f; b2 = v2 ? b2 : -1e30f; b3 = v3 ? b3 : -1e30f; }
    const float s2 = k3, s1 = s2 + k2, s0 = s1 + k1, t = s0 + k0;
    const auto rr = __builtin_amdgcn_permlane32_swap(__float_as_uint(t), __float_as_uint(t), false, false);
    const float tlo = __uint_as_float(rr[0]), thi = __uint_as_float(rr[1]);
    const float Hb = Hrun + (hi ? 0.f : thi);
    f4s w; w.a = __builtin_amdgcn_exp2f(b0 + (Hb + s0)); w.b = __builtin_amdgcn_exp2f(b1 + (Hb + s1)); w.c = __builtin_amdgcn_exp2f(b2 + (Hb + s2)); w.d = __builtin_amdgcn_exp2f(b3 + Hb);
    Hrun += tlo + thi; return w;
}
template <bool MASK> __device__ __forceinline__ void sb_tile(f32x16& p0, f32x16& p1, float& R, int kbase, int qpos, int hi) {
    float Hrun = R; const int kb = kbase + 4 * hi;
#define SBG(P, B, KO) do { const f4s w_ = sb_group<MASK>(P[B], P[B + 1], P[B + 2], P[B + 3], Hrun, kb + (KO), qpos, hi); P[B] = w_.a; P[B + 1] = w_.b; P[B + 2] = w_.c; P[B + 3] = w_.d; } while (0)
    SBG(p1, 12, 56); SBG(p1, 8, 48); SBG(p1, 4, 40); SBG(p1, 0, 32); SBG(p0, 12, 24); SBG(p0, 8, 16); SBG(p0, 4, 8); SBG(p0, 0, 0);
#undef SBG
    R = Hrun;
}
template <bool KVF32> __device__ __forceinline__ void sb_unit(LAS unsigned char* lds, const bf16* Q, bf16* O, int nwq, int i0, const bf16* KB, const bf16* VB, const float* KC, const float* VC,
                                                              float* OK, float* OV, int own_lo, int tid, int lane, int wave) {
    asm volatile("" : "+v"(tid)); lane = tid & 63; wave = __builtin_amdgcn_readfirstlane(tid >> 6);
    const int r32 = lane & 31, hi = lane >> 5;
    const int sr = tid >> 4, sc = (tid & 15) * 8, vst0 = v_st(sr, sc), vst1 = v_st(32 + sr, sc), kst0 = KSWZ(sr, sc * 2), kst1 = KSWZ(32 + sr, sc * 2);
    const int vb0 = (int)(uintptr_t)(lds + SB_V_OFF) + v_rd_base(lane);
    volatile LAS unsigned* flags = (volatile LAS unsigned*)(lds + SB_FLAG_OFF);
    const bool compute = wave < nwq;
    bf16x8 qr[8];
#pragma unroll
    for (int d0 = 0; d0 < 8; ++d0) qr[d0] = (bf16x8){0, 0, 0, 0, 0, 0, 0, 0};
    const bf16* Qw = Q + (size_t)((compute ? wave : 0) * 32 + r32) * 1024 + hi * 8;
    LAS unsigned char* qlds = lds + SB_Q_OFF + wave * 8192;
    if (compute) {
#pragma unroll
        for (int d0 = 0; d0 < 8; ++d0) *(LAS bf16x8*)(qlds + KSWZ(r32, (d0 * 16 + hi * 8) * 2)) = *(const GAS bf16x8*)(Qw + d0 * 16); }
    const int qpos = i0 + wave * 32 + r32;
    f32x16 o[4];
#pragma unroll
    for (int d = 0; d < 4; ++d)
#pragma unroll
        for (int r = 0; r < 16; ++r) o[d][r] = 0.f;
    float R = 0.f; bool done = !compute;
    typedef float f32x8 __attribute__((ext_vector_type(8)));
    f32x8 fk0, fk1, fv0, fv1; bf16x8 hk0, hk1, hv0, hv1;
    const int kbase = KVF32 ? 4096 : 0;
#define SB_LOAD_BF(jt) do { const int p0_ = 64 * (jt) + sr - kbase; \
        hk0 = *(const GAS bf16x8*)(KB + (size_t)p0_ * 1024 + sc); hk1 = *(const GAS bf16x8*)(KB + (size_t)(p0_ + 32) * 1024 + sc); hv0 = *(const GAS bf16x8*)(VB + (size_t)p0_ * 1024 + sc); hv1 = *(const GAS bf16x8*)(VB + (size_t)(p0_ + 32) * 1024 + sc); } while (0)
#define SB_LOAD_F32(jt) do { const int p0_ = 64 * (jt) + sr; \
        fk0 = *(const GAS f32x8*)(KC + (size_t)p0_ * 1024 + sc); fk1 = *(const GAS f32x8*)(KC + (size_t)(p0_ + 32) * 1024 + sc); fv0 = *(const GAS f32x8*)(VC + (size_t)p0_ * 1024 + sc); fv1 = *(const GAS f32x8*)(VC + (size_t)(p0_ + 32) * 1024 + sc); } while (0)
#define SB_CVT(x) ((bf16x8)__builtin_bit_cast(bf16x8, ((u32x4){cvtpk(x[0], x[1]), cvtpk(x[2], x[3]), cvtpk(x[4], x[5]), cvtpk(x[6], x[7])})))
#define SB_WRITE_BF(buf) do { LAS unsigned char* vb_ = lds + SB_V_OFF + (buf) * SB_TILE; LAS unsigned char* kb_ = lds + SB_K_OFF + (buf) * SB_TILE; \
        *(LAS bf16x8*)(vb_ + vst0) = hv0; *(LAS bf16x8*)(vb_ + vst1) = hv1; *(LAS bf16x8*)(kb_ + kst0) = hk0; *(LAS bf16x8*)(kb_ + kst1) = hk1; } while (0)
#define SB_WRITE_F32(buf) do { LAS unsigned char* vb_ = lds + SB_V_OFF + (buf) * SB_TILE; LAS unsigned char* kb_ = lds + SB_K_OFF + (buf) * SB_TILE; \
        *(LAS bf16x8*)(vb_ + vst0) = SB_CVT(fv0); *(LAS bf16x8*)(vb_ + vst1) = SB_CVT(fv1); *(LAS bf16x8*)(kb_ + kst0) = SB_CVT(fk0); *(LAS bf16x8*)(kb_ + kst1) = SB_CVT(fk1); } while (0)
#define SB_F4(x, a) ((f32x4){__uint_as_float((unsigned)(unsigned short)x[a] << 16), __uint_as_float((unsigned)(unsigned short)x[a + 1] << 16), __uint_as_float((unsigned)(unsigned short)x[a + 2] << 16), __uint_as_float((unsigned)(unsigned short)x[a + 3] << 16)})
#define SB_STORE_OWN(jt) do { const size_t o0_ = (size_t)(64 * (jt) + sr - own_lo) * 1024 + sc, o1_ = o0_ + 32 * 1024; \
        *(GAS f32x4*)(OK + o0_) = SB_F4(hk0, 0); *(GAS f32x4*)(OK + o0_ + 4) = SB_F4(hk0, 4); *(GAS f32x4*)(OK + o1_) = SB_F4(hk1, 0); *(GAS f32x4*)(OK + o1_ + 4) = SB_F4(hk1, 4); \
        *(GAS f32x4*)(OV + o0_) = SB_F4(hv0, 0); *(GAS f32x4*)(OV + o0_ + 4) = SB_F4(hv0, 4); *(GAS f32x4*)(OV + o1_) = SB_F4(hv1, 0); *(GAS f32x4*)(OV + o1_ + 4) = SB_F4(hv1, 4); } while (0)
    const int jt_top = (i0 + 32 * nwq - 1) >> 6;
    SB_LOAD_BF(jt_top); SB_WRITE_BF(0); SB_STORE_OWN(jt_top);
    WG_BAR();
    for (int jt = jt_top, it = 0;; --jt, ++it) {
        const int buf = it & 1; const bool has_next = jt > 0;
        if (has_next) { if (KVF32) SB_LOAD_F32(jt - 1); else SB_LOAD_BF(jt - 1); }
        const int wrow_lo = i0 + wave * 32;
        if (!done && (64 * jt < wrow_lo + 31)) {
#pragma unroll
            for (int d0 = 0; d0 < 8; ++d0) qr[d0] = *(const LAS bf16x8*)(qlds + KSWZ(r32, (d0 * 16 + hi * 8) * 2));
            f32x16 p0, p1; sb_qkt(p0, p1, lds + SB_K_OFF + buf * SB_TILE, qr, r32, hi);
            if (64 * jt + 64 <= wrow_lo) sb_tile<false>(p0, p1, R, 64 * jt, qpos, hi);
            else sb_tile<true>(p0, p1, R, 64 * jt, qpos, hi);
            bf16x8 pa0, pa1, pa2, pa3;
#define PK4(P, BASE, OUT) do { const unsigned a0 = cvtpk(P[BASE + 0], P[BASE + 1]), a1 = cvtpk(P[BASE + 2], P[BASE + 3]), b0 = cvtpk(P[BASE + 4], P[BASE + 5]), b1 = cvtpk(P[BASE + 6], P[BASE + 7]); \
            const auto r0 = __builtin_amdgcn_permlane32_swap(a0, b0, false, false); const auto r1 = __builtin_amdgcn_permlane32_swap(a1, b1, false, false); \
            OUT = __builtin_bit_cast(bf16x8, ((u32x4){r0[0], r1[0], r0[1], r1[1]})); } while (0)
            PK4(p0, 0, pa0); PK4(p0, 8, pa1); PK4(p1, 0, pa2); PK4(p1, 8, pa3);
#undef PK4
            const int vb = vb0 + buf * SB_TILE;
            pv_one<0>(o[0], vb, pa0, pa1, pa2, pa3); pv_one<1>(o[1], vb, pa0, pa1, pa2, pa3); pv_one<2>(o[2], vb, pa0, pa1, pa2, pa3); pv_one<3>(o[3], vb, pa0, pa1, pa2, pa3);
            done = __all(R <= SB_DONE_THR);
        }
        if (has_next) { if (KVF32) SB_WRITE_F32(buf ^ 1); else { SB_WRITE_BF(buf ^ 1); if (64 * (jt - 1) >= own_lo) SB_STORE_OWN(jt - 1); } }
        if (lane == 0) flags[buf * 8 + wave] = done ? 1u : 0u;
        WG_BAR();
        unsigned nd = 0;
#pragma unroll
        for (int w = 0; w < 8; ++w) nd += flags[buf * 8 + w];
        if ((nd == 8u && (KVF32 || 64 * (jt - 1) < own_lo)) || !has_next) break;
    }
#undef SB_LOAD_BF
#undef SB_LOAD_F32
#undef SB_WRITE_BF
#undef SB_WRITE_F32
#undef SB_CVT
#undef SB_F4
#undef SB_STORE_OWN
    if (compute) {
#pragma unroll
        for (int r = 0; r < 16; ++r) { bf16* orow = O + (size_t)(wave * 32 + crow(r, hi)) * 1024 + r32;
#pragma unroll
            for (int d0 = 0; d0 < 4; ++d0) orow[d0 * 32] = (bf16)(cvtpk(o[d0][r], 0.f) & 0xffffu); }
    }
}
#ifndef PHASE_MASK
#define PHASE_MASK 0xFFFFFFFFu
#endif
#define PH(k) ((PHASE_MASK >> (k)) & 1u)
#ifndef DUP_MASK
#define DUP_MASK 0u
#endif
#define REP(k) for (int rep_ = 0; rep_ < 1 + (int)((DUP_MASK >> (k)) & 1u); ++rep_)
#define STAMP(k) TSTAMP(k, lds, tid)
#ifdef DBL_BAR
#define XBAR() do { xcd_barrier(bar); xcd_barrier(bar); } while (0)
#else
#define XBAR() xcd_barrier(bar)
#endif
struct Args { const float* in[22]; float* out; unsigned char* ws; };
#define GEMM_PHASE(EPI, M_, A_, Bt_, N_, K_, E_) do { pg8::Gemm g_{(const pg8::bf16_t*)(A_), (const pg8::bf16_t*)(Bt_), (M_), (N_), (K_)}; pg8::StaticOrder S_; S_.init((M_), (N_), G, bx); \
        pg8::gemm_phase<EPI, pg8::StaticOrder, true, true>(lds + RING_OFF, g_, S_, (E_)); } while (0)
__global__ void __launch_bounds__(NWAVES * 64, 2) mk_fwd(Args a) {
    extern __shared__ __attribute__((aligned(16))) unsigned char lds_raw[];
    LAS unsigned char* lds = (LAS unsigned char*)lds_raw;
    const int tid = threadIdx.x, lane = tid & 63, wave = __builtin_amdgcn_readfirstlane(tid >> 6);
    const int G = gridDim.x, bx = blockIdx.x, vcu = (G % 8 == 0) ? (bx % 8) * (G / 8) + bx / 8 : bx;
    const int gw = vcu * NWAVES + wave, NGW = G * NWAVES;
#ifndef SF_MASK
#define SF_MASK 1
#endif
    const bool small_first = (vcu & SF_MASK) == SF_MASK && SF_MASK != 0;
    volatile LAS unsigned* MISC = (volatile LAS unsigned*)(lds + MISC_OFF);
    if (tid < 64) MISC[tid] = 0u;
    __syncthreads();
    unsigned char* ws = a.ws; float* out = a.out;
    XcdBarrier bar = xcd_barrier_post((unsigned*)(ws + WS_CTL) + CW_BAR, MISC + 8);
    const float* xp = a.in[0]; const float* xs = a.in[1]; const float* state_gla = a.in[2]; const float* cache_k = a.in[3]; const float* cache_v = a.in[4];
    bf16 *W1IN = (bf16*)(ws + WS_W1IN), *W1OUT = (bf16*)(ws + WS_W1OUT), *WIN = (bf16*)(ws + WS_WIN), *WGLAO = (bf16*)(ws + WS_WGLAO), *WSBO = (bf16*)(ws + WS_WSBO), *WOUT = (bf16*)(ws + WS_WOUT),
         *W2IN = (bf16*)(ws + WS_W2IN), *W2OUT = (bf16*)(ws + WS_W2OUT);
    bf16 *XB = (bf16*)(ws + WS_XB), *HB = (bf16*)(ws + WS_HB), *ACT = (bf16*)(ws + WS_ACT), *GQ = (bf16*)(ws + WS_GQ), *GK = (bf16*)(ws + WS_GK), *GV = (bf16*)(ws + WS_GV), *GR = (bf16*)(ws + WS_GR),
         *SQ = (bf16*)(ws + WS_SQ), *SKB = (bf16*)(ws + WS_SKB2), *SVB = (bf16*)(ws + WS_SVB2), *GA = (bf16*)(ws + WS_GA), *GB = (bf16*)(ws + WS_GB),
         *OA = (bf16*)(ws + WS_OA), *OB = (bf16*)(ws + WS_OB), *MG = (bf16*)(ws + WS_MG), *TB = (bf16*)(ws + WS_R + 40 * MiB);
    bf16* R = (bf16*)(ws + WS_R); float *GLR = (float*)(ws + WS_H), *LSUM = (float*)(ws + WS_B2), *DS = (float*)(ws + WS_DS), *SIN = (float*)(ws + WS_STS);

    STAMP(0);
    if (PH(0)) REP(0) { LAS float* scr = (LAS float*)(lds + wave * 16384); int itbase = 0;
      p0_weight<1>(a.in[5], 2 * DFF, DM, 2 * DFF, W1IN, scr, lane, gw, NGW, itbase);
      for (int m = gw; m < MT; m += NGW) row_to_bf16(m < MP ? xp + (size_t)m * DM : xs + (size_t)(m - MP) * DM, XB + (size_t)m * DM, lane); }
    XBAR(); STAMP(1);
    if (PH(1)) REP(1) { pg8::EpiSwiGLU E{(pg8::bf16_t*)ACT, DFF}; GEMM_PHASE(pg8::EpiSwiGLU, MT, XB, W1IN, 2 * DFF, DM, E);
      { const int nlast = (MT / 256) * (2 * DFF / 256) - 6 * G;
        if (G == 256 && bx >= nlast) { __syncthreads(); LAS float* scr = (LAS float*)(lds + wave * 16384); int itbase = 0; const int gw2 = (bx - nlast) * NWAVES + wave, NGW2 = (G - nlast) * NWAVES;
          p0_weight<0>(a.in[6], DM, DFF, DM, W1OUT, scr, lane, gw2, NGW2, itbase);
          p0_weight<2>(a.in[9], 8208, DM, NIN, WIN, scr, lane, gw2, NGW2, itbase);
          p0_weight<0>(a.in[13], DM, DM, DM, WGLAO, scr, lane, gw2, NGW2, itbase);
          p0_weight<0>(a.in[14], DM, DM, DM, WSBO, scr, lane, gw2, NGW2, itbase);
          p0_weight<0>(a.in[15], DM, DM, DM, WOUT, scr, lane, gw2, NGW2, itbase);
          p0_weight<1>(a.in[18], 2 * DFF, DM, 2 * DFF, W2IN, scr, lane, gw2, NGW2, itbase); }
        else if (G != 256) { __syncthreads(); LAS float* scr = (LAS float*)(lds + wave * 16384); int itbase = 0;
          p0_weight<0>(a.in[6], DM, DFF, DM, W1OUT, scr, lane, gw, NGW, itbase);
          p0_weight<2>(a.in[9], 8208, DM, NIN, WIN, scr, lane, gw, NGW, itbase);
          p0_weight<0>(a.in[13], DM, DM, DM, WGLAO, scr, lane, gw, NGW, itbase);
          p0_weight<0>(a.in[14], DM, DM, DM, WSBO, scr, lane, gw, NGW, itbase);
          p0_weight<0>(a.in[15], DM, DM, DM, WOUT, scr, lane, gw, NGW, itbase);
          p0_weight<1>(a.in[18], 2 * DFF, DM, 2 * DFF, W2IN, scr, lane, gw, NGW, itbase);
          p0_weight<0>(a.in[19], DM, DFF, DM, W2OUT, scr, lane, gw, NGW, itbase); } }
#ifdef PROBE_NULL_P1
      { pg8::EpiNull EN{(float*)R}; GEMM_PHASE(pg8::EpiNull, MT, XB, W1IN, 2 * DFF, DM, EN); }
#endif
    }
    XBAR(); STAMP(2);
#define P2_SMALL() do { pg8::SEpiResid<true> E{XB + (size_t)MP * DM, (pg8::bf16_t*)R + (size_t)MP * DM, DN_ALPHA, 0.5f}; for (int u = vcu; u < 256; u += G) { __syncthreads(); sgemm_unit(lds, ACT + (size_t)MP * DFF, W1OUT, DFF, u, E); } } while (0)
    if (PH(2)) REP(2) { if (small_first) { P2_SMALL(); __syncthreads(); }
      { pg8::EpiResid<true> E{XB, (pg8::bf16_t*)R, DN_ALPHA, 0.5f}; GEMM_PHASE(pg8::EpiResid<true>, MP, ACT, W1OUT, DM, DFF, E); }
      if (!small_first) P2_SMALL(); }
    XBAR(); STAMP(3);
    if (PH(3)) REP(3) ln1_phase(lds, R, HB, GLR, a.in[7], a.in[8], a.in[9], vcu, G, tid, lane, wave);
    XBAR(); STAMP(4);
#ifdef STAGGER_P4
    { const unsigned g4 = (unsigned)(bx >> 3) & 3u; const unsigned long long t0 = __builtin_amdgcn_s_memrealtime(); while (__builtin_amdgcn_s_memrealtime() - t0 < (unsigned long long)(g4 * STAGGER_P4)) __builtin_amdgcn_s_sleep(8); }
#endif
    if (PH(4)) REP(4) { pg8::EpiMixIn E{(pg8::bf16_t*)GQ, (pg8::bf16_t*)GK, (pg8::bf16_t*)GV, (pg8::bf16_t*)GR, (pg8::bf16_t*)SQ, (pg8::bf16_t*)SKB, (pg8::bf16_t*)SVB, (pg8::bf16_t*)GA, (pg8::bf16_t*)GB,
                      out + O_KP, out + O_KS, out + O_VP, out + O_VS};
      GEMM_PHASE(pg8::EpiMixIn, MT, HB, WIN, NIN, DM, E);
#ifdef PROBE_BF_P4
      { pg8::EpiMixIn E2 = E; E2.okp = nullptr; GEMM_PHASE(pg8::EpiMixIn, MT, HB, WIN, NIN, DM, E2); }
#endif
#ifdef PROBE_NULL_P1
#endif
#ifdef PROBE_NULL_P4
      { pg8::EpiNull EN{(float*)R}; GEMM_PHASE(pg8::EpiNull, MT, HB, WIN, NIN, DM, EN); }
#endif
    }
    XBAR(); STAMP(5);
#ifndef P5_ROT
#define P5_ROT 3
#endif
#pragma unroll 1
    for (int st_ = 0; st_ < 3; ++st_) { const int kind_ = (st_ + (P5_ROT > 1 ? vcu % P5_ROT : 0)) % 3;
      if (kind_ == 0 && PH(5)) REP(5) for (int u = vcu; u < 512; u += G) { __syncthreads();
        if (u < 256) { const int bh = u >> 5, sc = u & 31, m0 = (bh >> 2) * TSEQ + sc * 256;
            gla_unit_a(lds, m0, bh & 3, 4, GK, GV, GLR, a.in[10], a.in[11], nullptr, DS + (size_t)u * 32768, LSUM + u * 128, tid, lane, wave); }
        else if (u < 384) { const int su = u - 256, h = su & 3, m0 = MP + (su >> 2) * 64;
            gla_unit_a(lds, m0, h, 1, GK, GV, GLR, a.in[10], a.in[11], state_gla + (size_t)su * 32768, out + O_SGS + (size_t)su * 32768, nullptr, tid, lane, wave); }
        else { const int su = u - 384, h = su & 3, m0 = MP + (su >> 2) * 64;
            gla_unit_c(lds, m0, h, 1, GQ, GK, GV, GR, GLR, a.in[10], a.in[11], state_gla + (size_t)su * 32768, a.in[12], OA, tid, lane, wave); } }
      if (kind_ == 1 && PH(7)) REP(7) for (int u = vcu; u < 512; u += G) { const int bh = u >> 5, qb = u & 31, b = bh >> 3, h = bh & 7, i0 = qb * 256; __syncthreads();
        const size_t qo = ((size_t)b * TSEQ + i0) * 1024 + h * 128, ko = (size_t)b * TSEQ * 1024 + h * 128;
        sb_unit<false>(lds, SQ + qo, OB + qo, 8, i0, SKB + ko, SVB + ko, nullptr, nullptr, out + O_KP + qo, out + O_VP + qo, i0, tid, lane, wave); }
      if (kind_ == 2 && PH(8)) REP(8) for (int u = vcu; u < 256; u += G) { const int b = u >> 3, h = u & 7; __syncthreads();
        const size_t qo = ((size_t)MP + b * 64) * 1024 + h * 128, co = (size_t)b * 4096 * 1024 + h * 128, no = (size_t)b * 64 * 1024 + h * 128;
        sb_unit<true>(lds, SQ + qo, OB + qo, 2, 4096, SKB + qo, SVB + qo, cache_k + co, cache_v + co, out + O_KS + no, out + O_VS + no, 4096, tid, lane, wave); }
    }
    XBAR(); STAMP(6);
    if (PH(9)) REP(9) gla_scan_phase(DS, SIN, LSUM, out + O_SGP, vcu, G, tid);
    XBAR(); STAMP(7);
    if (PH(10)) REP(10) for (int u = vcu; u < 256; u += G) { __syncthreads();
        { const int bh = u >> 5, sc = u & 31, m0 = (bh >> 2) * TSEQ + sc * 256;
            gla_unit_c(lds, m0, bh & 3, 4, GQ, GK, GV, GR, GLR, a.in[10], a.in[11], SIN + (size_t)u * 32768, a.in[12], OA, tid, lane, wave); } }
    XBAR(); STAMP(8);
#define P8_SMALL() do { pg8::SEpiBranch2 E{(const pg8::bf16_t*)GA + (size_t)MP * DM, (const pg8::bf16_t*)GB + (size_t)MP * DM, (pg8::bf16_t*)MG + (size_t)MP * DM}; \
      for (int u = vcu; u < 256; u += G) { __syncthreads(); sgemm_unit2(lds, OA + (size_t)MP * DM, WGLAO, OB + (size_t)MP * DM, WSBO, u, E); } } while (0)
    if (PH(11)) REP(11) { if (small_first) { P8_SMALL(); __syncthreads(); }
      { pg8::EpiBranch<0> E{(const pg8::bf16_t*)GA, (pg8::bf16_t*)TB, nullptr}; GEMM_PHASE(pg8::EpiBranch<0>, MP, OA, WGLAO, DM, DM, E); }
      { pg8::EpiBranch<1> E{(const pg8::bf16_t*)GB, (pg8::bf16_t*)TB, (pg8::bf16_t*)MG}; GEMM_PHASE(pg8::EpiBranch<1>, MP, OB, WSBO, DM, DM, E); }
      if (!small_first) P8_SMALL(); }
    XBAR(); STAMP(9);
#define P9_SMALL() do { pg8::SEpiResid<true> E{HB + (size_t)MP * DM, (pg8::bf16_t*)R + (size_t)MP * DM, DN_ALPHA, 1.0f}; for (int u = vcu; u < 256; u += G) { __syncthreads(); sgemm_unit(lds, MG + (size_t)MP * DM, WOUT, DM, u, E); } } while (0)
    if (PH(13)) REP(13) { if (small_first) { P9_SMALL(); __syncthreads(); }
      { pg8::EpiResid<true> E{HB, (pg8::bf16_t*)R, DN_ALPHA, 1.0f}; GEMM_PHASE(pg8::EpiResid<true>, MP, MG, WOUT, DM, DM, E); }
      if (!small_first) P9_SMALL(); }
    XBAR(); STAMP(10);
    if (PH(14)) REP(14) ln_phase<0>(R, nullptr, HB, a.in[16], a.in[17], gw, NGW, lane);
    XBAR(); STAMP(11);
    if (PH(15)) REP(15) { pg8::EpiSwiGLU E{(pg8::bf16_t*)ACT, DFF}; GEMM_PHASE(pg8::EpiSwiGLU, MT, HB, W2IN, 2 * DFF, DM, E);
      { const int nlast = (MT / 256) * (2 * DFF / 256) - 6 * G;
        if (G == 256 && bx >= nlast) { __syncthreads(); int t2 = threadIdx.x; asm volatile("" : "+v"(t2)); const int lane2 = t2 & 63, wave2 = __builtin_amdgcn_readfirstlane(t2 >> 6);
          LAS float* scr = (LAS float*)(lds + wave2 * 16384); int itbase = 0; const int gw2 = (bx - nlast) * NWAVES + wave2, NGW2 = (G - nlast) * NWAVES;
          p0_weight<0>(a.in[19], DM, DFF, DM, W2OUT, scr, lane2, gw2, NGW2, itbase); } } }
    XBAR(); STAMP(12);
#define P12_SMALL() do { pg8::SEpiResid<true> E{HB + (size_t)MP * DM, (pg8::bf16_t*)R + (size_t)MP * DM, DN_ALPHA, 0.5f}; for (int u = vcu; u < 256; u += G) { __syncthreads(); sgemm_unit(lds, ACT + (size_t)MP * DFF, W2OUT, DFF, u, E); } } while (0)
    if (PH(16)) REP(16) { if (small_first) { P12_SMALL(); __syncthreads(); }
      { pg8::EpiResid<true> E{HB, (pg8::bf16_t*)R, DN_ALPHA, 0.5f}; GEMM_PHASE(pg8::EpiResid<true>, MP, ACT, W2OUT, DM, DFF, E); }
      if (!small_first) P12_SMALL(); }
    XBAR(); STAMP(13);
    if (PH(17)) REP(17) ln_phase<1>(R, out + O_Y, nullptr, a.in[20], a.in[21], gw, NGW, lane);
#ifdef TP_A
    XBAR(); STAMP(14);
#endif
#ifdef PROBE_A0
    XBAR(); STAMP(14);
    __syncthreads();
    if (bx == 0) {
#define TS(k) (((unsigned long long)MISC[17 + 2 * (k)] << 32) | (unsigned long long)MISC[16 + 2 * (k)])
        const float tA = (float)(long long)(TS(PROBE_A1) - TS(PROBE_A0)) * 0.01f, tB = (float)(long long)(TS(PROBE_B1) - TS(PROBE_B0)) * 0.01f;
        const float c = sqrtf(tA);
        for (int i = tid; i < MS * DM; i += 512) out[O_Y + (size_t)MP * DM + i] = c;
        if (tid == 0) out[O_VS] += tB;
    }
#endif
}

extern "C" void kernel_launch(void* const* d_in, const int* in_sizes, int n_in, void* d_out, int out_size, void* d_ws, size_t ws_size, hipStream_t stream) {
    static int grid = 0;
    if (grid == 0) {
        if (n_in != 22 || (size_t)out_size != O_END || ws_size < WS_END) { fprintf(stderr, "kernel_launch: unexpected shapes: n_in %d out %d ws %zu\n", n_in, out_size, ws_size); grid = -1; return; }
        int dev = 0, cus = 0, per_cu = 0;
        if (hipGetDevice(&dev) != hipSuccess || hipDeviceGetAttribute(&cus, hipDeviceAttributeMultiprocessorCount, dev) != hipSuccess) { grid = -1; return; }
        if (hipFuncSetAttribute((const void*)mk_fwd, hipFuncAttributeMaxDynamicSharedMemorySize, LDS_BYTES) != hipSuccess) { fprintf(stderr, "kernel_launch: hipFuncSetAttribute failed\n"); grid = -1; return; }
        if (hipOccupancyMaxActiveBlocksPerMultiprocessor(&per_cu, (const void*)mk_fwd, NWAVES * 64, LDS_BYTES) != hipSuccess || per_cu < 1) fprintf(stderr, "kernel_launch: occupancy query says %d\n", per_cu);
        (void)hipGetLastError();
        grid = cus;
    }
    if (grid < 0) return;
    if (hipMemsetAsync((char*)d_ws + WS_CTL, 0, CTL_ZERO_BYTES, stream) != hipSuccess) return;
    Args a{};
    for (int i = 0; i < 22; ++i) a.in[i] = (const float*)d_in[i];
    a.out = (float*)d_out; a.ws = (unsigned char*)d_ws;
    hipLaunchKernelGGL(mk_fwd, dim3(grid), dim3(NWAVES * 64), LDS_BYTES, stream, a);
    const hipError_t le = hipPeekAtLastError();
    if (le != hipSuccess) fprintf(stderr, "kernel_launch: launch failed: %s\n", hipGetErrorName(le));
}
```

```cpp
#include <hip/hip_runtime.h>
#include <cstdio>
#include <cstdint>
namespace pg8 {
#define PG8_LAS __attribute__((address_space(3)))
typedef unsigned short bf16_t;
typedef short bf16x8 __attribute__((ext_vector_type(8)));
typedef float f32x4 __attribute__((ext_vector_type(4)));
typedef unsigned u32x4 __attribute__((ext_vector_type(4)));
constexpr int BM = 256, BK = 64, HALF = 128, HTB = HALF * BK * 2  , STAGE_BYTES = 8 * HTB, NXCD = 8, WGM = 8;

__host__ __device__ __forceinline__ int lds_byte(int r, int c) { const int st = (r >> 4) * 2 + (c >> 5), rr = r & 15, cc = c & 31, ob = rr * 64 + cc * 2; return st * 1024 + (ob ^ (((ob >> 9) & 1) << 5)); }
__host__ __device__ __forceinline__ void stage_rc(int b, int& R, int& C) { const int st = b / 1024, sb = b % 1024, swz = sb ^ (((sb >> 9) & 1) << 5); R = (st >> 1) * 16 + swz / 64; C = (st & 1) * 32 + (swz % 64) / 2; }
__host__ __device__ __forceinline__ int perm32(int rho) { const int n = rho >> 4, i = rho & 15; return 8 * (i >> 2) + 4 * n + (i & 3); }

struct Unit { int pm, pn; };
struct Gemm { const bf16_t* A; const bf16_t* Bt; int M, N, K; };

struct StaticOrder {
    int nM, nN, nwg, G, c, wgm;
    __host__ __device__ void init(int M, int N, int G_, int c_) { nM = M / BM; nN = N / BM; nwg = nM * nN; G = G_; c = c_; wgm = WGM; }
    __host__ __device__ bool next(int i, Unit& u) const {
        const long L = (long)i * G + c; if (L >= nwg) return false;
        int wgid = (int)L; { const int q = nwg / NXCD, r = nwg % NXCD, xcd = wgid % NXCD, off = wgid / NXCD; wgid = (xcd < r ? xcd * (q + 1) : r * (q + 1) + (xcd - r) * q) + off; }
        const int nig = wgm * nN, gid = wgid / nig, fm = gid * wgm, gsz = (nM - fm) < wgm ? (nM - fm) : wgm;
        u.pm = fm + ((wgid % nig) % gsz); u.pn = (wgid % nig) / gsz; return true;
    }
    __device__ __forceinline__ void a_ready(const Unit&) const {}
    __device__ __forceinline__ void done(const Unit&) const {}
};

struct FfnOrder {
    StaticOrder so; int G, c;
    __host__ __device__ void init(int G_, int c_) { so.init(16384, 5632, G_, c_); G = G_; c = c_; }
    __host__ __device__ bool next(int i, Unit& u) const {
        const long L = (long)i * G + c; if (L >= 1536) return false;
        if (L < 1408) return so.next(i, u);
        const int l2 = (int)L - 1408; u.pm = 64 + (l2 & 7); u.pn = l2 >> 3; return true;
    }
    __device__ __forceinline__ void a_ready(const Unit&) const {}
    __device__ __forceinline__ void done(const Unit&) const {}
};
typedef __bf16 bf16x2c_t __attribute__((ext_vector_type(2))); typedef float f32x2c_t __attribute__((ext_vector_type(2)));
__device__ __forceinline__ unsigned cvt_pk_bf16(float lo, float hi) { const f32x2c_t v = {lo, hi}; const bf16x2c_t b = __builtin_convertvector(v, bf16x2c_t); return __builtin_bit_cast(unsigned, b); }
__device__ __forceinline__ float fast_sigmoid(float x) { return __builtin_amdgcn_rcpf(1.0f + __builtin_amdgcn_exp2f(-1.4426950408889634f * x)); }
struct EpiSwiGLU {
    static constexpr bool PERM = true, AFTER_DRAIN = false;
    bf16_t* O; int ldc;
    __device__ __forceinline__ void operator()(const f32x4 (&acc)[2][2][4][2], const Unit& u, int wr, int wc, int fr, int fq) const {
        const int row0 = u.pm * BM + wr * 64 + fr, col0 = u.pn * HALF + wc * 32 + 8 * fq;
#pragma unroll
        for (int ai = 0; ai < 2; ++ai)
#pragma unroll
            for (int m = 0; m < 4; ++m) { bf16_t* rowp = O + (size_t)(row0 + ai * HALF + m * 16) * ldc + col0;
                float o[8];
#pragma unroll
                for (int n = 0; n < 2; ++n)
#pragma unroll
                    for (int j = 0; j < 4; ++j) { const float g = acc[ai][0][m][n][j], up = acc[ai][1][m][n][j]; o[n * 4 + j] = g * fast_sigmoid(g) * up; }
                u32x4 w; w.x = cvt_pk_bf16(o[0], o[1]); w.y = cvt_pk_bf16(o[2], o[3]); w.z = cvt_pk_bf16(o[4], o[5]); w.w = cvt_pk_bf16(o[6], o[7]);
                *(u32x4*)rowp = w; }
    }
};
template <bool BF> struct EpiResid {
    static constexpr bool PERM = true, AFTER_DRAIN = false;
    const void* base; bf16_t* out; float alpha, beta;
    __device__ __forceinline__ void operator()(const f32x4 (&acc)[2][2][4][2], const Unit& u, int wr, int wc, int fr, int fq) const {
        const int row0 = u.pm * BM + wr * 64 + fr, col0 = u.pn * BM + wc * 32 + 8 * fq;
#pragma unroll
        for (int ai = 0; ai < 2; ++ai)
#pragma unroll
            for (int m = 0; m < 4; ++m) { const size_t ro = (size_t)(row0 + ai * HALF + m * 16) * 1024 + col0;
#pragma unroll
                for (int bj = 0; bj < 2; ++bj) { f32x4 b0, b1;
                    if (BF) { const u32x4 w = *(const u32x4*)((const bf16_t*)base + ro + bj * HALF);
                        b0 = (f32x4){__uint_as_float(w.x << 16), __uint_as_float(w.x & 0xffff0000u), __uint_as_float(w.y << 16), __uint_as_float(w.y & 0xffff0000u)};
                        b1 = (f32x4){__uint_as_float(w.z << 16), __uint_as_float(w.z & 0xffff0000u), __uint_as_float(w.w << 16), __uint_as_float(w.w & 0xffff0000u)}; }
                    else { b0 = *(const f32x4*)((const float*)base + ro + bj * HALF); b1 = *(const f32x4*)((const float*)base + ro + bj * HALF + 4); }
                    const f32x4 v0 = b0 * alpha + acc[ai][bj][m][0] * beta, v1 = b1 * alpha + acc[ai][bj][m][1] * beta;
                    u32x4 w; w.x = cvt_pk_bf16(v0[0], v0[1]); w.y = cvt_pk_bf16(v0[2], v0[3]); w.z = cvt_pk_bf16(v1[0], v1[1]); w.w = cvt_pk_bf16(v1[2], v1[3]);
                    *(u32x4*)(out + ro + bj * HALF) = w; } }
    }
};
template <bool BF> struct SEpiResid {
    const void* base; bf16_t* out; float alpha, beta;
    __device__ __forceinline__ void apply(int row, int col, f32x4 v) const { const size_t o = (size_t)row * 1024 + col; f32x4 b;
        if (BF) { const unsigned long long w = *(const unsigned long long*)((const bf16_t*)base + o); const unsigned lo = (unsigned)w, hi = (unsigned)(w >> 32);
            b = (f32x4){__uint_as_float(lo << 16), __uint_as_float(lo & 0xffff0000u), __uint_as_float(hi << 16), __uint_as_float(hi & 0xffff0000u)}; }
        else b = *(const f32x4*)((const float*)base + o);
        v = b * alpha + v * beta;
        *(unsigned long long*)(out + o) = (unsigned long long)cvt_pk_bf16(v[0], v[1]) | ((unsigned long long)cvt_pk_bf16(v[2], v[3]) << 32); }
};
template <int SECOND> struct SEpiBranch {
    const bf16_t* G; bf16_t* Tb; bf16_t* Mg;
    __device__ __forceinline__ void apply(int row, int col, f32x4 v) const { const size_t o = (size_t)row * 1024 + col;
        const unsigned long long w = *(const unsigned long long*)(G + o); const unsigned lo = (unsigned)w, hi = (unsigned)(w >> 32);
        v = v * (f32x4){__uint_as_float(lo << 16), __uint_as_float(lo & 0xffff0000u), __uint_as_float(hi << 16), __uint_as_float(hi & 0xffff0000u)};
        if (SECOND) { const unsigned long long t = *(const unsigned long long*)(Tb + o); const unsigned tl = (unsigned)t, th = (unsigned)(t >> 32);
            v = v + (f32x4){__uint_as_float(tl << 16), __uint_as_float(tl & 0xffff0000u), __uint_as_float(th << 16), __uint_as_float(th & 0xffff0000u)}; }
        *(unsigned long long*)((SECOND ? Mg : Tb) + o) = (unsigned long long)cvt_pk_bf16(v[0], v[1]) | ((unsigned long long)cvt_pk_bf16(v[2], v[3]) << 32); }
};
struct SEpiBranch2 {
    const bf16_t* Ga; const bf16_t* Gb; bf16_t* Mg;
    __device__ __forceinline__ void apply2(int row, int col, f32x4 v0, f32x4 v1) const { const size_t o = (size_t)row * 1024 + col;
        const unsigned long long wa = *(const unsigned long long*)(Ga + o), wb = *(const unsigned long long*)(Gb + o); const unsigned al = (unsigned)wa, ah = (unsigned)(wa >> 32), bl = (unsigned)wb, bh = (unsigned)(wb >> 32);
        const f32x4 v = v0 * (f32x4){__uint_as_float(al << 16), __uint_as_float(al & 0xffff0000u), __uint_as_float(ah << 16), __uint_as_float(ah & 0xffff0000u)}
                      + v1 * (f32x4){__uint_as_float(bl << 16), __uint_as_float(bl & 0xffff0000u), __uint_as_float(bh << 16), __uint_as_float(bh & 0xffff0000u)};
        *(unsigned long long*)(Mg + o) = (unsigned long long)cvt_pk_bf16(v[0], v[1]) | ((unsigned long long)cvt_pk_bf16(v[2], v[3]) << 32); }
};
struct EpiMixIn {
    static constexpr bool PERM = true, AFTER_DRAIN = false;
    bf16_t *GQ, *GK, *GV, *GR, *SQ, *SKB, *SVB, *GA, *GB; float *okp, *oks, *ovp, *ovs;
    template <int ACT> __device__ __forceinline__ void store_bf(const f32x4 (&acc)[2][2][4][2], bf16_t* dst, int ld, int row0, int col0, float sc) const {
#pragma unroll
        for (int ai = 0; ai < 2; ++ai)
#pragma unroll
            for (int m = 0; m < 4; ++m) { bf16_t* rp = dst + (size_t)(row0 + ai * HALF + m * 16) * ld + col0;
#pragma unroll
                for (int bj = 0; bj < 2; ++bj) { f32x4 v0 = acc[ai][bj][m][0], v1 = acc[ai][bj][m][1];
                    if (ACT == 1) {
#pragma unroll
                        for (int j = 0; j < 4; ++j) { v0[j] = v0[j] * fast_sigmoid(v0[j]); v1[j] = v1[j] * fast_sigmoid(v1[j]); } }
                    else if (ACT == 2) {
#pragma unroll
                        for (int j = 0; j < 4; ++j) { v0[j] = fast_sigmoid(v0[j]); v1[j] = fast_sigmoid(v1[j]); } }
                    else { v0 = v0 * sc; v1 = v1 * sc; }
                    u32x4 w; w.x = cvt_pk_bf16(v0[0], v0[1]); w.y = cvt_pk_bf16(v0[2], v0[3]); w.z = cvt_pk_bf16(v1[0], v1[1]); w.w = cvt_pk_bf16(v1[2], v1[3]);
                    *(u32x4*)(rp + bj * HALF) = w; } }
    }
    __device__ __forceinline__ void store_f32(const f32x4 (&acc)[2][2][4][2], float* dst, int row0, int col0) const {
#pragma unroll
        for (int ai = 0; ai < 2; ++ai)
#pragma unroll
            for (int m = 0; m < 4; ++m) { float* rp = dst + (size_t)(row0 + ai * HALF + m * 16) * 1024 + col0;
#pragma unroll
                for (int bj = 0; bj < 2; ++bj) { *(f32x4*)(rp + bj * HALF) = acc[ai][bj][m][0]; *(f32x4*)(rp + bj * HALF + 4) = acc[ai][bj][m][1]; } }
    }
    __device__ __forceinline__ void operator()(const f32x4 (&acc)[2][2][4][2], const Unit& u, int wr, int wc, int fr, int fq) const {
        const int pn = u.pn, row0 = u.pm * BM + wr * 64 + fr, cw = wc * 32 + 8 * fq;
        if (pn < 2) store_bf<0>(acc, GQ, 512, row0, pn * 256 + cw, 0.08838834764831845f);
        else if (pn < 4) store_bf<0>(acc, GK, 512, row0, (pn - 2) * 256 + cw, 1.0f);
        else if (pn < 8) store_bf<0>(acc, GV, 1024, row0, (pn - 4) * 256 + cw, 1.0f);
        else if (pn < 12) store_bf<1>(acc, GR, 1024, row0, (pn - 8) * 256 + cw, 1.0f);
        else if (pn < 16) store_bf<0>(acc, SQ, 1024, row0, (pn - 12) * 256 + cw, 0.08838834764831845f * 1.4426950408889634f);
        else if (pn < 20) store_bf<0>(acc, SKB, 1024, row0, (pn - 16) * 256 + cw, 1.0f);
        else if (pn < 24) store_bf<0>(acc, SVB, 1024, row0, (pn - 20) * 256 + cw, 1.0f);
        else if (pn < 28) store_bf<2>(acc, GA, 1024, row0, (pn - 24) * 256 + cw, 1.0f);
        else store_bf<2>(acc, GB, 1024, row0, (pn - 28) * 256 + cw, 1.0f);
    }
};
template <int SECOND> struct EpiBranch {
    static constexpr bool PERM = true, AFTER_DRAIN = false;
    const bf16_t* G; bf16_t* Tb; bf16_t* Mg;
    __device__ __forceinline__ void operator()(const f32x4 (&acc)[2][2][4][2], const Unit& u, int wr, int wc, int fr, int fq) const {
        const int row0 = u.pm * BM + wr * 64 + fr, col0 = u.pn * BM + wc * 32 + 8 * fq;
#pragma unroll
        for (int ai = 0; ai < 2; ++ai)
#pragma unroll
            for (int m = 0; m < 4; ++m) { const size_t ro = (size_t)(row0 + ai * HALF + m * 16) * 1024 + col0;
#pragma unroll
                for (int bj = 0; bj < 2; ++bj) { const u32x4 gw = *(const u32x4*)(G + ro + bj * HALF);
                    f32x4 v0 = acc[ai][bj][m][0], v1 = acc[ai][bj][m][1];
                    v0 = v0 * (f32x4){__uint_as_float(gw.x << 16), __uint_as_float(gw.x & 0xffff0000u), __uint_as_float(gw.y << 16), __uint_as_float(gw.y & 0xffff0000u)};
                    v1 = v1 * (f32x4){__uint_as_float(gw.z << 16), __uint_as_float(gw.z & 0xffff0000u), __uint_as_float(gw.w << 16), __uint_as_float(gw.w & 0xffff0000u)};
                    if (SECOND) { const u32x4 tw = *(const u32x4*)(Tb + ro + bj * HALF);
                        v0 = v0 + (f32x4){__uint_as_float(tw.x << 16), __uint_as_float(tw.x & 0xffff0000u), __uint_as_float(tw.y << 16), __uint_as_float(tw.y & 0xffff0000u)};
                        v1 = v1 + (f32x4){__uint_as_float(tw.z << 16), __uint_as_float(tw.z & 0xffff0000u), __uint_as_float(tw.w << 16), __uint_as_float(tw.w & 0xffff0000u)}; }
                    u32x4 w; w.x = cvt_pk_bf16(v0[0], v0[1]); w.y = cvt_pk_bf16(v0[2], v0[3]); w.z = cvt_pk_bf16(v1[0], v1[1]); w.w = cvt_pk_bf16(v1[2], v1[3]);
                    *(u32x4*)((SECOND ? Mg : Tb) + ro + bj * HALF) = w; } }
    }
};
struct EpiNull {
    static constexpr bool PERM = true, AFTER_DRAIN = false; float* sink;
    __device__ __forceinline__ void operator()(const f32x4 (&acc)[2][2][4][2], const Unit& u, int wr, int wc, int fr, int fq) const {
        f32x4 s = {0.f, 0.f, 0.f, 0.f};
#pragma unroll
        for (int ai = 0; ai < 2; ++ai)
#pragma unroll
            for (int bj = 0; bj < 2; ++bj)
#pragma unroll
                for (int m = 0; m < 4; ++m) { s = s + acc[ai][bj][m][0]; s = s + acc[ai][bj][m][1]; }
        if (s[0] + s[1] + s[2] + s[3] == 12345.678f) sink[0] = s[0];
    }
};
template <class Epi, class Sched, bool ALIGN_EPI = false, bool SP2 = false>
__device__ __forceinline__ void gemm_phase(PG8_LAS unsigned char* lds, const Gemm g, const Sched& S, const Epi& E) {
    int tid_ = threadIdx.x; asm volatile("" : "+v"(tid_));
    const int tid = tid_, wid = __builtin_amdgcn_readfirstlane(tid >> 6), lane = tid & 63, wr = wid >> 2, wc = wid & 3, fr = lane & 15, fq = lane >> 4;
    const int K = g.K, nt = K / BK;
    unsigned voffA[2], voffB[2];
#pragma unroll
    for (int i = 0; i < 2; ++i) { int R, C; stage_rc(tid * 16 + i * 8192, R, C); const int Rb = Epi::PERM ? ((R & ~31) + perm32(R & 31)) : R;
        voffA[i] = (unsigned)(R * K + C) * 2u; voffB[i] = (unsigned)(Rb * K + C) * 2u; }
    const size_t kstep = (size_t)(BK * 2);
    const size_t hstep = (size_t)HALF * K * 2;
    const size_t tstep = 2 * hstep;
    const unsigned ldsw = (unsigned)wid * 1024u;
    const int aoff = lds_byte(wr * 64 + fr, fq * 8), boff = lds_byte(wc * 32 + fr, fq * 8);
#define PG8_SA(b, h) (((b) * 2 + (h)) * HTB)
#define PG8_SB(b, h) ((4 + (b) * 2 + (h)) * HTB)
#define PG8_STAGE(bufoff, gbase, voff) do { _Pragma("unroll") for (int _i = 0; _i < 2; ++_i) \
        __builtin_amdgcn_global_load_lds((const unsigned*)((const char*)(gbase) + (voff)[_i]), (PG8_LAS unsigned*)(lds + (bufoff) + ldsw + _i * 8192), 16, 0, 0); } while (0)
#define PG8_LDA(dst, b, h) do { _Pragma("unroll") for (int m = 0; m < 4; ++m) _Pragma("unroll") for (int k = 0; k < 2; ++k) dst[m][k] = *(const PG8_LAS bf16x8*)(lds + PG8_SA(b, h) + aoff + m * 2048 + k * 1024); } while (0)
#define PG8_LDB(dst, b, h) do { _Pragma("unroll") for (int n = 0; n < 2; ++n) _Pragma("unroll") for (int k = 0; k < 2; ++k) dst[n][k] = *(const PG8_LAS bf16x8*)(lds + PG8_SB(b, h) + boff + n * 2048 + k * 1024); } while (0)
#define PG8_MMA(ai, bj, At, Bt) do { __builtin_amdgcn_s_setprio(1); _Pragma("unroll") for (int m = 0; m < 4; ++m) _Pragma("unroll") for (int n = 0; n < 2; ++n) _Pragma("unroll") for (int k = 0; k < 2; ++k) \
        acc[ai][bj][m][n] = __builtin_amdgcn_mfma_f32_16x16x32_bf16(Bt[n][k], At[m][k], acc[ai][bj][m][n], 0, 0, 0); __builtin_amdgcn_s_setprio(0); } while (0)
#define PG8_WAIT_V(n) asm volatile("s_waitcnt vmcnt(" #n ")" ::: "memory")
#define PG8_WAIT_L(n) asm volatile("s_waitcnt lgkmcnt(" #n ")" ::: "memory")
#define PG8_BAR __builtin_amdgcn_s_barrier()
#define PG8_SCHED __builtin_amdgcn_sched_barrier(0)
    Unit cur, nxt; int ui = 0;
    if (!S.next(0, cur)) return;
    f32x4 acc[2][2][4][2];
#pragma unroll
    for (int a = 0; a < 2; ++a)
#pragma unroll
        for (int b = 0; b < 2; ++b)
#pragma unroll
            for (int m = 0; m < 4; ++m)
#pragma unroll
                for (int n = 0; n < 2; ++n) acc[a][b][m][n] = (f32x4){0.f, 0.f, 0.f, 0.f};
    bf16x8 At[4][2], B0[2][2], B1[2][2];
    const char* cA = (const char*)g.A + (size_t)cur.pm * tstep; const char* cB = (const char*)g.Bt + (size_t)cur.pn * tstep;
    S.a_ready(cur);
    if constexpr (SP2) {
        PG8_STAGE(PG8_SB(0, 0), cB, voffB); PG8_STAGE(PG8_SB(0, 1), cB + hstep, voffB); PG8_STAGE(PG8_SA(0, 0), cA, voffA); PG8_STAGE(PG8_SA(0, 1), cA + hstep, voffA);
        if (wr == 1) PG8_BAR;
        PG8_WAIT_V(2); PG8_BAR;
        PG8_STAGE(PG8_SB(1, 0), cB + kstep, voffB); PG8_STAGE(PG8_SA(1, 0), cA + kstep, voffA); PG8_STAGE(PG8_SB(1, 1), cB + hstep + kstep, voffB);
        PG8_WAIT_V(6); PG8_BAR;
    } else {
        PG8_STAGE(PG8_SB(0, 0), cB, voffB); PG8_STAGE(PG8_SA(0, 0), cA, voffA); PG8_STAGE(PG8_SB(0, 1), cB + hstep, voffB); PG8_STAGE(PG8_SA(0, 1), cA + hstep, voffA);
        if (wr == 1) PG8_BAR;
        PG8_WAIT_V(4); PG8_BAR;
        PG8_STAGE(PG8_SB(1, 0), cB + kstep, voffB); PG8_STAGE(PG8_SA(1, 0), cA + kstep, voffA); PG8_STAGE(PG8_SB(1, 1), cB + hstep + kstep, voffB);
        PG8_WAIT_V(6); PG8_BAR;
    }
    for (;;) {
        const bool has_next = S.next(ui + 1, nxt);
        const char* nA = has_next ? (const char*)g.A + (size_t)nxt.pm * tstep : cA; const char* nB = has_next ? (const char*)g.Bt + (size_t)nxt.pn * tstep : cB;
        for (int t = 0; t < nt; t += 2) {
            const bool last = (t == nt - 2);
            const char* a1 = cA + (size_t)(t + 1) * kstep;
            const char* a2 = last ? nA : cA + (size_t)(t + 2) * kstep; const char* b2 = last ? nB : cB + (size_t)(t + 2) * kstep;
            const char* a3 = a2 + kstep; const char* b3 = b2 + kstep;
            if (last && has_next) S.a_ready(nxt);
            if constexpr (SP2) {
            PG8_LDB(B0, 0, 0); PG8_LDB(B1, 0, 1); PG8_SCHED; PG8_LDA(At, 0, 0); PG8_STAGE(PG8_SA(1, 1), a1 + hstep, voffA);
            PG8_WAIT_V(8); PG8_WAIT_L(0); PG8_BAR; PG8_MMA(0, 0, At, B0); PG8_MMA(0, 1, At, B1); PG8_BAR; PG8_SCHED;
            PG8_LDA(At, 0, 1); PG8_STAGE(PG8_SB(0, 0), b2, voffB); PG8_STAGE(PG8_SB(0, 1), b2 + hstep, voffB); PG8_STAGE(PG8_SA(0, 0), a2, voffA);
            PG8_WAIT_V(8); PG8_WAIT_L(0); PG8_BAR; PG8_MMA(1, 0, At, B0); PG8_MMA(1, 1, At, B1); PG8_BAR; PG8_SCHED;
            PG8_LDB(B0, 1, 0); PG8_LDB(B1, 1, 1); PG8_SCHED; PG8_LDA(At, 1, 0); PG8_STAGE(PG8_SA(0, 1), a2 + hstep, voffA);
            PG8_WAIT_V(8); PG8_WAIT_L(0); PG8_BAR; PG8_MMA(0, 0, At, B0); PG8_MMA(0, 1, At, B1); PG8_BAR; PG8_SCHED;
            PG8_LDA(At, 1, 1); PG8_STAGE(PG8_SB(1, 0), b3, voffB); PG8_STAGE(PG8_SB(1, 1), b3 + hstep, voffB); PG8_STAGE(PG8_SA(1, 0), a3, voffA);
            PG8_WAIT_V(8); PG8_WAIT_L(0); PG8_BAR; PG8_MMA(1, 0, At, B0); PG8_MMA(1, 1, At, B1); PG8_BAR; PG8_SCHED;
            } else {
            PG8_LDB(B0, 0, 0); PG8_SCHED; PG8_LDA(At, 0, 0); PG8_STAGE(PG8_SA(1, 1), a1 + hstep, voffA);
            PG8_WAIT_L(8); PG8_BAR; PG8_WAIT_L(0); PG8_MMA(0, 0, At, B0); PG8_BAR; PG8_SCHED;
            PG8_LDB(B1, 0, 1); PG8_STAGE(PG8_SB(0, 0), b2, voffB);
            PG8_BAR; PG8_WAIT_L(0); PG8_MMA(0, 1, At, B1); PG8_BAR;
            PG8_LDA(At, 0, 1); PG8_STAGE(PG8_SA(0, 0), a2, voffA);
            PG8_BAR; PG8_WAIT_L(0); PG8_MMA(1, 0, At, B0); PG8_BAR; PG8_SCHED;
            PG8_STAGE(PG8_SB(0, 1), b2 + hstep, voffB);
            PG8_WAIT_V(6); PG8_BAR; PG8_MMA(1, 1, At, B1); PG8_BAR;
            PG8_LDB(B0, 1, 0); PG8_SCHED; PG8_LDA(At, 1, 0); PG8_STAGE(PG8_SA(0, 1), a2 + hstep, voffA);
            PG8_WAIT_L(8); PG8_BAR; PG8_WAIT_L(0); PG8_MMA(0, 0, At, B0); PG8_BAR; PG8_SCHED;
            PG8_LDB(B1, 1, 1); PG8_STAGE(PG8_SB(1, 0), b3, voffB);
            PG8_BAR; PG8_WAIT_L(0); PG8_MMA(0, 1, At, B1); PG8_BAR;
            PG8_LDA(At, 1, 1); PG8_STAGE(PG8_SA(1, 0), a3, voffA);
            PG8_BAR; PG8_WAIT_L(0); PG8_MMA(1, 0, At, B0); PG8_BAR; PG8_SCHED;
            PG8_STAGE(PG8_SB(1, 1), b3 + hstep, voffB);
            PG8_WAIT_V(6); PG8_BAR; PG8_MMA(1, 1, At, B1); PG8_BAR;
            }
        }
        if constexpr (ALIGN_EPI) { if (wr == 0) PG8_BAR; }
        if constexpr (!Epi::AFTER_DRAIN) { E(acc, cur, wr, wc, fr, fq); S.done(cur); }
        if (!has_next) break;
#pragma unroll
        for (int a = 0; a < 2; ++a)
#pragma unroll
            for (int b = 0; b < 2; ++b)
#pragma unroll
                for (int m = 0; m < 4; ++m)
#pragma unroll
                    for (int n = 0; n < 2; ++n) acc[a][b][m][n] = (f32x4){0.f, 0.f, 0.f, 0.f};
        cur = nxt; cA = nA; cB = nB; ++ui;
        if constexpr (ALIGN_EPI) { if (wr == 1) PG8_BAR; }
    }
    PG8_WAIT_V(0);
    if constexpr (!ALIGN_EPI) { if (wr == 0) PG8_BAR; }
    PG8_BAR;
    if constexpr (Epi::AFTER_DRAIN) { E.fused(acc, cur, wr, wc, fr, fq, lds, wid, lane); S.done(cur); }
#undef PG8_SA
#undef PG8_SB
#undef PG8_STAGE
#undef PG8_LDA
#undef PG8_LDB
#undef PG8_MMA
#undef PG8_WAIT_V
#undef PG8_WAIT_L
#undef PG8_BAR
#undef PG8_SCHED
}
}
constexpr int NWAVES = 8;
constexpr int DM = 1024, MP = 16384, MS = 2048, MT = MP + MS, DFF = 2816, NIN = 8192, TSEQ = 8192, NCHP = 128  ;
constexpr float LN_EPS = 1e-5f;
constexpr float DN_ALPHA = 1.189207115002721f;
constexpr float LOG2E = 1.4426950408889634f;
constexpr size_t O_Y = 0, O_SGP = 18874368, O_KP = 19136512, O_VP = 35913728, O_SGS = 52690944, O_KS = 56885248, O_VS = 58982400, O_END = 61079552;
constexpr size_t MiB = 1u << 20;
constexpr size_t WS_CTL = 0, CTL_ZERO_BYTES = 32768;
constexpr size_t WS_W1IN = 2 * MiB, WS_W1OUT = 13 * MiB, WS_WIN = 19 * MiB, WS_WGLAO = 35 * MiB, WS_WSBO = 37 * MiB, WS_WOUT = 39 * MiB, WS_W2IN = 41 * MiB, WS_W2OUT = 52 * MiB;
constexpr size_t WS_XB = 64 * MiB, WS_HB = 100 * MiB, WS_ACT = 136 * MiB, WS_R = 236 * MiB, WS_H = 308 * MiB;
constexpr size_t WS_GQ = 380 * MiB, WS_GK = 398 * MiB, WS_GV = 416 * MiB, WS_GR = 452 * MiB, WS_SQ = 488 * MiB, WS_SKB = 524 * MiB, WS_SVB = 556 * MiB, WS_GA = 588 * MiB, WS_GB = 624 * MiB;
constexpr size_t WS_B2 = 660 * MiB, WS_DS = 696 * MiB, WS_STS = 824 * MiB, WS_OA = 888 * MiB, WS_OB = 924 * MiB, WS_MG = 960 * MiB, WS_SKB2 = 996 * MiB, WS_SVB2 = 1032 * MiB, WS_END = 1068 * MiB;
constexpr int CW_TMO = 0, CW_BAR = 4096;
constexpr int RING_OFF = 0, RING_BYTES = 131072;
constexpr int LDS_BYTES = 147456;
constexpr int MISC_OFF = LDS_BYTES - 256;
#define GAS __attribute__((address_space(1)))
#define LAS __attribute__((address_space(3)))
typedef unsigned short bf16;
typedef unsigned v4u __attribute__((ext_vector_type(4)));
typedef float f32x4 __attribute__((ext_vector_type(4)));
typedef short bf16x8 __attribute__((ext_vector_type(8)));
typedef GAS unsigned gu32;
typedef GAS unsigned long long gu64;
#define RLX_AGENT __ATOMIC_RELAXED, __HIP_MEMORY_SCOPE_AGENT
#define LDS_WAIT() asm volatile("s_waitcnt lgkmcnt(0)" ::: "memory")
#define VM_WAIT() asm volatile("s_waitcnt vmcnt(0)" ::: "memory")
__device__ __forceinline__ unsigned long long rt() { return __builtin_amdgcn_s_memrealtime(); }
__device__ __forceinline__ unsigned f2bf(float f) { unsigned u = __builtin_bit_cast(unsigned, f); return (u + 0x7fffu + ((u >> 16) & 1u)) >> 16; }
__device__ __forceinline__ unsigned pk2(float lo, float hi) { return f2bf(lo) | (f2bf(hi) << 16); }

#define XB_TMO      128
#define XB_XCNT(j)  (256  + 64 * (j))
#define XB_XSUB(j)  (1280 + 64 * (j))
#define XB_XGEN(j)  (2304 + 64 * (j))
#define XB_TOP      3328
#define XB_TOPGEN   3392
#define XCD_BAR_WORDS 3456
#define XB_SPIN_CAP (1u << 18)

__device__ __forceinline__ unsigned xb_ld(unsigned* p)              { return __hip_atomic_load(p, __ATOMIC_RELAXED, __HIP_MEMORY_SCOPE_AGENT); }
__device__ __forceinline__ unsigned xb_add(unsigned* p, unsigned v) { return __hip_atomic_fetch_add(p, v, __ATOMIC_RELAXED, __HIP_MEMORY_SCOPE_AGENT); }
__device__ __forceinline__ unsigned xb_xcc_id() { return (unsigned)__builtin_amdgcn_s_getreg((3 << 11) | 20) & 0xFu; }
#define XB_SPIN(cond, bar) do { unsigned _sp = 0; while (cond) { __builtin_amdgcn_s_sleep(1); \
    if ((++_sp & 255u) == 0u) { if (xb_ld(&(bar)[XB_TMO])) break; if (_sp > XB_SPIN_CAP) { atomicAdd(&(bar)[XB_TMO], 1u); break; } } } } while (0)

struct XcdBarrier {
    unsigned* bar; unsigned x;
    volatile LAS unsigned* st;
};

__device__ __forceinline__ XcdBarrier xcd_barrier_post(unsigned* bar, volatile LAS unsigned* st) {
    XcdBarrier b; b.bar = bar; b.x = xb_xcc_id(); b.st = st;
    if (threadIdx.x == 0) (void)xb_add(&bar[XB_XCNT(b.x)], 1u);
    return b;
}
__device__ __forceinline__ void xcd_barrier_complete(unsigned* bar, unsigned x, unsigned& nloc, unsigned& nx) {
    const unsigned G = gridDim.x * gridDim.y * gridDim.z;
    unsigned sum, cnt, mine, sp = 0u;
    for (;;) {
        sum = 0u; cnt = 0u; mine = 0u;
#pragma unroll
        for (unsigned j = 0; j < 16; ++j) { const unsigned c = xb_ld(&bar[XB_XCNT(j)]); sum += c; cnt += (c > 0u) ? 1u : 0u; mine = (j == x) ? c : mine; }
        if (sum == G) break;
        __builtin_amdgcn_s_sleep(1);
        if ((++sp & 255u) == 0u) { if (xb_ld(&bar[XB_TMO])) break; if (sp > XB_SPIN_CAP) { atomicAdd(&bar[XB_TMO], 1u); break; } }
    }
    nloc = mine > 0u ? mine : 1u; nx = cnt > 0u ? cnt : 1u;
}

__device__ __forceinline__ void xcd_barrier(const XcdBarrier& b) {
    asm volatile("s_waitcnt vmcnt(0)" ::: "memory");
    __syncthreads();
    if (threadIdx.x == 0) {
        unsigned* bar = b.bar;
        __builtin_amdgcn_s_waitcnt(0);
        unsigned nloc = b.st[0], nx = b.st[1];
        if (nloc == 0u) { xcd_barrier_complete(bar, b.x, nloc, nx); b.st[0] = nloc; b.st[1] = nx; }
        const unsigned old = xb_add(&bar[XB_XSUB(b.x)], 1u);
        const unsigned gen = old / nloc;
        if (old + 1u == (gen + 1u) * nloc) {
            __builtin_amdgcn_fence(__ATOMIC_RELEASE, "agent");
            asm volatile("s_waitcnt vmcnt(0)" ::: "memory");
            const unsigned og = xb_add(&bar[XB_TOP], 1u);
            const unsigned tg = og / nx;
            if (og + 1u == (tg + 1u) * nx) xb_add(&bar[XB_TOPGEN], 1u);
            else XB_SPIN(xb_ld(&bar[XB_TOPGEN]) == tg, bar);
            __builtin_amdgcn_fence(__ATOMIC_ACQUIRE, "agent");
            xb_add(&bar[XB_XGEN(b.x)], 1u);
            asm volatile("s_waitcnt vmcnt(0)" ::: "memory");
        } else {
            XB_SPIN(xb_ld(&bar[XB_XGEN(b.x)]) == gen, bar);
            __builtin_amdgcn_fence(__ATOMIC_ACQUIRE, "agent");
            asm volatile("s_waitcnt vmcnt(0)" ::: "memory");
        }
    }
    __syncthreads();
}
#ifdef TP_A
#define TSTAMP(k, lds_, tid_) do { if (blockIdx.x == 0 && ((k) == TP_A || (k) == TP_B)) { volatile LAS unsigned* M_ = (volatile LAS unsigned*)((lds_) + MISC_OFF); if ((tid_) == 0) { const unsigned long long t_ = __builtin_amdgcn_s_memrealtime(); \
        if ((k) == TP_A) { M_[16] = (unsigned)t_; M_[17] = (unsigned)(t_ >> 32); } \
        if ((k) == TP_B) { const unsigned long long t0_ = ((unsigned long long)M_[17] << 32) | (unsigned long long)M_[16]; const unsigned long long dl_ = t_ + (unsigned long long)TMULT * (t_ - t0_); \
            while (__builtin_amdgcn_s_memrealtime() < dl_) __builtin_amdgcn_s_sleep(8); } } \
        if ((k) == TP_B) __syncthreads(); } } while (0)
#else
#define TSTAMP(k, lds_, tid_) do { } while (0)
#endif
#define WG_BAR() do { asm volatile("s_waitcnt lgkmcnt(0)" ::: "memory"); __builtin_amdgcn_s_barrier(); asm volatile("" ::: "memory"); } while (0)
#define MFMA32(a, b, c) __builtin_amdgcn_mfma_f32_32x32x16_bf16((a), (b), (c), 0, 0, 0)
typedef float f32x16 __attribute__((ext_vector_type(16)));
typedef short s16x4 __attribute__((ext_vector_type(4)));
typedef unsigned u32x2 __attribute__((ext_vector_type(2)));
typedef float f32x2v __attribute__((ext_vector_type(2)));
typedef unsigned u32x4 __attribute__((ext_vector_type(4)));
__device__ __forceinline__ float wave_sum(float v) {
#pragma unroll
    for (int o = 1; o < 64; o <<= 1) v += __shfl_xor(v, o);
    return v;
}
__device__ __forceinline__ float bf_lo(unsigned w) { return __uint_as_float(w << 16); }
__device__ __forceinline__ float bf_hi(unsigned w) { return __uint_as_float(w & 0xffff0000u); }
typedef __bf16 bf16x2_t __attribute__((ext_vector_type(2)));
__device__ __forceinline__ unsigned cvtpk(float lo, float hi) { const f32x2v v = {lo, hi}; const bf16x2_t b = __builtin_convertvector(v, bf16x2_t); return __builtin_bit_cast(unsigned, b); }
__device__ __forceinline__ int crow(int r, int hi) { return (r & 3) + 8 * (r >> 2) + 4 * hi; }
__device__ __forceinline__ void p0_transpose_item(const float* W, int ldw, int col0, bf16* WT, int K, int row0, int k0, LAS float* scr, int lane) {
#pragma unroll 8
    for (int i = 0; i < 32; ++i) { const int kk = 2 * i + (lane >> 5); scr[kk * 33 + (lane & 31)] = W[(size_t)(k0 + kk) * ldw + col0 + (lane & 31)]; }
    LDS_WAIT(); asm volatile("" ::: "memory");
    const int c = lane & 7;
#pragma unroll
    for (int j = 0; j < 4; ++j) { const int n = (lane >> 3) + 8 * j; const LAS float* s = scr + (8 * c) * 33 + n;
        v4u o; o.x = pk2(s[0 * 33], s[1 * 33]); o.y = pk2(s[2 * 33], s[3 * 33]); o.z = pk2(s[4 * 33], s[5 * 33]); o.w = pk2(s[6 * 33], s[7 * 33]);
        *(GAS v4u*)(WT + (size_t)(row0 + n) * K + k0 + 8 * c) = o; }
    LDS_WAIT(); asm volatile("" ::: "memory");
}
template <int MODE> __device__ __forceinline__ void p0_weight(const float* W, int ldw, int K, int NOUT, bf16* WT, LAS float* scr, int lane, int gw, int NGW, int& itbase) {
    const int nblk = NOUT / 32, nitems = (K / 64) * nblk;
    int it = gw - (itbase % NGW); if (it < 0) it += NGW;
    for (; it < nitems; it += NGW) { const int kb = it / nblk, nb = it % nblk, n0 = 32 * nb; int c0 = n0;
        if (MODE == 1) { const int pn = n0 >> 8, s = (n0 >> 7) & 1, i = n0 & 127; c0 = s * DFF + 128 * pn + i; }
        if (MODE == 2) { c0 = n0 < 3072 ? n0 : n0 + 16; }
        p0_transpose_item(W, ldw, c0, WT, K, n0, 64 * kb, scr, lane); }
    itbase += nitems;
}
__device__ __forceinline__ void row_to_bf16(const float* xrow, bf16* orow, int lane) {
    const GAS f32x4* xr = (const GAS f32x4*)xrow + lane; GAS unsigned long long* o8 = (GAS unsigned long long*)orow + lane;
#pragma unroll
    for (int j = 0; j < 4; ++j) { const f32x4 v = xr[64 * j]; o8[64 * j] = (unsigned long long)pk2(v.x, v.y) | ((unsigned long long)pk2(v.z, v.w) << 32); }
}
__device__ __forceinline__ void ln_row(f32x4 (&v)[4], const f32x4 (&g)[4], const f32x4 (&b)[4]) {
    float s = 0.f;
#pragma unroll
    for (int j = 0; j < 4; ++j) s += (v[j].x + v[j].y) + (v[j].z + v[j].w);
    const float mean = wave_sum(s) * (1.f / DM); float s2 = 0.f;
#pragma unroll
    for (int j = 0; j < 4; ++j) { v[j] = v[j] - mean; s2 += (v[j].x * v[j].x + v[j].y * v[j].y) + (v[j].z * v[j].z + v[j].w * v[j].w); }
    const float rstd = 1.f / sqrtf(wave_sum(s2) * (1.f / DM) + LN_EPS);
#pragma unroll
    for (int j = 0; j < 4; ++j) v[j] = v[j] * rstd * g[j] + b[j];
}
constexpr int SG_S = 272, SG_A = 0, SG_B = 64 * 272, SG_BUF = 192 * 272;
#define SG_WRITE(S, BUF) do { LAS unsigned char* nb_ = lds + (BUF) * SG_BUF; *(LAS u32x4*)(nb_ + SG_A + wo) = a0_##S; *(LAS u32x4*)(nb_ + SG_A + wo + 128) = a1_##S; \
        *(LAS u32x4*)(nb_ + SG_B + wo) = b0_##S; *(LAS u32x4*)(nb_ + SG_B + wo + 128) = b1_##S; *(LAS u32x4*)(nb_ + SG_B + 64 * SG_S + wo) = b2_##S; *(LAS u32x4*)(nb_ + SG_B + 64 * SG_S + wo + 128) = b3_##S; } while (0)
#define SG_COMPUTE(BUF, AL, AH) do { const LAS unsigned char* ab_ = lds + (BUF) * SG_BUF + SG_A + (32 * wm + r32) * SG_S + kh * 128 + hi * 16; const LAS unsigned char* bb_ = lds + (BUF) * SG_BUF + SG_B + (64 * wn + r32) * SG_S + kh * 128 + hi * 16; \
        _Pragma("unroll") for (int ks = 0; ks < 4; ++ks) { const bf16x8 a_ = *(const LAS bf16x8*)(ab_ + ks * 32), b0_ = *(const LAS bf16x8*)(bb_ + ks * 32), b1_ = *(const LAS bf16x8*)(bb_ + 32 * SG_S + ks * 32); \
            AL = MFMA32(b0_, a_, AL); AH = MFMA32(b1_, a_, AH); } } while (0)
template <class Epi> __device__ __forceinline__ void sgemm_unit(LAS unsigned char* lds, const bf16* A, const bf16* Bt, int K, int unit, const Epi& E) {
    int tid = threadIdx.x; asm volatile("" : "+v"(tid));
    const int lane = tid & 63, wave = __builtin_amdgcn_readfirstlane(tid >> 6), r32 = lane & 31, hi = lane >> 5, kh = wave >> 2, wm = (wave >> 1) & 1, wn = wave & 1, mt = unit >> 3, nt = unit & 7, lr = tid >> 3, lc = tid & 7;
    const GAS u32x4* pa = (const GAS u32x4*)(A + (size_t)(64 * mt + lr) * K) + lc;
    const GAS u32x4* pb0 = (const GAS u32x4*)(Bt + (size_t)(128 * nt + lr) * K) + lc;
    const GAS u32x4* pb1 = (const GAS u32x4*)(Bt + (size_t)(128 * nt + 64 + lr) * K) + lc;
    const int wo = lr * SG_S + lc * 16;
    u32x4 a0_0, a1_0, b0_0, b1_0, b2_0, b3_0, a0_1, a1_1, b0_1, b1_1, b2_1, b3_1, a0_2, a1_2, b0_2, b1_2, b2_2, b3_2, a0_3, a1_3, b0_3, b1_3, b2_3, b3_3;
    const int nk = K / 128;
#define SG_LOAD(S, T) do { a0_##S = pa[16 * (T)]; a1_##S = pa[16 * (T) + 8]; b0_##S = pb0[16 * (T)]; b1_##S = pb0[16 * (T) + 8]; b2_##S = pb1[16 * (T)]; b3_##S = pb1[16 * (T) + 8]; } while (0)
#define SG_STEP(I, SL, SW) do { if (kt + (I) + 3 < nk) SG_LOAD(SL, kt + (I) + 3); SG_COMPUTE((I) & 1, accL, accH); if (kt + (I) + 1 < nk) SG_WRITE(SW, ((I) + 1) & 1); WG_BAR(); } while (0)
    SG_LOAD(0, 0); SG_LOAD(1, 1); if (2 < nk) SG_LOAD(2, 2);
    SG_WRITE(0, 0);
    WG_BAR();
    f32x16 accL, accH;
#pragma unroll
    for (int r = 0; r < 16; ++r) { accL[r] = 0.f; accH[r] = 0.f; }
    for (int kt = 0; kt < nk; kt += 4) {
        SG_STEP(0, 3, 1);
        if (kt + 1 < nk) SG_STEP(1, 0, 2);
        if (kt + 2 < nk) SG_STEP(2, 1, 3);
        if (kt + 3 < nk) SG_STEP(3, 2, 0);
    }
#undef SG_STEP
#undef SG_LOAD
    { LAS f32x4* xs = (LAS f32x4*)(lds + wave * 4096) + lane;
#pragma unroll
      for (int g = 0; g < 4; ++g) xs[64 * g] = kh ? (f32x4){accL[4 * g], accL[4 * g + 1], accL[4 * g + 2], accL[4 * g + 3]} : (f32x4){accH[4 * g], accH[4 * g + 1], accH[4 * g + 2], accH[4 * g + 3]}; }
    WG_BAR();
    const LAS f32x4* xr = (const LAS f32x4*)(lds + (wave ^ 4) * 4096) + lane;
    const int row = 64 * mt + 32 * wm + r32, col0 = 128 * nt + 64 * wn + 32 * kh + 4 * hi;
#pragma unroll
    for (int g = 0; g < 4; ++g) { const f32x4 own = kh ? (f32x4){accH[4 * g], accH[4 * g + 1], accH[4 * g + 2], accH[4 * g + 3]} : (f32x4){accL[4 * g], accL[4 * g + 1], accL[4 * g + 2], accL[4 * g + 3]};
        E.apply(row, col0 + 8 * g, own + xr[64 * g]); }
}

template <class Epi> __device__ __forceinline__ void sgemm_unit2(LAS unsigned char* lds, const bf16* A0, const bf16* Bt0, const bf16* A1, const bf16* Bt1, int unit, const Epi& E) {
    int tid = threadIdx.x; asm volatile("" : "+v"(tid));
    const int lane = tid & 63, wave = __builtin_amdgcn_readfirstlane(tid >> 6), r32 = lane & 31, hi = lane >> 5, kh = wave >> 2, wm = (wave >> 1) & 1, wn = wave & 1, mt = unit >> 3, nt = unit & 7, lr = tid >> 3, lc = tid & 7;
    constexpr int K = 1024, nk1 = 8, nk = 16;
    const unsigned oa = (unsigned)(64 * mt + lr) * K + 8u * lc, ob0 = (unsigned)(128 * nt + lr) * K + 8u * lc, ob1 = ob0 + 64u * K;
    const int wo = lr * SG_S + lc * 16;
    u32x4 a0_0, a1_0, b0_0, b1_0, b2_0, b3_0, a0_1, a1_1, b0_1, b1_1, b2_1, b3_1, a0_2, a1_2, b0_2, b1_2, b2_2, b3_2, a0_3, a1_3, b0_3, b1_3, b2_3, b3_3;
#define SG_LOAD(S, T) do { const int t_ = (T); const bf16* A_ = t_ < nk1 ? A0 : A1; const bf16* B_ = t_ < nk1 ? Bt0 : Bt1; const unsigned ko_ = 128u * (unsigned)(t_ & (nk1 - 1)); \
        const GAS u32x4* pa_ = (const GAS u32x4*)(A_ + (oa + ko_)); const GAS u32x4* pb0_ = (const GAS u32x4*)(B_ + (ob0 + ko_)); const GAS u32x4* pb1_ = (const GAS u32x4*)(B_ + (ob1 + ko_)); \
        a0_##S = pa_[0]; a1_##S = pa_[8]; b0_##S = pb0_[0]; b1_##S = pb0_[8]; b2_##S = pb1_[0]; b3_##S = pb1_[8]; } while (0)
#define SG_STEP(I, SL, SW, AL, AH) do { if (kt + (I) + 3 < nk) SG_LOAD(SL, kt + (I) + 3); SG_COMPUTE((I) & 1, AL, AH); if (kt + (I) + 1 < nk) SG_WRITE(SW, ((I) + 1) & 1); WG_BAR(); } while (0)
    SG_LOAD(0, 0); SG_LOAD(1, 1); SG_LOAD(2, 2);
    SG_WRITE(0, 0);
    WG_BAR();
    f32x16 p0L, p0H, p1L, p1H;
#pragma unroll
    for (int r = 0; r < 16; ++r) { p0L[r] = 0.f; p0H[r] = 0.f; p1L[r] = 0.f; p1H[r] = 0.f; }
#pragma unroll 1
    for (int kt = 0; kt < nk1; kt += 4) { SG_STEP(0, 3, 1, p0L, p0H); SG_STEP(1, 0, 2, p0L, p0H); SG_STEP(2, 1, 3, p0L, p0H); SG_STEP(3, 2, 0, p0L, p0H); }
#pragma unroll 1
    for (int kt = nk1; kt < nk; kt += 4) { SG_STEP(0, 3, 1, p1L, p1H); SG_STEP(1, 0, 2, p1L, p1H); SG_STEP(2, 1, 3, p1L, p1H); SG_STEP(3, 2, 0, p1L, p1H); }
#undef SG_STEP
#undef SG_LOAD
    { LAS f32x4* xs = (LAS f32x4*)(lds + wave * 8192) + lane;
#pragma unroll
      for (int g = 0; g < 4; ++g) { xs[64 * g] = kh ? (f32x4){p0L[4 * g], p0L[4 * g + 1], p0L[4 * g + 2], p0L[4 * g + 3]} : (f32x4){p0H[4 * g], p0H[4 * g + 1], p0H[4 * g + 2], p0H[4 * g + 3]};
                                    xs[256 + 64 * g] = kh ? (f32x4){p1L[4 * g], p1L[4 * g + 1], p1L[4 * g + 2], p1L[4 * g + 3]} : (f32x4){p1H[4 * g], p1H[4 * g + 1], p1H[4 * g + 2], p1H[4 * g + 3]}; } }
    WG_BAR();
    const LAS f32x4* xr = (const LAS f32x4*)(lds + (wave ^ 4) * 8192) + lane;
    const int row = 64 * mt + 32 * wm + r32, col0 = 128 * nt + 64 * wn + 32 * kh + 4 * hi;
#pragma unroll
    for (int g = 0; g < 4; ++g) { const f32x4 o0 = kh ? (f32x4){p0H[4 * g], p0H[4 * g + 1], p0H[4 * g + 2], p0H[4 * g + 3]} : (f32x4){p0L[4 * g], p0L[4 * g + 1], p0L[4 * g + 2], p0L[4 * g + 3]};
        const f32x4 o1 = kh ? (f32x4){p1H[4 * g], p1H[4 * g + 1], p1H[4 * g + 2], p1H[4 * g + 3]} : (f32x4){p1L[4 * g], p1L[4 * g + 1], p1L[4 * g + 2], p1L[4 * g + 3]};
        E.apply2(row, col0 + 8 * g, o0 + xr[64 * g], o1 + xr[256 + 64 * g]); }
}
#undef SG_WRITE
#undef SG_COMPUTE
__device__ __forceinline__ void ln_load_row(f32x4 (&v)[4], const bf16* Rrow, int lane) {
#pragma unroll
    for (int j2 = 0; j2 < 2; ++j2) { const u32x4 w = ((const GAS u32x4*)Rrow)[64 * j2 + lane];
        v[2 * j2] = (f32x4){bf_lo(w.x), bf_hi(w.x), bf_lo(w.y), bf_hi(w.y)}; v[2 * j2 + 1] = (f32x4){bf_lo(w.z), bf_hi(w.z), bf_lo(w.w), bf_hi(w.w)}; }
}
__device__ __forceinline__ void ln_store_row_bf16(const f32x4 (&v)[4], bf16* Orow, int lane) {
#pragma unroll
    for (int j2 = 0; j2 < 2; ++j2) ((GAS u32x4*)Orow)[64 * j2 + lane] = (u32x4){cvtpk(v[2 * j2].x, v[2 * j2].y), cvtpk(v[2 * j2].z, v[2 * j2].w), cvtpk(v[2 * j2 + 1].x, v[2 * j2 + 1].y), cvtpk(v[2 * j2 + 1].z, v[2 * j2 + 1].w)};
}
constexpr int LW_S = 2064;
__device__ __forceinline__ void ln1_phase(LAS unsigned char* lds, const bf16* R, bf16* HB, float* GLR, const float* g_ln, const float* b_ln, const float* w_in, int vcu, int G, int tid, int lane, int wave) {
    asm volatile("" : "+v"(tid)); lane = tid & 63;
    LAS unsigned char* WH = lds; LAS unsigned char* WL = lds + 16 * LW_S; LAS float* GAM = (LAS float*)(lds + 32 * LW_S); LAS float* BET = GAM + 1024;
    for (int e = tid; e < 16384; e += 512) { const int k = e >> 4, i = e & 15; const float w = w_in[(size_t)k * 8208 + 3072 + i]; const unsigned hb = cvtpk(w, 0.f) & 0xffffu;
        *(LAS unsigned short*)(WH + i * LW_S + k * 2) = (unsigned short)hb; *(LAS unsigned short*)(WL + i * LW_S + k * 2) = (unsigned short)(cvtpk(w - __uint_as_float(hb << 16), 0.f) & 0xffffu); }
    for (int e = tid; e < 1024; e += 512) { GAM[e] = g_ln[e]; BET[e] = b_ln[e]; }
    LDS_WAIT(); __syncthreads();
    const int r = lane & 15, g = lane >> 4;
    for (int bt = vcu + G * wave; bt < MT / 16; bt += G * NWAVES) {
        const int m0 = bt * 16;
        const GAS u32x4* rp = (const GAS u32x4*)(R + (size_t)(m0 + r) * DM + 8 * g);
        float sum = 0.f, sq = 0.f;
#pragma unroll 8
        for (int s = 0; s < 32; ++s) { const u32x4 w = rp[4 * s];
#pragma unroll
            for (int j = 0; j < 4; ++j) { const float a = bf_lo(w[j]), c = bf_hi(w[j]); sum += a + c; sq += a * a + c * c; } }
        sum += __shfl_xor(sum, 16); sq += __shfl_xor(sq, 16); sum += __shfl_xor(sum, 32); sq += __shfl_xor(sq, 32);
        const float mean = sum * (1.f / DM), rstd = 1.f / sqrtf(fmaxf(sq * (1.f / DM) - mean * mean, 0.f) + LN_EPS);
        f32x4 acc = {0.f, 0.f, 0.f, 0.f};
        GAS u32x4* hp = (GAS u32x4*)(HB + (size_t)(m0 + r) * DM + 8 * g);
#pragma unroll 4
        for (int s = 0; s < 32; ++s) { const u32x4 w = rp[4 * s]; const int c0 = 32 * s + 8 * g;
            const f32x4 ga = *(const LAS f32x4*)(GAM + c0), gb = *(const LAS f32x4*)(GAM + c0 + 4), ba = *(const LAS f32x4*)(BET + c0), bb = *(const LAS f32x4*)(BET + c0 + 4);
            u32x4 hw;
            hw[0] = cvtpk((bf_lo(w[0]) - mean) * rstd * ga[0] + ba[0], (bf_hi(w[0]) - mean) * rstd * ga[1] + ba[1]);
            hw[1] = cvtpk((bf_lo(w[1]) - mean) * rstd * ga[2] + ba[2], (bf_hi(w[1]) - mean) * rstd * ga[3] + ba[3]);
            hw[2] = cvtpk((bf_lo(w[2]) - mean) * rstd * gb[0] + bb[0], (bf_hi(w[2]) - mean) * rstd * gb[1] + bb[1]);
            hw[3] = cvtpk((bf_lo(w[3]) - mean) * rstd * gb[2] + bb[2], (bf_hi(w[3]) - mean) * rstd * gb[3] + bb[3]);
            hp[4 * s] = hw;
            const bf16x8 af = __builtin_bit_cast(bf16x8, hw);
            const bf16x8 bh = *(const LAS bf16x8*)(WH + r * LW_S + c0 * 2), bl = *(const LAS bf16x8*)(WL + r * LW_S + c0 * 2);
            acc = __builtin_amdgcn_mfma_f32_16x16x32_bf16(af, bh, acc, 0, 0, 0); acc = __builtin_amdgcn_mfma_f32_16x16x32_bf16(af, bl, acc, 0, 0, 0); }
#pragma unroll
        for (int q = 0; q < 4; ++q) GLR[(size_t)(m0 + 4 * g + q) * 16 + r] = acc[q];
    }
}
template <int FINAL> __device__ __forceinline__ void ln_phase(const bf16* R, float* Y, bf16* HB, const float* g_ln, const float* b_ln, int gw, int NGW, int lane) {
    { int t_ = threadIdx.x; asm volatile("" : "+v"(t_)); lane = t_ & 63; }
    f32x4 g[4], b[4];
#pragma unroll
    for (int j = 0; j < 4; ++j) { g[j] = ((const GAS f32x4*)g_ln)[128 * (j >> 1) + 2 * lane + (j & 1)]; b[j] = ((const GAS f32x4*)b_ln)[128 * (j >> 1) + 2 * lane + (j & 1)]; }
    f32x4 v[4];
    int row = gw;
    if (row < MT) ln_load_row(v, R + (size_t)row * DM, lane);
    for (; row < MT; row += NGW) {
        f32x4 nv[4]; const int nrow = row + NGW;
        if (nrow < MT) ln_load_row(nv, R + (size_t)nrow * DM, lane);
        ln_row(v, g, b);
        if (FINAL) {
#pragma unroll
            for (int j = 0; j < 4; ++j) ((GAS f32x4*)(Y + (size_t)row * DM))[128 * (j >> 1) + 2 * lane + (j & 1)] = v[j]; }
        else ln_store_row_bf16(v, HB + (size_t)row * DM, lane);
#pragma unroll
        for (int j = 0; j < 4; ++j) v[j] = nv[j];
    }
}
constexpr int QT_OFF = 0, QT_S = 272, KT_OFF = 17408, KT_S = 272, PT_OFF = KT_OFF, PT_S = 144, RED_OFF = KT_OFF + 9216, KD_OFF = 34816, KD_S = 320, VT_OFF = 55296, VT_S = 576, LB_OFF = 92160, LB_S = 528, WU_OFF = 125952;
static_assert(WU_OFF + 8192 <= MISC_OFF, "GLA LDS map");
typedef short v4i16_t __attribute__((ext_vector_type(4)));
__device__ __forceinline__ bf16x8 frag_row(const LAS unsigned char* base, int S, int row, int kcol) { return *(const LAS bf16x8*)(base + row * S + kcol * 2); }
__device__ __forceinline__ s16x4 tr4(const LAS unsigned char* p) { return __builtin_bit_cast(s16x4, __builtin_amdgcn_ds_read_tr16_b64_v4i16((LAS v4i16_t*)p)); }
__device__ __forceinline__ bf16x8 frag_tr(const LAS unsigned char* base, int S, int k0, int c0, int lane) {
    const int hi = lane >> 5, blk = (lane >> 4) & 1, q = (lane & 15) >> 2, p = lane & 3;
    const LAS unsigned char* a = base + (k0 + 8 * hi + q) * S + (c0 + 16 * blk + 4 * p) * 2;
    const s16x4 lo = tr4(a), h4 = tr4(a + 4 * S);
    return (bf16x8){lo[0], lo[1], lo[2], lo[3], h4[0], h4[1], h4[2], h4[3]};
}
struct GlaIn { f32x4 glr[4]; u32x4 q0, q1, k0, k1, v[4]; };
template <bool WITH_Q> __device__ __forceinline__ void gla_load(GlaIn& x, const bf16* GQ, const bf16* GK, const bf16* GV, const float* GLR, int m0, int h, int tid) {
    const int row = tid >> 3, cs = tid & 7; const unsigned go = (unsigned)(m0 + row) * 512u + (unsigned)(h * 128 + 16 * cs);
    { const int l_ = tid & 63;
#pragma unroll
      for (int i = 0; i < 4; ++i) x.glr[i] = *(const GAS f32x4*)(GLR + ((unsigned)(m0 + 32 * (i >> 1) + (l_ & 31)) * 16u + (unsigned)(8 * (l_ >> 5) + 4 * (i & 1)))); }
    const GAS u32x4* kp = (const GAS u32x4*)(GK + go); x.k0 = kp[0]; x.k1 = kp[1];
    if (WITH_Q) { const GAS u32x4* qp = (const GAS u32x4*)(GQ + go); x.q0 = qp[0]; x.q1 = qp[1]; }
    const GAS u32x4* vp = (const GAS u32x4*)(GV + ((unsigned)(m0 + row) * 1024u + (unsigned)(h * 256 + 32 * cs)));
#pragma unroll
    for (int i = 0; i < 4; ++i) x.v[i] = vp[i];
}
struct GlaGate { bf16x8 whi, wlo; float bias; };
__device__ __forceinline__ void gla_gate_init(GlaGate& gt, const float* w_up, const float* b_gate, int h, int lane, int wave) {
    const int col = h * 128 + 32 * (wave >> 1) + (lane & 31), k0 = 8 * (lane >> 5); float w[8], l[8];
#pragma unroll
    for (int j = 0; j < 8; ++j) { w[j] = ((const GAS float*)w_up)[(k0 + j) * 512 + col]; const unsigned hb = cvtpk(w[j], 0.f) & 0xffffu; l[j] = w[j] - __uint_as_float(hb << 16); }
    gt.whi = __builtin_bit_cast(bf16x8, ((u32x4){cvtpk(w[0], w[1]), cvtpk(w[2], w[3]), cvtpk(w[4], w[5]), cvtpk(w[6], w[7])}));
    gt.wlo = __builtin_bit_cast(bf16x8, ((u32x4){cvtpk(l[0], l[1]), cvtpk(l[2], l[3]), cvtpk(l[4], l[5]), cvtpk(l[6], l[7])}));
    gt.bias = ((const GAS float*)b_gate)[col];
}
__device__ __forceinline__ void gla_lb_tile(LAS unsigned char* lds, const GlaIn& x, const GlaGate& gt, int lane, int wave) {
    const int r32 = lane & 31, hi = lane >> 5, tbw = wave & 1, cb = wave >> 1;
    float base = 0.f;
#pragma unroll
    for (int tbb = 0; tbb < 2; ++tbb) {
        const f32x4 g0 = x.glr[2 * tbb], g1 = x.glr[2 * tbb + 1]; const float gv[8] = {g0.x, g0.y, g0.z, g0.w, g1.x, g1.y, g1.z, g1.w}; float gl[8];
#pragma unroll
        for (int j = 0; j < 8; ++j) { const unsigned hb = cvtpk(gv[j], 0.f) & 0xffffu; gl[j] = gv[j] - __uint_as_float(hb << 16); }
        const bf16x8 ahi = __builtin_bit_cast(bf16x8, ((u32x4){cvtpk(gv[0], gv[1]), cvtpk(gv[2], gv[3]), cvtpk(gv[4], gv[5]), cvtpk(gv[6], gv[7])}));
        const bf16x8 alo = __builtin_bit_cast(bf16x8, ((u32x4){cvtpk(gl[0], gl[1]), cvtpk(gl[2], gl[3]), cvtpk(gl[4], gl[5]), cvtpk(gl[6], gl[7])}));
        f32x16 z;
#pragma unroll
        for (int r = 0; r < 16; ++r) z[r] = gt.bias;
        z = MFMA32(ahi, gt.whi, z); z = MFMA32(alo, gt.whi, z); z = MFMA32(ahi, gt.wlo, z);
        float run = 0.f;
#pragma unroll
        for (int rho = 0; rho < 4; ++rho) { float p[4];
#pragma unroll
            for (int j = 0; j < 4; ++j) { const float y = z[4 * rho + j] * LOG2E, t = fabsf(y); p[j] = -0.0625f * (__builtin_amdgcn_logf(1.0f + __builtin_amdgcn_exp2f(-t)) + fmaxf(-y, 0.f)); }
            p[1] += p[0]; p[2] += p[1]; p[3] += p[2];
            const auto rr = __builtin_amdgcn_permlane32_swap(__float_as_uint(p[3]), __float_as_uint(p[3]), false, false);
            const float tlo = __uint_as_float(rr[0]), thi = __uint_as_float(rr[1]);
            const float off = base + run + (hi ? tlo : 0.f);
            if (tbb == tbw) {
#pragma unroll
                for (int j = 0; j < 4; ++j) *(LAS float*)(lds + LB_OFF + (32 * tbb + 8 * rho + 4 * hi + j) * LB_S + (32 * cb + r32) * 4) = off + p[j]; }
            run += tlo + thi; }
        base += run;
    }
    WG_BAR();
}
template <bool WITH_QK> __device__ __forceinline__ void gla_stage(LAS unsigned char* lds, const GlaIn& x, int tid, bool need_kd = true) {
    const int row = tid >> 3, cs = tid & 7;
    { LAS u32x4* dst = (LAS u32x4*)(lds + VT_OFF + row * VT_S + 64 * cs);
#pragma unroll
      for (int i = 0; i < 4; ++i) dst[i] = x.v[i]; }
    const unsigned kw[8] = {x.k0[0], x.k0[1], x.k0[2], x.k0[3], x.k1[0], x.k1[1], x.k1[2], x.k1[3]};
    float bb[16], bl[16];
#pragma unroll
    for (int q = 0; q < 4; ++q) { const f32x4 t = *(const LAS f32x4*)(lds + LB_OFF + row * LB_S + (16 * cs + 4 * q) * 4), u = *(const LAS f32x4*)(lds + LB_OFF + 63 * LB_S + (16 * cs + 4 * q) * 4);
        bb[4 * q] = t.x; bb[4 * q + 1] = t.y; bb[4 * q + 2] = t.z; bb[4 * q + 3] = t.w; bl[4 * q] = u.x; bl[4 * q + 1] = u.y; bl[4 * q + 2] = u.z; bl[4 * q + 3] = u.w; }
    if (need_kd) {
        unsigned okd[8];
#pragma unroll
        for (int i = 0; i < 8; ++i) okd[i] = cvtpk(bf_lo(kw[i]) * __builtin_amdgcn_exp2f(bl[2 * i] - bb[2 * i]), bf_hi(kw[i]) * __builtin_amdgcn_exp2f(bl[2 * i + 1] - bb[2 * i + 1]));
        LAS u32x4* d = (LAS u32x4*)(lds + KD_OFF + row * KD_S + 32 * cs); d[0] = (u32x4){okd[0], okd[1], okd[2], okd[3]}; d[1] = (u32x4){okd[4], okd[5], okd[6], okd[7]}; }
    if (WITH_QK) {
        const unsigned qw[8] = {x.q0[0], x.q0[1], x.q0[2], x.q0[3], x.q1[0], x.q1[1], x.q1[2], x.q1[3]};
        unsigned oq[8], ok[8];
#pragma unroll
        for (int i = 0; i < 8; ++i) { const float e0 = __builtin_amdgcn_exp2f(bb[2 * i]), e1 = __builtin_amdgcn_exp2f(bb[2 * i + 1]), f0 = __builtin_amdgcn_exp2f(-bb[2 * i]), f1 = __builtin_amdgcn_exp2f(-bb[2 * i + 1]);
            oq[i] = cvtpk(bf_lo(qw[i]) * e0, bf_hi(qw[i]) * e1); ok[i] = cvtpk(bf_lo(kw[i]) * f0, bf_hi(kw[i]) * f1); }
        LAS u32x4* dq = (LAS u32x4*)(lds + QT_OFF + row * QT_S + 32 * cs); LAS u32x4* dk = (LAS u32x4*)(lds + KT_OFF + row * KT_S + 32 * cs);
        dq[0] = (u32x4){oq[0], oq[1], oq[2], oq[3]}; dq[1] = (u32x4){oq[4], oq[5], oq[6], oq[7]};
        dk[0] = (u32x4){ok[0], ok[1], ok[2], ok[3]}; dk[1] = (u32x4){ok[4], ok[5], ok[6], ok[7]};
    }
}
__device__ __forceinline__ void gla_update(f32x16 (&acc)[4], const LAS unsigned char* lds, int lane, int wave) {
    const int hi = lane >> 5;
#pragma unroll
    for (int ib = 0; ib < 4; ++ib)
#pragma unroll
        for (int g = 0; g < 4; ++g) { const f32x4 bl = *(const LAS f32x4*)(lds + LB_OFF + 63 * LB_S + (32 * ib + 8 * g + 4 * hi) * 4);
#pragma unroll
            for (int j = 0; j < 4; ++j) acc[ib][4 * g + j] *= __builtin_amdgcn_exp2f(bl[j]); }
#pragma unroll 1
    for (int ks = 0; ks < 4; ++ks) { const bf16x8 b = frag_tr(lds + VT_OFF, VT_S, 16 * ks, 32 * wave, lane);
#pragma unroll
        for (int ib = 0; ib < 4; ++ib) { const bf16x8 a = frag_tr(lds + KD_OFF, KD_S, 16 * ks, 32 * ib, lane); acc[ib] = MFMA32(a, b, acc[ib]); } }
}
__device__ __forceinline__ void gla_unit_a(LAS unsigned char* lds, int m0, int h, int nch, const bf16* GK, const bf16* GV, const float* GLR, const float* w_up, const float* b_gate,
                                           const float* S0, float* dst, float* lsum, int tid, int lane, int wave) {
    asm volatile("" : "+v"(tid)); lane = tid & 63; wave = __builtin_amdgcn_readfirstlane(tid >> 6);
    const int r32 = lane & 31, hi = lane >> 5;
    f32x16 acc[4];
#pragma unroll
    for (int ib = 0; ib < 4; ++ib)
#pragma unroll
        for (int r = 0; r < 16; ++r) acc[ib][r] = S0 ? ((const GAS float*)S0)[(32 * ib + crow(r, hi)) * 256 + 32 * wave + r32] : 0.f;
    float ls = 0.f;
    GlaGate gt; gla_gate_init(gt, w_up, b_gate, h, lane, wave);
    GlaIn x; gla_load<false>(x, nullptr, GK, GV, GLR, m0, h, tid);
    WG_BAR();
    for (int c = 0; c < nch; ++c) {
        asm volatile("" : "+v"(tid)); lane = tid & 63;
        gla_lb_tile(lds, x, gt, lane, wave);
#ifdef PROBE_LB2
        gla_lb_tile(lds, x, gt, lane, wave);
#endif
#ifdef PROBE_ST2
        gla_stage<false>(lds, x, tid); WG_BAR();
#endif
        gla_stage<false>(lds, x, tid);
        if (c + 1 < nch) gla_load<false>(x, nullptr, GK, GV, GLR, m0 + 64 * (c + 1), h, tid);
        if (tid < 128) ls += *((const LAS float*)(lds + LB_OFF + 63 * LB_S) + tid);
        WG_BAR();
        gla_update(acc, lds, lane, wave);
        WG_BAR();
    }
#pragma unroll
    for (int ib = 0; ib < 4; ++ib)
#pragma unroll
        for (int r = 0; r < 16; ++r) ((GAS float*)dst)[(32 * ib + crow(r, hi)) * 256 + 32 * wave + r32] = acc[ib][r];
    if (lsum && tid < 128) lsum[tid] = ls;
}
__device__ __forceinline__ void gla_unit_c(LAS unsigned char* lds, int m0, int h, int nch, const bf16* GQ, const bf16* GK, const bf16* GV, const bf16* GR, const float* GLR, const float* w_up, const float* b_gate,
                                           const float* Sin, const float* gnorm, bf16* OA, int tid, int lane, int wave) {
    asm volatile("" : "+v"(tid)); lane = tid & 63; wave = __builtin_amdgcn_readfirstlane(tid >> 6);
    const int r32 = lane & 31, hi = lane >> 5;
    f32x16 acc[4];
#pragma unroll
    for (int ib = 0; ib < 4; ++ib)
#pragma unroll
        for (int r = 0; r < 16; ++r) acc[ib][r] = ((const GAS float*)Sin)[(32 * ib + crow(r, hi)) * 256 + 32 * wave + r32];
    GlaGate gt; gla_gate_init(gt, w_up, b_gate, h, lane, wave);
    if (tid < 64) *(LAS f32x4*)(lds + WU_OFF + tid * 16) = ((const GAS f32x4*)(gnorm + h * 256))[tid];
    GlaIn x; gla_load<true>(x, GQ, GK, GV, GLR, m0, h, tid);
    WG_BAR();
    for (int c = 0; c < nch; ++c) { const int mc = m0 + 64 * c;
        TSTAMP(30, lds, tid);
        asm volatile("" : "+v"(tid)); lane = tid & 63;
        gla_lb_tile(lds, x, gt, lane, wave);
#ifdef PROBE_LB2
        gla_lb_tile(lds, x, gt, lane, wave);
#endif
#ifdef PROBE_ST2
        gla_stage<true>(lds, x, tid); WG_BAR();
#endif
        TSTAMP(31, lds, tid);
        gla_stage<true>(lds, x, tid);
        WG_BAR();
        TSTAMP(32, lds, tid);
        const int tb = wave & 1, sb = wave >> 1; const bool do_att = (wave < 4) && (sb <= tb);
        f32x16 att;
#pragma unroll
        for (int r = 0; r < 16; ++r) att[r] = 0.f;
        if (do_att) {
#pragma unroll 2
            for (int ks = 0; ks < 8; ++ks) { const bf16x8 a = frag_row(lds + QT_OFF, QT_S, 32 * tb + r32, 16 * ks + 8 * hi), b = frag_row(lds + KT_OFF, KT_S, 32 * sb + r32, 16 * ks + 8 * hi); att = MFMA32(a, b, att); } }
        WG_BAR();
        if (do_att) {
#pragma unroll
            for (int r = 0; r < 16; ++r) { const int t = 32 * tb + crow(r, hi), s = 32 * sb + r32; const float val = (s <= t) ? att[r] : 0.f;
                *(LAS unsigned short*)(lds + PT_OFF + t * PT_S + s * 2) = (unsigned short)(cvtpk(val, val) & 0xffffu); } }
        WG_BAR();
        TSTAMP(33, lds, tid);
        f32x16 o0, o1;
#pragma unroll
        for (int r = 0; r < 16; ++r) { o0[r] = 0.f; o1[r] = 0.f; }
#pragma unroll
        for (int ks = 0; ks < 4; ++ks) { const bf16x8 b = frag_tr(lds + VT_OFF, VT_S, 16 * ks, 32 * wave, lane);
            if (ks < 2) { const bf16x8 a0 = frag_row(lds + PT_OFF, PT_S, r32, 16 * ks + 8 * hi); o0 = MFMA32(a0, b, o0); }
            const bf16x8 a1 = frag_row(lds + PT_OFF, PT_S, 32 + r32, 16 * ks + 8 * hi); o1 = MFMA32(a1, b, o1); }
#pragma unroll
        for (int ib = 0; ib < 4; ++ib)
#pragma unroll
            for (int s = 0; s < 2; ++s) {
                const bf16x8 b = __builtin_bit_cast(bf16x8, ((u32x4){cvtpk(acc[ib][8 * s], acc[ib][8 * s + 1]), cvtpk(acc[ib][8 * s + 2], acc[ib][8 * s + 3]), cvtpk(acc[ib][8 * s + 4], acc[ib][8 * s + 5]), cvtpk(acc[ib][8 * s + 6], acc[ib][8 * s + 7])}));
                const int kc = (32 * ib + 16 * s + 4 * hi) * 2;
                const u32x2 a0l = *(const LAS u32x2*)(lds + QT_OFF + r32 * QT_S + kc), a0h = *(const LAS u32x2*)(lds + QT_OFF + r32 * QT_S + kc + 16);
                const u32x2 a1l = *(const LAS u32x2*)(lds + QT_OFF + (32 + r32) * QT_S + kc), a1h = *(const LAS u32x2*)(lds + QT_OFF + (32 + r32) * QT_S + kc + 16);
                o0 = MFMA32(__builtin_bit_cast(bf16x8, ((u32x4){a0l[0], a0l[1], a0h[0], a0h[1]})), b, o0);
                o1 = MFMA32(__builtin_bit_cast(bf16x8, ((u32x4){a1l[0], a1l[1], a1h[0], a1h[1]})), b, o1); }
        TSTAMP(34, lds, tid);
        if (c + 1 < nch) gla_load<true>(x, GQ, GK, GV, GLR, mc + 64, h, tid);
        u32x4 grw[4];
        { const GAS u32x4* gp = (const GAS u32x4*)(GR + ((unsigned)(mc + (tid >> 3)) * 1024u + (unsigned)(h * 256 + 32 * (tid & 7))));
#pragma unroll
          for (int i = 0; i < 4; ++i) grw[i] = gp[i]; }
        if (c + 1 < nch) gla_update(acc, lds, lane, wave);
        WG_BAR();
        TSTAMP(35, lds, tid);
#pragma unroll
        for (int r = 0; r < 16; ++r) { *(LAS unsigned short*)(lds + VT_OFF + crow(r, hi) * 528 + (32 * wave + r32) * 2) = (unsigned short)(cvtpk(o0[r], o0[r]) & 0xffffu);
                                       *(LAS unsigned short*)(lds + VT_OFF + (32 + crow(r, hi)) * 528 + (32 * wave + r32) * 2) = (unsigned short)(cvtpk(o1[r], o1[r]) & 0xffffu); }
        WG_BAR();
        TSTAMP(36, lds, tid);
        { const int row = tid >> 3, cs = tid & 7; u32x4 ow[4]; float ss = 0.f;
#pragma unroll
          for (int i = 0; i < 4; ++i) { ow[i] = *(const LAS u32x4*)(lds + VT_OFF + row * 528 + 64 * cs + 16 * i);
#pragma unroll
              for (int j = 0; j < 4; ++j) { const float lo = bf_lo(ow[i][j]), hi2 = bf_hi(ow[i][j]); ss += lo * lo + hi2 * hi2; } }
          ss += __shfl_xor(ss, 1); ss += __shfl_xor(ss, 2); ss += __shfl_xor(ss, 4);
          const float rstd = 1.0f / sqrtf(ss * (1.0f / 256.0f) + LN_EPS);
          const LAS f32x4* gp = (const LAS f32x4*)(lds + WU_OFF + 128 * cs); GAS u32x4* op = (GAS u32x4*)(OA + ((unsigned)(mc + row) * 1024u + (unsigned)(h * 256 + 32 * cs)));
#pragma unroll
          for (int i = 0; i < 4; ++i) { const f32x4 g0 = gp[2 * i], g1 = gp[2 * i + 1]; u32x4 w;
              w[0] = cvtpk(bf_lo(ow[i][0]) * rstd * g0[0] * bf_lo(grw[i][0]), bf_hi(ow[i][0]) * rstd * g0[1] * bf_hi(grw[i][0]));
              w[1] = cvtpk(bf_lo(ow[i][1]) * rstd * g0[2] * bf_lo(grw[i][1]), bf_hi(ow[i][1]) * rstd * g0[3] * bf_hi(grw[i][1]));
              w[2] = cvtpk(bf_lo(ow[i][2]) * rstd * g1[0] * bf_lo(grw[i][2]), bf_hi(ow[i][2]) * rstd * g1[1] * bf_hi(grw[i][2]));
              w[3] = cvtpk(bf_lo(ow[i][3]) * rstd * g1[2] * bf_lo(grw[i][3]), bf_hi(ow[i][3]) * rstd * g1[3] * bf_hi(grw[i][3]));
              op[i] = w; } }
        TSTAMP(37, lds, tid);
    }
}
__device__ __forceinline__ void gla_scan_phase(const float* DSS, float* SIN, const float* LSUM, float* out_state, int vcu, int G, int tid) {
    for (int item = vcu * 512 + tid; item < 131072; item += G * 512) {
        const int bh = item >> 14, e2 = item & 16383, dk = e2 >> 7, dv = (e2 & 127) * 2;
        const size_t eo = (size_t)dk * 256 + dv;
        float s0 = 0.f, s1 = 0.f;
        f32x2v dd[32]; float lg[32];
#pragma unroll
        for (int sc = 0; sc < 32; ++sc) { dd[sc] = *(const GAS f32x2v*)(DSS + (size_t)(bh * 32 + sc) * 32768 + eo); lg[sc] = ((const GAS float*)LSUM)[(bh * 32 + sc) * 128 + dk]; }
#pragma unroll
        for (int sc = 0; sc < 32; ++sc) { *(GAS f32x2v*)(SIN + (size_t)(bh * 32 + sc) * 32768 + eo) = (f32x2v){s0, s1};
            const float dec = __builtin_amdgcn_exp2f(lg[sc]); s0 = dec * s0 + dd[sc].x; s1 = dec * s1 + dd[sc].y; }
        *(f32x2v*)(out_state + (size_t)bh * 32768 + eo) = (f32x2v){s0, s1};
    }
}
constexpr int SB_V_OFF = 0, SB_K_OFF = 32768, SB_FLAG_OFF = 65536, SB_Q_OFF = 66560, SB_TILE = 16384;
constexpr float SB_DONE_THR = -140.0f;
#define KSWZ(row, colB) ((row) * 256 + ((colB) ^ (((row) & 7) << 4)))
#define SBAR() __builtin_amdgcn_sched_barrier(0)
__device__ __forceinline__ int v_st(int k, int c) { const int kk = (k & ~0xC) | ((k & 4) << 1) | ((k & 8) >> 1); return ((kk >> 3) * 4 + (c >> 5)) * 512 + ((kk & 7) * 32 + (c & 31)) * 2; }
__device__ __forceinline__ int v_rd_base(int lane) { return ((lane & 3) << 3) | (((lane >> 2) & 3) << 6) | (((lane >> 4) & 1) << 5) | (((lane >> 5) & 1) << 8); }
constexpr int v_rd_off(int d0, int ks, int half) { return d0 * 512 + ks * 4096 + half * 2048; }
template <int OFF> __device__ __forceinline__ s16x4 tr_read(int vb) { s16x4 r; asm volatile("ds_read_b64_tr_b16 %0, %1 offset:%2" : "=&v"(r) : "v"(vb), "i"(OFF) : "memory"); return r; }
template <int D0> __device__ __forceinline__ void pv_one(f32x16& od, int vb, bf16x8 pa0, bf16x8 pa1, bf16x8 pa2, bf16x8 pa3) {
    const s16x4 l0 = tr_read<v_rd_off(D0, 0, 0)>(vb), h0 = tr_read<v_rd_off(D0, 0, 1)>(vb), l1 = tr_read<v_rd_off(D0, 1, 0)>(vb), h1 = tr_read<v_rd_off(D0, 1, 1)>(vb);
    const s16x4 l2 = tr_read<v_rd_off(D0, 2, 0)>(vb), h2 = tr_read<v_rd_off(D0, 2, 1)>(vb), l3 = tr_read<v_rd_off(D0, 3, 0)>(vb), h3 = tr_read<v_rd_off(D0, 3, 1)>(vb);
    asm volatile("s_waitcnt lgkmcnt(0)" ::: "memory"); SBAR();
#define PKV(L, H) (bf16x8){L[0], L[1], L[2], L[3], H[0], H[1], H[2], H[3]}
    od = MFMA32(pa0, PKV(l0, h0), od); od = MFMA32(pa1, PKV(l1, h1), od); od = MFMA32(pa2, PKV(l2, h2), od); od = MFMA32(pa3, PKV(l3, h3), od);
#undef PKV
}
__device__ __forceinline__ void sb_qkt(f32x16& p0, f32x16& p1, const LAS unsigned char* Ks, const bf16x8 (&qr)[8], int r32, int hi) {
#pragma unroll
    for (int r = 0; r < 16; ++r) { p0[r] = 0.f; p1[r] = 0.f; }
#pragma unroll
    for (int d0 = 0; d0 < 8; ++d0) { const int cb = (d0 * 16 + hi * 8) * 2;
        const bf16x8 b0 = *(const LAS bf16x8*)(Ks + KSWZ(r32, cb)), b1 = *(const LAS bf16x8*)(Ks + KSWZ(32 + r32, cb));
        p0 = MFMA32(b0, qr[d0], p0); p1 = MFMA32(b1, qr[d0], p1); }
}
struct f4s { float a, b, c, d; };
template <bool MASK> __device__ __forceinline__ f4s sb_group(float x0, float x1, float x2, float x3, float& Hrun, int kb, int qpos, int hi) {
    float l0 = __builtin_amdgcn_logf(1.0f + __builtin_amdgcn_exp2f(-x0)), l1 = __builtin_amdgcn_logf(1.0f + __builtin_amdgcn_exp2f(-x1));
    float l2 = __builtin_amdgcn_logf(1.0f + __builtin_amdgcn_exp2f(-x2)), l3 = __builtin_amdgcn_logf(1.0f + __builtin_amdgcn_exp2f(-x3));
    float k0 = -l0 - x0, k1 = -l1 - x1, k2 = -l2 - x2, k3 = -l3 - x3;
    float b0 = -l0, b1 = -l1, b2 = -l2, b3 = -l3;
    if (MASK) { const bool v0 = kb < qpos, v1 = kb + 1 < qpos, v2 = kb + 2 < qpos, v3 = kb + 3 < qpos;
        k0 = v0 ? k0 : 0.f; k1 = v1 ? k1 : 0.f; k2 = v2 ? k2 : 0.f; k3 = v3 ? k3 : 0.f;
        b0 = v0 ? b0 : -1e30f; b1 = v1 ? b1 : -1e30f; b2 = v2 ? b2 : -1e30f; b3 = v3 ? b3 : -1e30f; }
    const float s2 = k3, s1 = s2 + k2, s0 = s1 + k1, t = s0 + k0;
    const auto rr = __builtin_amdgcn_permlane32_swap(__float_as_uint(t), __float_as_uint(t), false, false);
    const float tlo = __uint_as_float(rr[0]), thi = __uint_as_float(rr[1]);
    const float Hb = Hrun + (hi ? 0.f : thi);
    f4s w; w.a = __builtin_amdgcn_exp2f(b0 + (Hb + s0)); w.b = __builtin_amdgcn_exp2f(b1 + (Hb + s1)); w.c = __builtin_amdgcn_exp2f(b2 + (Hb + s2)); w.d = __builtin_amdgcn_exp2f(b3 + Hb);
    Hrun += tlo + thi; return w;
}
template <bool MASK> __device__ __forceinline__ void sb_tile(f32x16& p0, f32x16& p1, float& R, int kbase, int qpos, int hi) {
    float Hrun = R; const int kb = kbase + 4 * hi;
#define SBG(P, B, KO) do { const f4s w_ = sb_group<MASK>(P[B], P[B + 1], P[B + 2], P[B + 3], Hrun, kb + (KO), qpos, hi); P[B] = w_.a; P[B + 1] = w_.b; P[B + 2] = w_.c; P[B + 3] = w_.d; } while (0)
    SBG(p1, 12, 56); SBG(p1, 8, 48); SBG(p1, 4, 40); SBG(p1, 0, 32); SBG(p0, 12, 24); SBG(p0, 8, 16); SBG(p0, 4, 8); SBG(p0, 0, 0);
#undef SBG
    R = Hrun;
}
template <bool KVF32> __device__ __forceinline__ void sb_unit(LAS unsigned char* lds, const bf16* Q, bf16* O, int nwq, int i0, const bf16* KB, const bf16* VB, const float* KC, const float* VC,
                                                              float* OK, float* OV, int own_lo, int tid, int lane, int wave) {
    asm volatile("" : "+v"(tid)); lane = tid & 63; wave = __builtin_amdgcn_readfirstlane(tid >> 6);
    const int r32 = lane & 31, hi = lane >> 5;
    const int sr = tid >> 4, sc = (tid & 15) * 8, vst0 = v_st(sr, sc), vst1 = v_st(32 + sr, sc), kst0 = KSWZ(sr, sc * 2), kst1 = KSWZ(32 + sr, sc * 2);
    const int vb0 = (int)(uintptr_t)(lds + SB_V_OFF) + v_rd_base(lane);
    volatile LAS unsigned* flags = (volatile LAS unsigned*)(lds + SB_FLAG_OFF);
    const bool compute = wave < nwq;
    bf16x8 qr[8];
#pragma unroll
    for (int d0 = 0; d0 < 8; ++d0) qr[d0] = (bf16x8){0, 0, 0, 0, 0, 0, 0, 0};
    const bf16* Qw = Q + (size_t)((compute ? wave : 0) * 32 + r32) * 1024 + hi * 8;
    LAS unsigned char* qlds = lds + SB_Q_OFF + wave * 8192;
    if (compute) {
#pragma unroll
        for (int d0 = 0; d0 < 8; ++d0) *(LAS bf16x8*)(qlds + KSWZ(r32, (d0 * 16 + hi * 8) * 2)) = *(const GAS bf16x8*)(Qw + d0 * 16); }
    const int qpos = i0 + wave * 32 + r32;
    f32x16 o[4];
#pragma unroll
    for (int d = 0; d < 4; ++d)
#pragma unroll
        for (int r = 0; r < 16; ++r) o[d][r] = 0.f;
    float R = 0.f; bool done = !compute;
    typedef float f32x8 __attribute__((ext_vector_type(8)));
    f32x8 fk0, fk1, fv0, fv1; bf16x8 hk0, hk1, hv0, hv1;
    const int kbase = KVF32 ? 4096 : 0;
#define SB_LOAD_BF(jt) do { const int p0_ = 64 * (jt) + sr - kbase; \
        hk0 = *(const GAS bf16x8*)(KB + (size_t)p0_ * 1024 + sc); hk1 = *(const GAS bf16x8*)(KB + (size_t)(p0_ + 32) * 1024 + sc); hv0 = *(const GAS bf16x8*)(VB + (size_t)p0_ * 1024 + sc); hv1 = *(const GAS bf16x8*)(VB + (size_t)(p0_ + 32) * 1024 + sc); } while (0)
#define SB_LOAD_F32(jt) do { const int p0_ = 64 * (jt) + sr; \
        fk0 = *(const GAS f32x8*)(KC + (size_t)p0_ * 1024 + sc); fk1 = *(const GAS f32x8*)(KC + (size_t)(p0_ + 32) * 1024 + sc); fv0 = *(const GAS f32x8*)(VC + (size_t)p0_ * 1024 + sc); fv1 = *(const GAS f32x8*)(VC + (size_t)(p0_ + 32) * 1024 + sc); } while (0)
#define SB_CVT(x) ((bf16x8)__builtin_bit_cast(bf16x8, ((u32x4){cvtpk(x[0], x[1]), cvtpk(x[2], x[3]), cvtpk(x[4], x[5]), cvtpk(x[6], x[7])})))
#define SB_WRITE_BF(buf) do { LAS unsigned char* vb_ = lds + SB_V_OFF + (buf) * SB_TILE; LAS unsigned char* kb_ = lds + SB_K_OFF + (buf) * SB_TILE; \
        *(LAS bf16x8*)(vb_ + vst0) = hv0; *(LAS bf16x8*)(vb_ + vst1) = hv1; *(LAS bf16x8*)(kb_ + kst0) = hk0; *(LAS bf16x8*)(kb_ + kst1) = hk1; } while (0)
#define SB_WRITE_F32(buf) do { LAS unsigned char* vb_ = lds + SB_V_OFF + (buf) * SB_TILE; LAS unsigned char* kb_ = lds + SB_K_OFF + (buf) * SB_TILE; \
        *(LAS bf16x8*)(vb_ + vst0) = SB_CVT(fv0); *(LAS bf16x8*)(vb_ + vst1) = SB_CVT(fv1); *(LAS bf16x8*)(kb_ + kst0) = SB_CVT(fk0); *(LAS bf16x8*)(kb_ + kst1) = SB_CVT(fk1); } while (0)
#define SB_F4(x, a) ((f32x4){__uint_as_float((unsigned)(unsigned short)x[a] << 16), __uint_as_float((unsigned)(unsigned short)x[a + 1] << 16), __uint_as_float((unsigned)(unsigned short)x[a + 2] << 16), __uint_as_float((unsigned)(unsigned short)x[a + 3] << 16)})
#define SB_STORE_OWN(jt) do { const size_t o0_ = (size_t)(64 * (jt) + sr - own_lo) * 1024 + sc, o1_ = o0_ + 32 * 1024; \
        *(GAS f32x4*)(OK + o0_) = SB_F4(hk0, 0); *(GAS f32x4*)(OK + o0_ + 4) = SB_F4(hk0, 4); *(GAS f32x4*)(OK + o1_) = SB_F4(hk1, 0); *(GAS f32x4*)(OK + o1_ + 4) = SB_F4(hk1, 4); \
        *(GAS f32x4*)(OV + o0_) = SB_F4(hv0, 0); *(GAS f32x4*)(OV + o0_ + 4) = SB_F4(hv0, 4); *(GAS f32x4*)(OV + o1_) = SB_F4(hv1, 0); *(GAS f32x4*)(OV + o1_ + 4) = SB_F4(hv1, 4); } while (0)
    const int jt_top = (i0 + 32 * nwq - 1) >> 6;
    SB_LOAD_BF(jt_top); SB_WRITE_BF(0); SB_STORE_OWN(jt_top);
    WG_BAR();
    for (int jt = jt_top, it = 0;; --jt, ++it) {
        const int buf = it & 1; const bool has_next = jt > 0;
        if (has_next) { if (KVF32) SB_LOAD_F32(jt - 1); else SB_LOAD_BF(jt - 1); }
        const int wrow_lo = i0 + wave * 32;
        if (!done && (64 * jt < wrow_lo + 31)) {
#pragma unroll
            for (int d0 = 0; d0 < 8; ++d0) qr[d0] = *(const LAS bf16x8*)(qlds + KSWZ(r32, (d0 * 16 + hi * 8) * 2));
            f32x16 p0, p1; sb_qkt(p0, p1, lds + SB_K_OFF + buf * SB_TILE, qr, r32, hi);
            if (64 * jt + 64 <= wrow_lo) sb_tile<false>(p0, p1, R, 64 * jt, qpos, hi);
            else sb_tile<true>(p0, p1, R, 64 * jt, qpos, hi);
            bf16x8 pa0, pa1, pa2, pa3;
#define PK4(P, BASE, OUT) do { const unsigned a0 = cvtpk(P[BASE + 0], P[BASE + 1]), a1 = cvtpk(P[BASE + 2], P[BASE + 3]), b0 = cvtpk(P[BASE + 4], P[BASE + 5]), b1 = cvtpk(P[BASE + 6], P[BASE + 7]); \
            const auto r0 = __builtin_amdgcn_permlane32_swap(a0, b0, false, false); const auto r1 = __builtin_amdgcn_permlane32_swap(a1, b1, false, false); \
            OUT = __builtin_bit_cast(bf16x8, ((u32x4){r0[0], r1[0], r0[1], r1[1]})); } while (0)
            PK4(p0, 0, pa0); PK4(p0, 8, pa1); PK4(p1, 0, pa2); PK4(p1, 8, pa3);
#undef PK4
            const int vb = vb0 + buf * SB_TILE;
            pv_one<0>(o[0], vb, pa0, pa1, pa2, pa3); pv_one<1>(o[1], vb, pa0, pa1, pa2, pa3); pv_one<2>(o[2], vb, pa0, pa1, pa2, pa3); pv_one<3>(o[3], vb, pa0, pa1, pa2, pa3);
            done = __all(R <= SB_DONE_THR);
        }
        if (has_next) { if (KVF32) SB_WRITE_F32(buf ^ 1); else { SB_WRITE_BF(buf ^ 1); if (64 * (jt - 1) >= own_lo) SB_STORE_OWN(jt - 1); } }
        if (lane == 0) flags[buf * 8 + wave] = done ? 1u : 0u;
        WG_BAR();
        unsigned nd = 0;
#pragma unroll
        for (int w = 0; w < 8; ++w) nd += flags[buf * 8 + w];
        if ((nd == 8u && (KVF32 || 64 * (jt - 1) < own_lo)) || !has_next) break;
    }
#undef SB_LOAD_BF
#undef SB_LOAD_F32
#undef SB_WRITE_BF
#undef SB_WRITE_F32
#undef SB_CVT
#undef SB_F4
#undef SB_STORE_OWN
    if (compute) {
#pragma unroll
        for (int r = 0; r < 16; ++r) { bf16* orow = O + (size_t)(wave * 32 + crow(r, hi)) * 1024 + r32;
#pragma unroll
            for (int d0 = 0; d0 < 4; ++d0) orow[d0 * 32] = (bf16)(cvtpk(o[d0][r], 0.f) & 0xffffu); }
    }
}
#ifndef PHASE_MASK
#define PHASE_MASK 0xFFFFFFFFu
#endif
#define PH(k) ((PHASE_MASK >> (k)) & 1u)
#ifndef DUP_MASK
#define DUP_MASK 0u
#endif
#define REP(k) for (int rep_ = 0; rep_ < 1 + (int)((DUP_MASK >> (k)) & 1u); ++rep_)
#define STAMP(k) TSTAMP(k, lds, tid)
#ifdef DBL_BAR
#define XBAR() do { xcd_barrier(bar); xcd_barrier(bar); } while (0)
#else
#define XBAR() xcd_barrier(bar)
#endif
struct Args { const float* in[22]; float* out; unsigned char* ws; };
#define GEMM_PHASE(EPI, M_, A_, Bt_, N_, K_, E_) do { pg8::Gemm g_{(const pg8::bf16_t*)(A_), (const pg8::bf16_t*)(Bt_), (M_), (N_), (K_)}; pg8::StaticOrder S_; S_.init((M_), (N_), G, bx); \
        pg8::gemm_phase<EPI, pg8::StaticOrder, true, true>(lds + RING_OFF, g_, S_, (E_)); } while (0)
__global__ void __launch_bounds__(NWAVES * 64, 2) mk_fwd(Args a) {
    extern __shared__ __attribute__((aligned(16))) unsigned char lds_raw[];
    LAS unsigned char* lds = (LAS unsigned char*)lds_raw;
    const int tid = threadIdx.x, lane = tid & 63, wave = __builtin_amdgcn_readfirstlane(tid >> 6);
    const int G = gridDim.x, bx = blockIdx.x, vcu = (G % 8 == 0) ? (bx % 8) * (G / 8) + bx / 8 : bx;
    const int gw = vcu * NWAVES + wave, NGW = G * NWAVES;
#ifndef SF_MASK
#define SF_MASK 1
#endif
    const bool small_first = (vcu & SF_MASK) == SF_MASK && SF_MASK != 0;
    volatile LAS unsigned* MISC = (volatile LAS unsigned*)(lds + MISC_OFF);
    if (tid < 64) MISC[tid] = 0u;
    __syncthreads();
    unsigned char* ws = a.ws; float* out = a.out;
    XcdBarrier bar = xcd_barrier_post((unsigned*)(ws + WS_CTL) + CW_BAR, MISC + 8);
    const float* xp = a.in[0]; const float* xs = a.in[1]; const float* state_gla = a.in[2]; const float* cache_k = a.in[3]; const float* cache_v = a.in[4];
    bf16 *W1IN = (bf16*)(ws + WS_W1IN), *W1OUT = (bf16*)(ws + WS_W1OUT), *WIN = (bf16*)(ws + WS_WIN), *WGLAO = (bf16*)(ws + WS_WGLAO), *WSBO = (bf16*)(ws + WS_WSBO), *WOUT = (bf16*)(ws + WS_WOUT),
         *W2IN = (bf16*)(ws + WS_W2IN), *W2OUT = (bf16*)(ws + WS_W2OUT);
    bf16 *XB = (bf16*)(ws + WS_XB), *HB = (bf16*)(ws + WS_HB), *ACT = (bf16*)(ws + WS_ACT), *GQ = (bf16*)(ws + WS_GQ), *GK = (bf16*)(ws + WS_GK), *GV = (bf16*)(ws + WS_GV), *GR = (bf16*)(ws + WS_GR),
         *SQ = (bf16*)(ws + WS_SQ), *SKB = (bf16*)(ws + WS_SKB2), *SVB = (bf16*)(ws + WS_SVB2), *GA = (bf16*)(ws + WS_GA), *GB = (bf16*)(ws + WS_GB),
         *OA = (bf16*)(ws + WS_OA), *OB = (bf16*)(ws + WS_OB), *MG = (bf16*)(ws + WS_MG), *TB = (bf16*)(ws + WS_R + 40 * MiB);
    bf16* R = (bf16*)(ws + WS_R); float *GLR = (float*)(ws + WS_H), *LSUM = (float*)(ws + WS_B2), *DS = (float*)(ws + WS_DS), *SIN = (float*)(ws + WS_STS);

    STAMP(0);
    if (PH(0)) REP(0) { LAS float* scr = (LAS float*)(lds + wave * 16384); int itbase = 0;
      p0_weight<1>(a.in[5], 2 * DFF, DM, 2 * DFF, W1IN, scr, lane, gw, NGW, itbase);
      for (int m = gw; m < MT; m += NGW) row_to_bf16(m < MP ? xp + (size_t)m * DM : xs + (size_t)(m - MP) * DM, XB + (size_t)m * DM, lane); }
    XBAR(); STAMP(1);
    if (PH(1)) REP(1) { pg8::EpiSwiGLU E{(pg8::bf16_t*)ACT, DFF}; GEMM_PHASE(pg8::EpiSwiGLU, MT, XB, W1IN, 2 * DFF, DM, E);
      { const int nlast = (MT / 256) * (2 * DFF / 256) - 6 * G;
        if (G == 256 && bx >= nlast) { __syncthreads(); LAS float* scr = (LAS float*)(lds + wave * 16384); int itbase = 0; const int gw2 = (bx - nlast) * NWAVES + wave, NGW2 = (G - nlast) * NWAVES;
          p0_weight<0>(a.in[6], DM, DFF, DM, W1OUT, scr, lane, gw2, NGW2, itbase);
          p0_weight<2>(a.in[9], 8208, DM, NIN, WIN, scr, lane, gw2, NGW2, itbase);
          p0_weight<0>(a.in[13], DM, DM, DM, WGLAO, scr, lane, gw2, NGW2, itbase);
          p0_weight<0>(a.in[14], DM, DM, DM, WSBO, scr, lane, gw2, NGW2, itbase);
          p0_weight<0>(a.in[15], DM, DM, DM, WOUT, scr, lane, gw2, NGW2, itbase);
          p0_weight<1>(a.in[18], 2 * DFF, DM, 2 * DFF, W2IN, scr, lane, gw2, NGW2, itbase); }
        else if (G != 256) { __syncthreads(); LAS float* scr = (LAS float*)(lds + wave * 16384); int itbase = 0;
          p0_weight<0>(a.in[6], DM, DFF, DM, W1OUT, scr, lane, gw, NGW, itbase);
          p0_weight<2>(a.in[9], 8208, DM, NIN, WIN, scr, lane, gw, NGW, itbase);
          p0_weight<0>(a.in[13], DM, DM, DM, WGLAO, scr, lane, gw, NGW, itbase);
          p0_weight<0>(a.in[14], DM, DM, DM, WSBO, scr, lane, gw, NGW, itbase);
          p0_weight<0>(a.in[15], DM, DM, DM, WOUT, scr, lane, gw, NGW, itbase);
          p0_weight<1>(a.in[18], 2 * DFF, DM, 2 * DFF, W2IN, scr, lane, gw, NGW, itbase);
          p0_weight<0>(a.in[19], DM, DFF, DM, W2OUT, scr, lane, gw, NGW, itbase); } }
#ifdef PROBE_NULL_P1
      { pg8::EpiNull EN{(float*)R}; GEMM_PHASE(pg8::EpiNull, MT, XB, W1IN, 2 * DFF, DM, EN); }
#endif
    }
    XBAR(); STAMP(2);
#define P2_SMALL() do { pg8::SEpiResid<true> E{XB + (size_t)MP * DM, (pg8::bf16_t*)R + (size_t)MP * DM, DN_ALPHA, 0.5f}; for (int u = vcu; u < 256; u += G) { __syncthreads(); sgemm_unit(lds, ACT + (size_t)MP * DFF, W1OUT, DFF, u, E); } } while (0)
    if (PH(2)) REP(2) { if (small_first) { P2_SMALL(); __syncthreads(); }
      { pg8::EpiResid<true> E{XB, (pg8::bf16_t*)R, DN_ALPHA, 0.5f}; GEMM_PHASE(pg8::EpiResid<true>, MP, ACT, W1OUT, DM, DFF, E); }
      if (!small_first) P2_SMALL(); }
    XBAR(); STAMP(3);
    if (PH(3)) REP(3) ln1_phase(lds, R, HB, GLR, a.in[7], a.in[8], a.in[9], vcu, G, tid, lane, wave);
    XBAR(); STAMP(4);
#ifdef STAGGER_P4
    { const unsigned g4 = (unsigned)(bx >> 3) & 3u; const unsigned long long t0 = __builtin_amdgcn_s_memrealtime(); while (__builtin_amdgcn_s_memrealtime() - t0 < (unsigned long long)(g4 * STAGGER_P4)) __builtin_amdgcn_s_sleep(8); }
#endif
    if (PH(4)) REP(4) { pg8::EpiMixIn E{(pg8::bf16_t*)GQ, (pg8::bf16_t*)GK, (pg8::bf16_t*)GV, (pg8::bf16_t*)GR, (pg8::bf16_t*)SQ, (pg8::bf16_t*)SKB, (pg8::bf16_t*)SVB, (pg8::bf16_t*)GA, (pg8::bf16_t*)GB,
                      out + O_KP, out + O_KS, out + O_VP, out + O_VS};
      GEMM_PHASE(pg8::EpiMixIn, MT, HB, WIN, NIN, DM, E);
#ifdef PROBE_BF_P4
      { pg8::EpiMixIn E2 = E; E2.okp = nullptr; GEMM_PHASE(pg8::EpiMixIn, MT, HB, WIN, NIN, DM, E2); }
#endif
#ifdef PROBE_NULL_P1
#endif
#ifdef PROBE_NULL_P4
      { pg8::EpiNull EN{(float*)R}; GEMM_PHASE(pg8::EpiNull, MT, HB, WIN, NIN, DM, EN); }
#endif
    }
    XBAR(); STAMP(5);
#ifndef P5_ROT
#define P5_ROT 3
#endif
#pragma unroll 1
    for (int st_ = 0; st_ < 3; ++st_) { const int kind_ = (st_ + (P5_ROT > 1 ? vcu % P5_ROT : 0)) % 3;
      if (kind_ == 0 && PH(5)) REP(5) for (int u = vcu; u < 512; u += G) { __syncthreads();
        if (u < 256) { const int bh = u >> 5, sc = u & 31, m0 = (bh >> 2) * TSEQ + sc * 256;
            gla_unit_a(lds, m0, bh & 3, 4, GK, GV, GLR, a.in[10], a.in[11], nullptr, DS + (size_t)u * 32768, LSUM + u * 128, tid, lane, wave); }
        else if (u < 384) { const int su = u - 256, h = su & 3, m0 = MP + (su >> 2) * 64;
            gla_unit_a(lds, m0, h, 1, GK, GV, GLR, a.in[10], a.in[11], state_gla + (size_t)su * 32768, out + O_SGS + (size_t)su * 32768, nullptr, tid, lane, wave); }
        else { const int su = u - 384, h = su & 3, m0 = MP + (su >> 2) * 64;
            gla_unit_c(lds, m0, h, 1, GQ, GK, GV, GR, GLR, a.in[10], a.in[11], state_gla + (size_t)su * 32768, a.in[12], OA, tid, lane, wave); } }
      if (kind_ == 1 && PH(7)) REP(7) for (int u = vcu; u < 512; u += G) { const int bh = u >> 5, qb = u & 31, b = bh >> 3, h = bh & 7, i0 = qb * 256; __syncthreads();
        const size_t qo = ((size_t)b * TSEQ + i0) * 1024 + h * 128, ko = (size_t)b * TSEQ * 1024 + h * 128;
        sb_unit<false>(lds, SQ + qo, OB + qo, 8, i0, SKB + ko, SVB + ko, nullptr, nullptr, out + O_KP + qo, out + O_VP + qo, i0, tid, lane, wave); }
      if (kind_ == 2 && PH(8)) REP(8) for (int u = vcu; u < 256; u += G) { const int b = u >> 3, h = u & 7; __syncthreads();
        const size_t qo = ((size_t)MP + b * 64) * 1024 + h * 128, co = (size_t)b * 4096 * 1024 + h * 128, no = (size_t)b * 64 * 1024 + h * 128;
        sb_unit<true>(lds, SQ + qo, OB + qo, 2, 4096, SKB + qo, SVB + qo, cache_k + co, cache_v + co, out + O_KS + no, out + O_VS + no, 4096, tid, lane, wave); }
    }
    XBAR(); STAMP(6);
    if (PH(9)) REP(9) gla_scan_phase(DS, SIN, LSUM, out + O_SGP, vcu, G, tid);
    XBAR(); STAMP(7);
    if (PH(10)) REP(10) for (int u = vcu; u < 256; u += G) { __syncthreads();
        { const int bh = u >> 5, sc = u & 31, m0 = (bh >> 2) * TSEQ + sc * 256;
            gla_unit_c(lds, m0, bh & 3, 4, GQ, GK, GV, GR, GLR, a.in[10], a.in[11], SIN + (size_t)u * 32768, a.in[12], OA, tid, lane, wave); } }
    XBAR(); STAMP(8);
#define P8_SMALL() do { pg8::SEpiBranch2 E{(const pg8::bf16_t*)GA + (size_t)MP * DM, (const pg8::bf16_t*)GB + (size_t)MP * DM, (pg8::bf16_t*)MG + (size_t)MP * DM}; \
      for (int u = vcu; u < 256; u += G) { __syncthreads(); sgemm_unit2(lds, OA + (size_t)MP * DM, WGLAO, OB + (size_t)MP * DM, WSBO, u, E); } } while (0)
    if (PH(11)) REP(11) { if (small_first) { P8_SMALL(); __syncthreads(); }
      { pg8::EpiBranch<0> E{(const pg8::bf16_t*)GA, (pg8::bf16_t*)TB, nullptr}; GEMM_PHASE(pg8::EpiBranch<0>, MP, OA, WGLAO, DM, DM, E); }
      { pg8::EpiBranch<1> E{(const pg8::bf16_t*)GB, (pg8::bf16_t*)TB, (pg8::bf16_t*)MG}; GEMM_PHASE(pg8::EpiBranch<1>, MP, OB, WSBO, DM, DM, E); }
      if (!small_first) P8_SMALL(); }
    XBAR(); STAMP(9);
#define P9_SMALL() do { pg8::SEpiResid<true> E{HB + (size_t)MP * DM, (pg8::bf16_t*)R + (size_t)MP * DM, DN_ALPHA, 1.0f}; for (int u = vcu; u < 256; u += G) { __syncthreads(); sgemm_unit(lds, MG + (size_t)MP * DM, WOUT, DM, u, E); } } while (0)
    if (PH(13)) REP(13) { if (small_first) { P9_SMALL(); __syncthreads(); }
      { pg8::EpiResid<true> E{HB, (pg8::bf16_t*)R, DN_ALPHA, 1.0f}; GEMM_PHASE(pg8::EpiResid<true>, MP, MG, WOUT, DM, DM, E); }
      if (!small_first) P9_SMALL(); }
    XBAR(); STAMP(10);
    if (PH(14)) REP(14) ln_phase<0>(R, nullptr, HB, a.in[16], a.in[17], gw, NGW, lane);
    XBAR(); STAMP(11);
    if (PH(15)) REP(15) { pg8::EpiSwiGLU E{(pg8::bf16_t*)ACT, DFF}; GEMM_PHASE(pg8::EpiSwiGLU, MT, HB, W2IN, 2 * DFF, DM, E);
      { const int nlast = (MT / 256) * (2 * DFF / 256) - 6 * G;
        if (G == 256 && bx >= nlast) { __syncthreads(); int t2 = threadIdx.x; asm volatile("" : "+v"(t2)); const int lane2 = t2 & 63, wave2 = __builtin_amdgcn_readfirstlane(t2 >> 6);
          LAS float* scr = (LAS float*)(lds + wave2 * 16384); int itbase = 0; const int gw2 = (bx - nlast) * NWAVES + wave2, NGW2 = (G - nlast) * NWAVES;
          p0_weight<0>(a.in[19], DM, DFF, DM, W2OUT, scr, lane2, gw2, NGW2, itbase); } } }
    XBAR(); STAMP(12);
#define P12_SMALL() do { pg8::SEpiResid<true> E{HB + (size_t)MP * DM, (pg8::bf16_t*)R + (size_t)MP * DM, DN_ALPHA, 0.5f}; for (int u = vcu; u < 256; u += G) { __syncthreads(); sgemm_unit(lds, ACT + (size_t)MP * DFF, W2OUT, DFF, u, E); } } while (0)
    if (PH(16)) REP(16) { if (small_first) { P12_SMALL(); __syncthreads(); }
      { pg8::EpiResid<true> E{HB, (pg8::bf16_t*)R, DN_ALPHA, 0.5f}; GEMM_PHASE(pg8::EpiResid<true>, MP, ACT, W2OUT, DM, DFF, E); }
      if (!small_first) P12_SMALL(); }
    XBAR(); STAMP(13);
    if (PH(17)) REP(17) ln_phase<1>(R, out + O_Y, nullptr, a.in[20], a.in[21], gw, NGW, lane);
#ifdef TP_A
    XBAR(); STAMP(14);
#endif
#ifdef PROBE_A0
    XBAR(); STAMP(14);
    __syncthreads();
    if (bx == 0) {
#define TS(k) (((unsigned long long)MISC[17 + 2 * (k)] << 32) | (unsigned long long)MISC[16 + 2 * (k)])
        const float tA = (float)(long long)(TS(PROBE_A1) - TS(PROBE_A0)) * 0.01f, tB = (float)(long long)(TS(PROBE_B1) - TS(PROBE_B0)) * 0.01f;
        const float c = sqrtf(tA);
        for (int i = tid; i < MS * DM; i += 512) out[O_Y + (size_t)MP * DM + i] = c;
        if (tid == 0) out[O_VS] += tB;
    }
#endif
}

extern "C" void kernel_launch(void* const* d_in, const int* in_sizes, int n_in, void* d_out, int out_size, void* d_ws, size_t ws_size, hipStream_t stream) {
    static int grid = 0;
    if (grid == 0) {
        if (n_in != 22 || (size_t)out_size != O_END || ws_size < WS_END) { fprintf(stderr, "kernel_launch: unexpected shapes: n_in %d out %d ws %zu\n", n_in, out_size, ws_size); grid = -1; return; }
        int dev = 0, cus = 0, per_cu = 0;
        if (hipGetDevice(&dev) != hipSuccess || hipDeviceGetAttribute(&cus, hipDeviceAttributeMultiprocessorCount, dev) != hipSuccess) { grid = -1; return; }
        if (hipFuncSetAttribute((const void*)mk_fwd, hipFuncAttributeMaxDynamicSharedMemorySize, LDS_BYTES) != hipSuccess) { fprintf(stderr, "kernel_launch: hipFuncSetAttribute failed\n"); grid = -1; return; }
        if (hipOccupancyMaxActiveBlocksPerMultiprocessor(&per_cu, (const void*)mk_fwd, NWAVES * 64, LDS_BYTES) != hipSuccess || per_cu < 1) fprintf(stderr, "kernel_launch: occupancy query says %d\n", per_cu);
        (void)hipGetLastError();
        grid = cus;
    }
    if (grid < 0) return;
    if (hipMemsetAsync((char*)d_ws + WS_CTL, 0, CTL_ZERO_BYTES, stream) != hipSuccess) return;
    Args a{};
    for (int i = 0; i < 22; ++i) a.in[i] = (const float*)d_in[i];
    a.out = (float*)d_out; a.ws = (unsigned char*)d_ws;
    hipLaunchKernelGGL(mk_fwd, dim3(grid), dim3(NWAVES * 64), LDS_BYTES, stream, a);
    const hipError_t le = hipPeekAtLastError();
    if (le != hipSuccess) fprintf(stderr, "kernel_launch: launch failed: %s\n", hipGetErrorName(le));
}
```
